# Optimizing an MI355X kernel written in HIP

```python
import jax, jax.numpy as jnp
from jax import lax
import numpy as np

D_MODEL = 1024
BATCH = 8
SEQ = 4096
DEPTH = 1

N_HEADS = 8
N_KV_HEADS = 2
HEAD_DIM = 64
GQA_GROUP = N_HEADS // N_KV_HEADS
ATTN_DIM = N_HEADS * HEAD_DIM
KV_DIM = N_KV_HEADS * HEAD_DIM
WINDOW = 128
ATTN_BLOCK = 128
ROT_DIM = HEAD_DIM // 4
ROPE_THETA = 500000.0
CONV_DIM = D_MODEL // 2
CONV_WIDTH = 3
SPLIT_SIZES = (ATTN_DIM, KV_DIM, KV_DIM, CONV_DIM, CONV_DIM, CONV_DIM, D_MODEL, D_MODEL)
PROJ_WIDTH = sum(SPLIT_SIZES)
SPLIT_POINTS = tuple(int(v) for v in np.cumsum(SPLIT_SIZES)[:-1])
N_GROUPS = 4
EXPERTS_PER_GROUP = 8
N_EXPERTS = N_GROUPS * EXPERTS_PER_GROUP
TOP_K = 2
D_FF_EXPERT = D_MODEL // 4
MOE_BLOCK = 128
NORM_EPS = 1e-6
MASK_VALUE = -1e30

kernel_name = "hybrid_swa_shortconv_hiermoe_encoder"


def rmsnorm(x, g):
    xf = x.astype(jnp.float32)
    xf = xf * lax.rsqrt(jnp.mean(xf * xf, axis=-1, keepdims=True) + NORM_EPS)
    return xf.astype(x.dtype) * g


def rope_tables(seq_len):
    inv_freq = ROPE_THETA ** (-jnp.arange(0, ROT_DIM, 2, dtype=jnp.float32) / ROT_DIM)
    ang = jnp.arange(seq_len, dtype=jnp.float32)[:, None] * inv_freq[None, :]
    return jnp.cos(ang), jnp.sin(ang)


def partial_rope(x, cos, sin):
    half = ROT_DIM // 2
    c = cos[None, :, None, :].astype(x.dtype)
    s = sin[None, :, None, :].astype(x.dtype)
    x1 = x[..., :half]
    x2 = x[..., half:ROT_DIM]
    return jnp.concatenate([x1 * c - x2 * s, x2 * c + x1 * s, x[..., ROT_DIM:]], axis=-1)


def band_keys(t):
    b, s, hk, hd = t.shape
    nb = s // ATTN_BLOCK
    tp = jnp.pad(t, ((0, 0), (WINDOW, WINDOW), (0, 0), (0, 0))).reshape(b, nb + 2, ATTN_BLOCK, hk, hd)
    return jnp.concatenate([tp[:, :-2], tp[:, 1:-1], tp[:, 2:]], axis=2)


def windowed_gqa(q, k, v, sink):
    b, s, _, hd = q.shape
    nb = s // ATTN_BLOCK
    qb = q.reshape(b, nb, ATTN_BLOCK, N_KV_HEADS, GQA_GROUP, hd)
    kw = band_keys(k)
    vw = band_keys(v)
    scores = jnp.einsum('bnqhgd,bnkhd->bnhgqk', qb, kw,
                        preferred_element_type=jnp.float32) * (HEAD_DIM ** -0.5)
    blk = jnp.arange(nb)[:, None, None] * ATTN_BLOCK
    qpos = blk + jnp.arange(ATTN_BLOCK)[None, :, None]
    kpos = blk - WINDOW + jnp.arange(3 * ATTN_BLOCK)[None, None, :]
    valid = (jnp.abs(qpos - kpos) <= WINDOW) & (kpos >= 0) & (kpos < s)
    scores = jnp.where(valid[None, :, None, None], scores, MASK_VALUE)
    sink_b = sink.astype(jnp.float32).reshape(1, 1, N_KV_HEADS, GQA_GROUP, 1, 1)
    m = jnp.maximum(jnp.max(scores, axis=-1, keepdims=True), sink_b)
    e = jnp.exp(scores - m)
    p = e / (jnp.sum(e, axis=-1, keepdims=True) + jnp.exp(sink_b - m))
    o = jnp.einsum('bnhgqk,bnkhd->bnqhgd', p.astype(v.dtype), vw)
    return o.reshape(b, s, N_HEADS * hd)


def short_gated_conv(gate_b, gate_c, xc, conv_w, conv_b):
    u = gate_c * xc
    up = jnp.pad(u, ((0, 0), (1, 1), (0, 0)))
    conv = up[:, :-2] * conv_w[0] + up[:, 1:-1] * conv_w[1] + up[:, 2:] * conv_w[2] + conv_b
    return gate_b * conv


def hierarchical_moe(h, w_rg, b_rg, w_re, b_re, w_gate, w_up, w_down):
    b, s, d = h.shape
    t = b * s
    hf = h.reshape(t, d)
    hf32 = hf.astype(jnp.float32)
    g_logits = hf32 @ w_rg.astype(jnp.float32) + b_rg.astype(jnp.float32)
    grp = jnp.argmax(g_logits, axis=-1)
    p_grp = jnp.take_along_axis(jax.nn.softmax(g_logits, axis=-1), grp[:, None], axis=-1)
    e_logits = (hf32 @ w_re.astype(jnp.float32) + b_re.astype(jnp.float32)).reshape(t, N_GROUPS, EXPERTS_PER_GROUP)
    e_in = jnp.take_along_axis(e_logits, grp[:, None, None], axis=1)[:, 0]
    top_p, top_i = lax.top_k(jax.nn.softmax(e_in, axis=-1), TOP_K)
    top_p = top_p / jnp.sum(top_p, axis=-1, keepdims=True)
    gates = (p_grp * top_p).reshape(t * TOP_K)
    expert = (grp[:, None] * EXPERTS_PER_GROUP + top_i).reshape(t * TOP_K)
    n_assign = t * TOP_K
    order = jnp.argsort(expert)
    e_sorted = expert[order]
    tok = order // TOP_K
    counts = jnp.bincount(expert, length=N_EXPERTS)
    starts = jnp.cumsum(counts) - counts
    padded = ((counts + MOE_BLOCK - 1) // MOE_BLOCK) * MOE_BLOCK
    pad_ends = jnp.cumsum(padded)
    pad_starts = pad_ends - padded
    dest = pad_starts[e_sorted] + (jnp.arange(n_assign) - starts[e_sorted])
    n_rows = n_assign + N_EXPERTS * MOE_BLOCK
    n_blocks = n_rows // MOE_BLOCK
    x_pad = jnp.zeros((n_rows, d), h.dtype).at[dest].set(hf[tok])
    block_e = jnp.minimum(jnp.searchsorted(pad_ends, jnp.arange(n_blocks) * MOE_BLOCK, side='right'),
                          N_EXPERTS - 1)

    def expert_block(args):
        xb, e = args
        hid = jax.nn.silu(xb @ w_gate[e]) * (xb @ w_up[e])
        return hid @ w_down[e]

    y_pad = lax.map(expert_block, (x_pad.reshape(n_blocks, MOE_BLOCK, d), block_e)).reshape(n_rows, d)
    y = y_pad[dest] * gates[order][:, None].astype(h.dtype)
    out = jnp.zeros((t, d), h.dtype).at[tok].add(y)
    return out.reshape(b, s, d)


def setup_inputs(seed: int = 0) -> dict:
    key = jax.random.key(seed)
    ks = jax.random.split(key, 20)
    f32 = jnp.float32

    def nrm(k, shape, fan_in):
        return jax.random.normal(k, shape, f32) * (fan_in ** -0.5)

    def gain(k, shape):
        return 1.0 + 0.02 * jax.random.normal(k, shape, f32)

    return {
        "x": jax.random.normal(ks[0], (BATCH, SEQ, D_MODEL), f32),
        "norm1_g": gain(ks[1], (DEPTH, D_MODEL)),
        "w_in": nrm(ks[2], (DEPTH, D_MODEL, PROJ_WIDTH), D_MODEL),
        "q_norm_g": gain(ks[3], (DEPTH, HEAD_DIM)),
        "k_norm_g": gain(ks[4], (DEPTH, HEAD_DIM)),
        "attn_sink": 0.5 * jax.random.normal(ks[5], (DEPTH, N_HEADS), f32),
        "conv_w": nrm(ks[6], (DEPTH, CONV_WIDTH, CONV_DIM), CONV_WIDTH),
        "conv_b": 0.02 * jax.random.normal(ks[7], (DEPTH, CONV_DIM), f32),
        "w_attn_proj": nrm(ks[8], (DEPTH, ATTN_DIM, D_MODEL), ATTN_DIM),
        "w_conv_proj": nrm(ks[9], (DEPTH, CONV_DIM, D_MODEL), CONV_DIM),
        "w_out": nrm(ks[10], (DEPTH, D_MODEL, D_MODEL), D_MODEL),
        "norm2_g": gain(ks[11], (DEPTH, D_MODEL)),
        "w_router_group": nrm(ks[12], (DEPTH, D_MODEL, N_GROUPS), D_MODEL),
        "b_router_group": 0.01 * jax.random.normal(ks[13], (DEPTH, N_GROUPS), f32),
        "w_router_expert": nrm(ks[14], (DEPTH, D_MODEL, N_EXPERTS), D_MODEL),
        "b_router_expert": 0.01 * jax.random.normal(ks[15], (DEPTH, N_EXPERTS), f32),
        "w_gate_e": nrm(ks[16], (DEPTH, N_EXPERTS, D_MODEL, D_FF_EXPERT), D_MODEL),
        "w_up_e": nrm(ks[17], (DEPTH, N_EXPERTS, D_MODEL, D_FF_EXPERT), D_MODEL),
        "w_down_e": nrm(ks[18], (DEPTH, N_EXPERTS, D_FF_EXPERT, D_MODEL), D_FF_EXPERT),
    }


def reference(x, norm1_g, w_in, q_norm_g, k_norm_g, attn_sink, conv_w, conv_b,
              w_attn_proj, w_conv_proj, w_out, norm2_g, w_router_group, b_router_group,
              w_router_expert, b_router_expert, w_gate_e, w_up_e, w_down_e):
    b, s, _ = x.shape
    cos, sin = rope_tables(s)
    for l in range(DEPTH):
        h = rmsnorm(x, norm1_g[l])
        proj = h @ w_in[l]
        q, k, v, cb, cc, cx, g_attn, g_conv = jnp.split(proj, SPLIT_POINTS, axis=-1)
        q = rmsnorm(q.reshape(b, s, N_HEADS, HEAD_DIM), q_norm_g[l])
        k = rmsnorm(k.reshape(b, s, N_KV_HEADS, HEAD_DIM), k_norm_g[l])
        v = v.reshape(b, s, N_KV_HEADS, HEAD_DIM)
        q = partial_rope(q, cos, sin)
        k = partial_rope(k, cos, sin)
        attn = windowed_gqa(q, k, v, attn_sink[l])
        conv = short_gated_conv(cb, cc, cx, conv_w[l], conv_b[l])
        merged = (jax.nn.sigmoid(g_attn) * (attn @ w_attn_proj[l])
                  + jax.nn.sigmoid(g_conv) * (conv @ w_conv_proj[l]))
        x = x + merged @ w_out[l]
        h2 = rmsnorm(x, norm2_g[l])
        x = x + hierarchical_moe(h2, w_router_group[l], b_router_group[l],
                                 w_router_expert[l], b_router_expert[l],
                                 w_gate_e[l], w_up_e[l], w_down_e[l])
    return x
```

```cpp
#include <hip/hip_runtime.h>
#include <hip/hip_cooperative_groups.h>
#include <cstdio>
#include <cstdint>
namespace cg = cooperative_groups;

#ifndef PROBE_DUP
#define PROBE_DUP -1
#endif
#ifndef MK_N_LAUNCHES
#define MK_N_LAUNCHES 1
#endif

#define LAS __attribute__((address_space(3)))
#define GAS __attribute__((address_space(1)))
typedef unsigned short bf16_t;
typedef short bf16x8 __attribute__((ext_vector_type(8)));
typedef short s16x4 __attribute__((ext_vector_type(4)));
typedef float f32x4 __attribute__((ext_vector_type(4)));
typedef float f32x2 __attribute__((ext_vector_type(2)));
typedef float f32x16 __attribute__((ext_vector_type(16)));
typedef unsigned u32x4 __attribute__((ext_vector_type(4)));
typedef unsigned u32x2 __attribute__((ext_vector_type(2)));
typedef __bf16 bf16x2_t __attribute__((ext_vector_type(2)));

constexpr int NB = 8, SEQ = 4096, M = NB * SEQ, D = 1024, PW = 4352;
constexpr int NH = 8, NKV = 2, HD = 64, AD = 512, CD = 512;
constexpr int C_Q = 0, C_K = 512, C_V = 640, C_CB = 768, C_CC = 1280, C_CX = 1792, C_GA = 2304;
constexpr int NE = 32, DFF = 256, CAP = 32768;
constexpr float EPS = 1e-6f;
constexpr float QSCALE = 0.125f * 1.4426950408889634f;
constexpr int NWAVES = 8, NTHREADS = 512;

constexpr size_t MiB = 1u << 20;
constexpr size_t WS_CTL = 0, CTL_ZERO_BYTES = 64 * 1024;
constexpr size_t WS_ROPE = 1 * MiB;
constexpr size_t WS_WR = 1 * MiB + 256 * 1024;
constexpr size_t WS_WIN = 2 * MiB;
constexpr size_t WS_WA = 11 * MiB, WS_WC = 12 * MiB;
constexpr size_t WS_WOUT = 13 * MiB;
constexpr size_t WS_WGU = 16 * MiB;
constexpr size_t WS_WD = 48 * MiB;
constexpr size_t WS_XN = 64 * MiB;
constexpr size_t WS_AC = 64 * MiB;
constexpr size_t WS_PROJ = 128 * MiB;
constexpr size_t WS_H2 = 128 * MiB;
constexpr size_t WS_HID = 192 * MiB;
constexpr size_t WS_Y = 232 * MiB;
constexpr size_t WS_QN = 400 * MiB;
constexpr size_t WS_KN = 432 * MiB;
constexpr size_t WS_MERGED = 400 * MiB;
constexpr size_t WS_ASG = 464 * MiB;
constexpr size_t WS_RSG = 468 * MiB;
constexpr size_t WS_END = 476 * MiB;
constexpr int CW_CNT = 1024;
constexpr int CW_BAR = 4096;

constexpr int RING_BYTES = 131072;
constexpr int LDSCTL_OFF = RING_BYTES;
constexpr int LC_MISC = 0;
constexpr int LC_MTPRE = 128;
constexpr int LC_CNT = 128 + 160;
constexpr int LC_HIST = LC_CNT + 128;
constexpr int LC_BASE = LC_HIST + 128;
constexpr int LDS_BYTES = 163840;

__device__ __forceinline__ unsigned cvtpk(float lo, float hi) { f32x2 v = {lo, hi}; bf16x2_t b = __builtin_convertvector(v, bf16x2_t); return __builtin_bit_cast(unsigned, b); }
__device__ __forceinline__ bf16_t f2bf(float f) { return (bf16_t)(cvtpk(f, 0.f) & 0xffffu); }
__device__ __forceinline__ float bf2f(unsigned h) { return __builtin_bit_cast(float, h << 16); }
__device__ __forceinline__ float bflo(unsigned w) { return __builtin_bit_cast(float, w << 16); }
__device__ __forceinline__ float bfhi(unsigned w) { return __builtin_bit_cast(float, w & 0xffff0000u); }
__device__ __forceinline__ float wave_sum(float v) {
#pragma unroll
    for (int o = 1; o < 64; o <<= 1) v += __shfl_xor(v, o);
    return v;
}
__device__ __forceinline__ float wave_max(float v) {
#pragma unroll
    for (int o = 1; o < 64; o <<= 1) v = fmaxf(v, __shfl_xor(v, o));
    return v;
}
__device__ __forceinline__ float sigmoidf_(float v) { return __builtin_amdgcn_rcpf(1.0f + __builtin_amdgcn_exp2f(-1.4426950408889634f * v)); }
__device__ __forceinline__ void unpack8(const u32x4 w, float (&v)[8]) { v[0] = bflo(w.x); v[1] = bfhi(w.x); v[2] = bflo(w.y); v[3] = bfhi(w.y); v[4] = bflo(w.z); v[5] = bfhi(w.z); v[6] = bflo(w.w); v[7] = bfhi(w.w); }
__device__ __forceinline__ u32x4 pack8(const float (&v)[8]) { u32x4 w; w.x = cvtpk(v[0], v[1]); w.y = cvtpk(v[2], v[3]); w.z = cvtpk(v[4], v[5]); w.w = cvtpk(v[6], v[7]); return w; }
#define LDS_WAIT() asm volatile("s_waitcnt lgkmcnt(0)" ::: "memory")
#define VM_WAIT() asm volatile("s_waitcnt vmcnt(0)" ::: "memory")

namespace pg8 {
constexpr int BM = 256, BK = 64, HALF = 128, HTB = HALF * BK * 2, STAGE_BYTES = 8 * HTB, NXCD = 8, WGM = 8;
__host__ __device__ __forceinline__ int lds_byte(int r, int c) { const int st = (r >> 4) * 2 + (c >> 5), rr = r & 15, cc = c & 31, ob = rr * 64 + cc * 2; return st * 1024 + (ob ^ (((ob >> 9) & 1) << 5)); }
__host__ __device__ __forceinline__ void stage_rc(int b, int& R, int& C) { const int st = b / 1024, sb = b % 1024, swz = sb ^ (((sb >> 9) & 1) << 5); R = (st >> 1) * 16 + swz / 64; C = (st & 1) * 32 + (swz % 64) / 2; }
__host__ __device__ __forceinline__ int perm32(int rho) { const int n = rho >> 4, i = rho & 15; return 8 * (i >> 2) + 4 * n + (i & 3); }

struct Unit { int pm, pn, z, valid; };

__device__ __forceinline__ void tile_of(int L, int nM, int nN, int& pm, int& pn) {
    const int nwg = nM * nN; int wgid = L;
    { const int q = nwg / NXCD, r = nwg % NXCD, xcd = wgid % NXCD, off = wgid / NXCD; wgid = (xcd < r ? xcd * (q + 1) : r * (q + 1) + (xcd - r) * q) + off; }
    const int nig = WGM * nN, gid = wgid / nig, fm = gid * WGM, gsz = (nM - fm) < WGM ? (nM - fm) : WGM;
    pm = fm + ((wgid % nig) % gsz); pn = (wgid % nig) / gsz;
}

struct PlainOrder {
    static constexpr bool GATHER = false;
    const bf16_t* A; const bf16_t* Bt; int lda, ldb, nM, nN, G, c;
    __device__ __forceinline__ bool next(int i, Unit& u) const { const int L = i * G + c; if (L >= nM * nN) return false; tile_of(L, nM, nN, u.pm, u.pn); u.z = 0; u.valid = 256; return true; }
    __device__ __forceinline__ void ptrs(const Unit& u, const char*& a, const char*& b) const { a = (const char*)(A + (size_t)u.pm * 256 * lda); b = (const char*)(Bt + (size_t)u.pn * 256 * ldb); }
    __device__ __forceinline__ void avoff(const Unit&, const int (&R)[2], const int (&C)[2], unsigned (&v)[2][2]) const {
#pragma unroll
        for (int h = 0; h < 2; ++h)
#pragma unroll
            for (int i = 0; i < 2; ++i) v[h][i] = (unsigned)(R[i] * lda + C[i]) * 2u;
    }
};
struct DualOrder {
    static constexpr bool GATHER = false;
    const bf16_t* AC; const bf16_t* Wa; const bf16_t* Wc; int G, c;
    __device__ __forceinline__ bool next(int i, Unit& u) const { const int L = (i >> 1) * G + c; if (L >= 128 * 4) return false; tile_of(L, 128, 4, u.pm, u.pn); u.z = i & 1; u.valid = 256; return true; }
    __device__ __forceinline__ void ptrs(const Unit& u, const char*& a, const char*& b) const { a = (const char*)(AC + (size_t)u.pm * 256 * 1024 + u.z * 512); b = (const char*)((u.z ? Wc : Wa) + (size_t)u.pn * 256 * 512); }
    __device__ __forceinline__ void avoff(const Unit&, const int (&R)[2], const int (&C)[2], unsigned (&v)[2][2]) const {
#pragma unroll
        for (int h = 0; h < 2; ++h)
#pragma unroll
            for (int i = 0; i < 2; ++i) v[h][i] = (unsigned)(R[i] * 1024 + C[i]) * 2u;
    }
};
struct MoeOrder {
    const LAS int* mtpre; const LAS int* cnt; int NT, G, c;
    __device__ __forceinline__ bool locate(int i, Unit& u) const {
        const int L = i * G + c; const int U = mtpre[32] * NT; if (L >= U) return false;
        const int tg = L / NT; u.pn = L - tg * NT; int e = 0;
#pragma unroll 1
        for (int j = 1; j < 32; ++j) e += (mtpre[j] <= tg) ? 1 : 0;
        u.z = e; u.pm = tg; const int mt = tg - mtpre[e]; const int left = cnt[e] - mt * 256; u.valid = left < 256 ? left : 256; return true;
    }
};
struct MoeGuOrder : MoeOrder {
    static constexpr bool GATHER = true;
    const bf16_t* H2; const bf16_t* Wgu; const int* asg;
    __device__ __forceinline__ bool next(int i, Unit& u) const { return locate(i, u); }
    __device__ __forceinline__ void ptrs(const Unit& u, const char*& a, const char*& b) const { a = (const char*)H2; b = (const char*)(Wgu + ((size_t)u.z * 512 + (size_t)u.pn * 256) * 1024); }
    __device__ __forceinline__ void avoff(const Unit& u, const int (&R)[2], const int (&C)[2], unsigned (&v)[2][2]) const {
        const int mt = u.pm - mtpre[u.z]; const int* ap = asg + ((size_t)u.z * CAP + mt * 256);
#pragma unroll
        for (int h = 0; h < 2; ++h)
#pragma unroll
            for (int i = 0; i < 2; ++i) { const unsigned r = (unsigned)(h * 128 + R[i]); int tok = 0; if ((int)r < u.valid) tok = ap[r] >> 1; v[h][i] = (unsigned)(tok * 1024 + C[i]) * 2u; }
    }
};
struct MoeDownOrder : MoeOrder {
    static constexpr bool GATHER = false;
    const bf16_t* HID; const bf16_t* Wd;
    __device__ __forceinline__ bool next(int i, Unit& u) const { return locate(i, u); }
    __device__ __forceinline__ void ptrs(const Unit& u, const char*& a, const char*& b) const { a = (const char*)(HID + (size_t)u.pm * 256 * 256); b = (const char*)(Wd + ((size_t)u.z * 1024 + (size_t)u.pn * 256) * 256); }
    __device__ __forceinline__ void avoff(const Unit&, const int (&R)[2], const int (&C)[2], unsigned (&v)[2][2]) const {
#pragma unroll
        for (int h = 0; h < 2; ++h)
#pragma unroll
            for (int i = 0; i < 2; ++i) v[h][i] = (unsigned)(R[i] * 256 + C[i]) * 2u;
    }
};

typedef f32x4 Acc[2][2][4][2];

struct EpiProj {
    static constexpr bool PERM = true, HAS_MID = false;
    bf16_t* O;
    __device__ __forceinline__ void operator()(const Acc& acc, const Unit& u, int wr, int wc, int fr, int fq) const {
        bf16_t* base = O + (size_t)u.pm * BM * PW + u.pn * BM;
        unsigned l0 = (unsigned)((wr * 64 + fr) * PW + wc * 32 + 8 * fq); asm volatile("" : "+v"(l0)); const bool sg = u.pn >= 9;
#pragma unroll
        for (int ai = 0; ai < 2; ++ai)
#pragma unroll
            for (int m = 0; m < 4; ++m)
#pragma unroll
                for (int bj = 0; bj < 2; ++bj) { f32x4 v0 = acc[ai][bj][m][0], v1 = acc[ai][bj][m][1];
                    if (sg) {
#pragma unroll
                        for (int k = 0; k < 4; ++k) { v0[k] = sigmoidf_(v0[k]); v1[k] = sigmoidf_(v1[k]); } }
                    u32x4 w; w.x = cvtpk(v0[0], v0[1]); w.y = cvtpk(v0[2], v0[3]); w.z = cvtpk(v1[0], v1[1]); w.w = cvtpk(v1[2], v1[3]);
                    *(u32x4*)(base + (l0 + (unsigned)((ai * HALF + m * 16) * PW + bj * HALF))) = w; }
    }
};
struct EpiGate2 {
    static constexpr bool PERM = true, HAS_MID = true;
    const bf16_t* PROJ; bf16_t* MG;
    __device__ __forceinline__ void mid(Acc& acc, const Unit& u, int wr, int wc, int fr, int fq) const {
        const bf16_t* gbase = PROJ + (size_t)u.pm * BM * PW + C_GA + u.pn * BM;
        unsigned lg = (unsigned)((wr * 64 + fr) * PW + wc * 32 + 8 * fq); asm volatile("" : "+v"(lg));
#pragma unroll
        for (int ai = 0; ai < 2; ++ai) { u32x4 ga[4][2], gc[4][2];
#pragma unroll
            for (int m = 0; m < 4; ++m)
#pragma unroll
                for (int bj = 0; bj < 2; ++bj) { const unsigned o = lg + (unsigned)((ai * HALF + m * 16) * PW + bj * HALF); ga[m][bj] = *(const u32x4*)(gbase + o); gc[m][bj] = *(const u32x4*)(gbase + 1024 + o); }
#pragma unroll
            for (int m = 0; m < 4; ++m)
#pragma unroll
                for (int bj = 0; bj < 2; ++bj) { float a8[8], c8[8]; unpack8(ga[m][bj], a8); unpack8(gc[m][bj], c8);
#pragma unroll
                    for (int k = 0; k < 8; ++k) { const float r = a8[k] * __builtin_amdgcn_rcpf(fmaxf(c8[k], 9.5367431640625e-07f)); if (k < 4) acc[ai][bj][m][0][k] *= r; else acc[ai][bj][m][1][k - 4] *= r; } }
            asm volatile("" ::: "memory"); }
    }
    __device__ __forceinline__ void operator()(const Acc& acc, const Unit& u, int wr, int wc, int fr, int fq) const {
        const bf16_t* gbase = PROJ + (size_t)u.pm * BM * PW + C_GA + 1024 + u.pn * BM;
        bf16_t* ob = MG + (size_t)u.pm * BM * 1024 + u.pn * BM;
        unsigned lg = (unsigned)((wr * 64 + fr) * PW + wc * 32 + 8 * fq), lt = (unsigned)((wr * 64 + fr) * 1024 + wc * 32 + 8 * fq); asm volatile("" : "+v"(lg), "+v"(lt));
        u32x4 gc[2][4][2];
#pragma unroll
        for (int ai = 0; ai < 2; ++ai)
#pragma unroll
            for (int m = 0; m < 4; ++m)
#pragma unroll
                for (int bj = 0; bj < 2; ++bj) gc[ai][m][bj] = *(const u32x4*)(gbase + (lg + (unsigned)((ai * HALF + m * 16) * PW + bj * HALF)));
#pragma unroll
        for (int ai = 0; ai < 2; ++ai)
#pragma unroll
            for (int m = 0; m < 4; ++m)
#pragma unroll
                for (int bj = 0; bj < 2; ++bj) { float c8[8]; unpack8(gc[ai][m][bj], c8); float v[8];
#pragma unroll
                    for (int k = 0; k < 8; ++k) v[k] = (k < 4 ? acc[ai][bj][m][0][k] : acc[ai][bj][m][1][k - 4]) * fmaxf(c8[k], 9.5367431640625e-07f);
                    *(u32x4*)(ob + (lt + (unsigned)((ai * HALF + m * 16) * 1024 + bj * HALF))) = pack8(v); }
    }
};
struct EpiRes {
    static constexpr bool PERM = false, HAS_MID = false;
    const float* X; float* O;
    __device__ __forceinline__ void operator()(const Acc& acc, const Unit& u, int wr, int wc, int fr, int fq) const {
        const size_t tb = (size_t)u.pm * BM * D + u.pn * BM; const float* xb = X + tb; float* ob = O + tb;
        unsigned l0 = (unsigned)((wr * 64 + fr) * D + wc * 32 + 4 * fq); asm volatile("" : "+v"(l0));
#pragma unroll
        for (int ai = 0; ai < 2; ++ai) { f32x4 xv[4][2][2];
#pragma unroll
            for (int m = 0; m < 4; ++m)
#pragma unroll
                for (int bj = 0; bj < 2; ++bj)
#pragma unroll
                    for (int n = 0; n < 2; ++n) xv[m][bj][n] = *(const f32x4*)(xb + (l0 + (unsigned)((ai * HALF + m * 16) * D + bj * HALF + n * 16)));
#pragma unroll
            for (int m = 0; m < 4; ++m)
#pragma unroll
                for (int bj = 0; bj < 2; ++bj)
#pragma unroll
                    for (int n = 0; n < 2; ++n) *(f32x4*)(ob + (l0 + (unsigned)((ai * HALF + m * 16) * D + bj * HALF + n * 16))) = xv[m][bj][n] + acc[ai][bj][m][n];
            asm volatile("" ::: "memory"); }
    }
};
struct EpiGU {
    static constexpr bool PERM = true, HAS_MID = false;
    bf16_t* HID; const f32x2* rsg; const LAS int* mtpre;
    __device__ __forceinline__ void operator()(const Acc& acc, const Unit& u, int wr, int wc, int fr, int fq) const {
        const int mt = u.pm - mtpre[u.z]; const f32x2* rp = rsg + ((size_t)u.z * CAP + mt * 256);
        bf16_t* hb = HID + (size_t)u.pm * 256 * 256 + u.pn * 128;
        int r0 = wr * 64 + fr; asm volatile("" : "+v"(r0)); const unsigned l0 = (unsigned)(r0 * 256 + wc * 32 + 8 * fq);
        float rsv[2][4];
#pragma unroll
        for (int ai = 0; ai < 2; ++ai)
#pragma unroll
            for (int m = 0; m < 4; ++m) { const int r = r0 + ai * HALF + m * 16; const float t = rp[(unsigned)(r < u.valid ? r : 0)].y; rsv[ai][m] = r < u.valid ? t : 0.f; }
#pragma unroll
        for (int ai = 0; ai < 2; ++ai)
#pragma unroll
            for (int m = 0; m < 4; ++m) { const int r = r0 + ai * HALF + m * 16;
                const float rs = rsv[ai][m];
                const f32x4 g0 = acc[ai][0][m][0] * rs, g1 = acc[ai][0][m][1] * rs, u0 = acc[ai][1][m][0] * rs, u1 = acc[ai][1][m][1] * rs;
                float h[8];
#pragma unroll
                for (int k = 0; k < 4; ++k) { h[k] = g0[k] * sigmoidf_(g0[k]) * u0[k]; h[4 + k] = g1[k] * sigmoidf_(g1[k]) * u1[k]; }
                u32x4 w; w.x = cvtpk(h[0], h[1]); w.y = cvtpk(h[2], h[3]); w.z = cvtpk(h[4], h[5]); w.w = cvtpk(h[6], h[7]);
                *(u32x4*)(hb + (l0 + (unsigned)((ai * HALF + m * 16) * 256))) = w; }
    }
};
struct EpiDown {
    static constexpr bool PERM = true, HAS_MID = false;
    bf16_t* Y; const int* asg; const f32x2* rsg; const LAS int* mtpre;
    __device__ __forceinline__ void operator()(const Acc& acc, const Unit& u, int wr, int wc, int fr, int fq) const {
        const int mt = u.pm - mtpre[u.z]; const size_t pb = (size_t)u.z * CAP + mt * 256; const int* ap = asg + pb; const f32x2* rp = rsg + pb;
        bf16_t* yb = Y + u.pn * BM;
        int r0 = wr * 64 + fr; unsigned c0 = (unsigned)(wc * 32 + 8 * fq); asm volatile("" : "+v"(r0), "+v"(c0));
#pragma unroll
        for (int ai = 0; ai < 2; ++ai) { int av[4]; float gv[4];
#pragma unroll
            for (int m = 0; m < 4; ++m) { const int r = r0 + ai * HALF + m * 16; const unsigned rr = (unsigned)(r < u.valid ? r : 0); av[m] = ap[rr]; gv[m] = rp[rr].x; }
#pragma unroll
            for (int m = 0; m < 4; ++m) { const int r = r0 + ai * HALF + m * 16;
                if (r < u.valid) { const float gt = gv[m];
#pragma unroll
                    for (int bj = 0; bj < 2; ++bj) { const f32x4 v0 = acc[ai][bj][m][0] * gt, v1 = acc[ai][bj][m][1] * gt;
                        u32x4 w; w.x = cvtpk(v0[0], v0[1]); w.y = cvtpk(v0[2], v0[3]); w.z = cvtpk(v1[0], v1[1]); w.w = cvtpk(v1[2], v1[3]);
                        *(u32x4*)(yb + ((unsigned)av[m] * 1024u + c0 + (unsigned)(bj * HALF))) = w; } } }
            asm volatile("" ::: "memory"); }
    }
};

template <class Epi, class Sched, bool ALIGN_EPI>
__device__ __forceinline__ void gemm_phase(LAS unsigned char* lds, const int K, const int lda, const int ldb, const Sched& S, const Epi& E) {
    int tid = threadIdx.x; asm volatile("" : "+v"(tid));
    const int wid = __builtin_amdgcn_readfirstlane(tid >> 6), lane = tid & 63, wr = wid >> 2, wc = wid & 3, fr = lane & 15, fq = lane >> 4;
    const int nt = K / BK;
    int sR[2], sC[2]; unsigned voffB[2];
#pragma unroll
    for (int i = 0; i < 2; ++i) { int R, C; stage_rc(tid * 16 + i * 8192, R, C); sR[i] = R; sC[i] = C; const int Rb = Epi::PERM ? ((R & ~31) + perm32(R & 31)) : R;
        voffB[i] = (unsigned)(Rb * ldb + C) * 2u; }
    const size_t kstep = (size_t)(BK * 2);
    const size_t hB = (size_t)HALF * ldb * 2, hA = Sched::GATHER ? (size_t)0 : (size_t)HALF * lda * 2;
    const unsigned ldsw = (unsigned)wid * 1024u;
    const int aoff = lds_byte(wr * 64 + fr, fq * 8), boff = lds_byte(wc * 32 + fr, fq * 8);
#define PG8_SA(b, h) (((b) * 2 + (h)) * HTB)
#define PG8_SB(b, h) ((4 + (b) * 2 + (h)) * HTB)
#define PG8_STAGE(bufoff, gbase, v0, v1) do { \
        __builtin_amdgcn_global_load_lds((const unsigned*)((const char*)(gbase) + (v0)), (LAS unsigned*)(lds + (bufoff) + ldsw), 16, 0, 0); \
        __builtin_amdgcn_global_load_lds((const unsigned*)((const char*)(gbase) + (v1)), (LAS unsigned*)(lds + (bufoff) + ldsw + 8192), 16, 0, 0); } while (0)
#define PG8_STB(bufoff, gbase) PG8_STAGE(bufoff, gbase, voffB[0], voffB[1])
#define PG8_STA(bufoff, gbase, h) PG8_STAGE(bufoff, (gbase) + (h) * hA, cv[Sched::GATHER ? (h) : 0][0], cv[Sched::GATHER ? (h) : 0][1])
#define PG8_LDA(dst, b, h) do { _Pragma("unroll") for (int m = 0; m < 4; ++m) _Pragma("unroll") for (int k = 0; k < 2; ++k) dst[m][k] = *(const LAS bf16x8*)(lds + PG8_SA(b, h) + aoff + m * 2048 + k * 1024); } while (0)
#define PG8_LDB(dst, b, h) do { _Pragma("unroll") for (int n = 0; n < 2; ++n) _Pragma("unroll") for (int k = 0; k < 2; ++k) dst[n][k] = *(const LAS bf16x8*)(lds + PG8_SB(b, h) + boff + n * 2048 + k * 1024); } while (0)
#define PG8_MMA(ai, bj, At, Bt) do { __builtin_amdgcn_s_setprio(1); _Pragma("unroll") for (int m = 0; m < 4; ++m) _Pragma("unroll") for (int n = 0; n < 2; ++n) _Pragma("unroll") for (int k = 0; k < 2; ++k) \
        acc[ai][bj][m][n] = __builtin_amdgcn_mfma_f32_16x16x32_bf16(Bt[n][k], At[m][k], acc[ai][bj][m][n], 0, 0, 0); __builtin_amdgcn_s_setprio(0); } while (0)
#define PG8_WAIT_V(n) asm volatile("s_waitcnt vmcnt(" #n ")" ::: "memory")
#define PG8_WAIT_L(n) asm volatile("s_waitcnt lgkmcnt(" #n ")" ::: "memory")
#define PG8_BAR __builtin_amdgcn_s_barrier()
#define PG8_SCHED __builtin_amdgcn_sched_barrier(0)
    Unit cur, nxt; int ui = 0;
    if (!S.next(0, cur)) return;
    Acc acc;
#pragma unroll
    for (int a = 0; a < 2; ++a)
#pragma unroll
        for (int b = 0; b < 2; ++b)
#pragma unroll
            for (int m = 0; m < 4; ++m)
#pragma unroll
                for (int n = 0; n < 2; ++n) acc[a][b][m][n] = (f32x4){0.f, 0.f, 0.f, 0.f};
    bf16x8 At[4][2], B0[2][2], B1[2][2];
    const char* cA; const char* cB; S.ptrs(cur, cA, cB);
    unsigned cv[2][2]; S.avoff(cur, sR, sC, cv);
    PG8_STB(PG8_SB(0, 0), cB); PG8_STB(PG8_SB(0, 1), cB + hB); PG8_STA(PG8_SA(0, 0), cA, 0); PG8_STA(PG8_SA(0, 1), cA, 1);
    if (wr == 1) PG8_BAR;
    PG8_WAIT_V(2); PG8_BAR;
    PG8_STB(PG8_SB(1, 0), cB + kstep); PG8_STA(PG8_SA(1, 0), cA + kstep, 0); PG8_STB(PG8_SB(1, 1), cB + hB + kstep);
    PG8_WAIT_V(6); PG8_BAR;
    for (;;) {
        const bool has_next = S.next(ui + 1, nxt);
        const char* nA = cA; const char* nB = cB;
        if (has_next) S.ptrs(nxt, nA, nB);
#pragma unroll 1
        for (int t = 0; t < nt; t += 2) {
            const bool last = (t == nt - 2);
            if constexpr (Epi::HAS_MID) { if (t == (nt >> 1)) E.mid(acc, cur, wr, wc, fr, fq); }
            unsigned nv[2][2];
            if (Sched::GATHER) { if (last && has_next) { S.avoff(nxt, sR, sC, nv); cv[0][0] = nv[0][0]; cv[0][1] = nv[0][1]; } }
            const char* a1 = cA + (size_t)(t + 1) * kstep;
            const char* a2 = last ? nA : cA + (size_t)(t + 2) * kstep; const char* b2 = last ? nB : cB + (size_t)(t + 2) * kstep;
            const char* a3 = a2 + kstep; const char* b3 = b2 + kstep;
            PG8_LDB(B0, 0, 0); PG8_LDB(B1, 0, 1); PG8_SCHED; PG8_LDA(At, 0, 0); PG8_STA(PG8_SA(1, 1), a1, 1);
            if (Sched::GATHER) { if (last && has_next) { cv[1][0] = nv[1][0]; cv[1][1] = nv[1][1]; } }
            PG8_WAIT_V(8); PG8_WAIT_L(0); PG8_BAR; PG8_MMA(0, 0, At, B0); PG8_MMA(0, 1, At, B1); PG8_BAR; PG8_SCHED;
            PG8_LDA(At, 0, 1); PG8_STB(PG8_SB(0, 0), b2); PG8_STB(PG8_SB(0, 1), b2 + hB); PG8_STA(PG8_SA(0, 0), a2, 0);
            PG8_WAIT_V(8); PG8_WAIT_L(0); PG8_BAR; PG8_MMA(1, 0, At, B0); PG8_MMA(1, 1, At, B1); PG8_BAR; PG8_SCHED;
            PG8_LDB(B0, 1, 0); PG8_LDB(B1, 1, 1); PG8_SCHED; PG8_LDA(At, 1, 0); PG8_STA(PG8_SA(0, 1), a2, 1);
            PG8_WAIT_V(8); PG8_WAIT_L(0); PG8_BAR; PG8_MMA(0, 0, At, B0); PG8_MMA(0, 1, At, B1); PG8_BAR; PG8_SCHED;
            PG8_LDA(At, 1, 1); PG8_STB(PG8_SB(1, 0), b3); PG8_STB(PG8_SB(1, 1), b3 + hB); PG8_STA(PG8_SA(1, 0), a3, 0);
            PG8_WAIT_V(8); PG8_WAIT_L(0); PG8_BAR; PG8_MMA(1, 0, At, B0); PG8_MMA(1, 1, At, B1); PG8_BAR; PG8_SCHED;
        }
        if constexpr (ALIGN_EPI) { if (wr == 0) PG8_BAR; }
        E(acc, cur, wr, wc, fr, fq);
        if (!has_next) break;
#pragma unroll
        for (int a = 0; a < 2; ++a)
#pragma unroll
            for (int b = 0; b < 2; ++b)
#pragma unroll
                for (int m = 0; m < 4; ++m)
#pragma unroll
                    for (int n = 0; n < 2; ++n) acc[a][b][m][n] = (f32x4){0.f, 0.f, 0.f, 0.f};
        cur = nxt; cA = nA; cB = nB; ++ui;
        if constexpr (ALIGN_EPI) { if (wr == 1) PG8_BAR; }
    }
    PG8_WAIT_V(0);
    if constexpr (!ALIGN_EPI) { if (wr == 0) PG8_BAR; }
    PG8_BAR;
#undef PG8_SA
#undef PG8_SB
#undef PG8_STAGE
#undef PG8_STA
#undef PG8_STB
#undef PG8_LDA
#undef PG8_LDB
#undef PG8_MMA
#undef PG8_WAIT_V
#undef PG8_WAIT_L
#undef PG8_BAR
#undef PG8_SCHED
}
}

#ifndef MK_USE_CG
#define MK_USE_CG 0
#endif
#define XB_TMO      128
#define XB_XCNT(j)  (256  + 64 * (j))
#define XB_XSUB(j)  (1280 + 64 * (j))
#define XB_XGEN(j)  (2304 + 64 * (j))
#define XB_TOP      3328
#define XB_TOPGEN   3392
#define XCD_BAR_WORDS 3456
#define XB_SPIN_CAP (1u << 18)
__device__ __forceinline__ unsigned xb_ld(unsigned* p)              { return __hip_atomic_load(p, __ATOMIC_RELAXED, __HIP_MEMORY_SCOPE_AGENT); }
__device__ __forceinline__ unsigned xb_add(unsigned* p, unsigned v) { return __hip_atomic_fetch_add(p, v, __ATOMIC_RELAXED, __HIP_MEMORY_SCOPE_AGENT); }
__device__ __forceinline__ unsigned xb_xcc_id() { return (unsigned)__builtin_amdgcn_s_getreg((3 << 11) | 20) & 0xFu; }
#define XB_SPIN(cond, bar) do { unsigned _sp = 0; while (cond) { __builtin_amdgcn_s_sleep(1); \
    if ((++_sp & 255u) == 0u) { if (xb_ld(&(bar)[XB_TMO])) break; if (_sp > XB_SPIN_CAP) { atomicAdd(&(bar)[XB_TMO], 1u); break; } } } } while (0)
struct XcdBarrier { unsigned* bar; unsigned x; volatile LAS unsigned* st; };
__device__ __forceinline__ XcdBarrier xcd_barrier_post(unsigned* bar, volatile LAS unsigned* st) {
    XcdBarrier b; b.bar = bar; b.x = xb_xcc_id(); b.st = st;
    if (threadIdx.x == 0) (void)xb_add(&bar[XB_XCNT(b.x)], 1u);
    return b;
}
__device__ __forceinline__ void xcd_barrier_complete(unsigned* bar, unsigned x, unsigned& nloc, unsigned& nx) {
    const unsigned G = gridDim.x * gridDim.y * gridDim.z;
    unsigned sum, cnt, mine, sp = 0u;
    for (;;) {
        sum = 0u; cnt = 0u; mine = 0u;
#pragma unroll
        for (unsigned j = 0; j < 16; ++j) { const unsigned c = xb_ld(&bar[XB_XCNT(j)]); sum += c; cnt += (c > 0u) ? 1u : 0u; mine = (j == x) ? c : mine; }
        if (sum == G) break;
        __builtin_amdgcn_s_sleep(1);
        if ((++sp & 255u) == 0u) { if (xb_ld(&bar[XB_TMO])) break; if (sp > XB_SPIN_CAP) { atomicAdd(&bar[XB_TMO], 1u); break; } }
    }
    nloc = mine > 0u ? mine : 1u; nx = cnt > 0u ? cnt : 1u;
}
__device__ __forceinline__ void xcd_barrier(const XcdBarrier& b) {
    asm volatile("s_waitcnt vmcnt(0)" ::: "memory");
    __syncthreads();
    if (threadIdx.x == 0) {
        unsigned* bar = b.bar;
        __builtin_amdgcn_s_waitcnt(0);
        unsigned nloc = b.st[0], nx = b.st[1];
        if (nloc == 0u) { xcd_barrier_complete(bar, b.x, nloc, nx); b.st[0] = nloc; b.st[1] = nx; }
        const unsigned old = xb_add(&bar[XB_XSUB(b.x)], 1u);
        const unsigned gen = old / nloc;
        if (old + 1u == (gen + 1u) * nloc) {
            __builtin_amdgcn_fence(__ATOMIC_RELEASE, "agent");
            asm volatile("s_waitcnt vmcnt(0)" ::: "memory");
            const unsigned og = xb_add(&bar[XB_TOP], 1u);
            const unsigned tg = og / nx;
            if (og + 1u == (tg + 1u) * nx) xb_add(&bar[XB_TOPGEN], 1u);
            else XB_SPIN(xb_ld(&bar[XB_TOPGEN]) == tg, bar);
            __builtin_amdgcn_fence(__ATOMIC_ACQUIRE, "agent");
            xb_add(&bar[XB_XGEN(b.x)], 1u);
            asm volatile("s_waitcnt vmcnt(0)" ::: "memory");
        } else {
            XB_SPIN(xb_ld(&bar[XB_XGEN(b.x)]) == gen, bar);
            __builtin_amdgcn_fence(__ATOMIC_ACQUIRE, "agent");
            asm volatile("s_waitcnt vmcnt(0)" ::: "memory");
        }
    }
    __syncthreads();
}

struct Args {
    const float* in[19]; float* out; unsigned char* ws; int ph_lo, ph_hi; int rep[10];
};
struct Frame {
    LAS unsigned char* lds; int tid, lane, wave, G, vcu;
};

__device__ __forceinline__ void tr_item(const float* W, int ldw, int k0, int n0, bf16_t* WT, int ldt, int drow0, LAS float* scr, int lane) {
    float tv[32];
#pragma unroll
    for (int i = 0; i < 32; ++i) { const int kk = 2 * i + (lane >> 5); tv[i] = W[(size_t)(k0 + kk) * ldw + n0 + (lane & 31)]; }
#pragma unroll
    for (int i = 0; i < 32; ++i) { const int kk = 2 * i + (lane >> 5); scr[kk * 33 + (lane & 31)] = tv[i]; }
    LDS_WAIT(); asm volatile("" ::: "memory");
    const int c = lane & 7;
#pragma unroll
    for (int j = 0; j < 4; ++j) { const int n = (lane >> 3) + 8 * j; const LAS float* s = scr + (8 * c) * 33 + n;
        u32x4 o; o.x = cvtpk(s[0 * 33], s[1 * 33]); o.y = cvtpk(s[2 * 33], s[3 * 33]); o.z = cvtpk(s[4 * 33], s[5 * 33]); o.w = cvtpk(s[6 * 33], s[7 * 33]);
        *(u32x4*)(WT + (size_t)(drow0 + n) * ldt + k0 + 8 * c) = o; }
    LDS_WAIT(); asm volatile("" ::: "memory");
}
__device__ __forceinline__ void p0_prologue(const Frame& F, const Args& a) {
    unsigned char* ws = a.ws;
    LAS float* scr = (LAS float*)(F.lds + F.wave * 16384);
    const int gw = F.vcu * NWAVES + F.wave, NGW = F.G * NWAVES;
    const float* w_in = a.in[2]; const float* w_a = a.in[8]; const float* w_c = a.in[9]; const float* w_out = a.in[10];
    const float* w_gate = a.in[16]; const float* w_up = a.in[17]; const float* w_down = a.in[18];
    bf16_t* WinT = (bf16_t*)(ws + WS_WIN); bf16_t* WaT = (bf16_t*)(ws + WS_WA); bf16_t* WcT = (bf16_t*)(ws + WS_WC); bf16_t* WoutT = (bf16_t*)(ws + WS_WOUT);
    bf16_t* WguT = (bf16_t*)(ws + WS_WGU); bf16_t* WdT = (bf16_t*)(ws + WS_WD);
    constexpr int I_IN = 16 * 136, I_A = 8 * 32, I_OUT = 16 * 32, I_G = 32 * 128, I_D = 32 * 128;
    constexpr int NITEMS = I_IN + 2 * I_A + I_OUT + 2 * I_G + I_D;
    for (int it = gw; it < NITEMS; it += NGW) {
        int r = it;
        if (r < I_IN) { const int kb = r / 136, nb = r % 136; tr_item(w_in, PW, 64 * kb, 32 * nb, WinT, 1024, 32 * nb, scr, F.lane); continue; } r -= I_IN;
        if (r < I_A) { const int kb = r / 32, nb = r % 32; tr_item(w_a, 1024, 64 * kb, 32 * nb, WaT, 1024, 32 * nb, scr, F.lane); continue; } r -= I_A;
        if (r < I_A) { const int kb = r / 32, nb = r % 32; tr_item(w_c, 1024, 64 * kb, 32 * nb, WaT + 512, 1024, 32 * nb, scr, F.lane); continue; } r -= I_A;
        if (r < I_OUT) { const int kb = r / 32, nb = r % 32; tr_item(w_out, 1024, 64 * kb, 32 * nb, WoutT, 1024, 32 * nb, scr, F.lane); continue; } r -= I_OUT;
        if (r < 2 * I_G) { const int up = r >= I_G; if (up) r -= I_G; const int e = r / 128, q = r % 128, kb = q / 8, nb = q % 8, n0 = 32 * nb;
            tr_item((up ? w_up : w_gate) + (size_t)e * 1024 * 256, 256, 64 * kb, n0, WguT + (size_t)e * 512 * 1024, 1024, (n0 >> 7) * 256 + up * 128 + (n0 & 127), scr, F.lane); continue; } r -= 2 * I_G;
        { const int e = r / 128, q = r % 128, kb = q / 32, nb = q % 32; tr_item(w_down + (size_t)e * 256 * 1024, 1024, 64 * kb, 32 * nb, WdT + (size_t)e * 1024 * 256, 256, 32 * nb, scr, F.lane); }
    }
    const int gt = F.vcu * NTHREADS + F.tid, NGT = F.G * NTHREADS;
    { const float* w_rg = a.in[12]; const float* w_re = a.in[14]; bf16_t* WrT = (bf16_t*)(ws + WS_WR);
      for (int i = gt; i < 48 * 1024; i += NGT) { const int j = i >> 10, k = i & 1023; float v = 0.f; if (j < 4) v = w_rg[k * 4 + j]; else if (j < 36) v = w_re[k * 32 + (j - 4)]; WrT[i] = f2bf(v); } }
    { float* cosT = (float*)(ws + WS_ROPE); float* sinT = cosT + SEQ * 8;
      for (int i = gt; i < SEQ * 8; i += NGT) { const int pos = i >> 3, j = i & 7; const float inv = (float)pow(500000.0, -(double)j / 8.0); const float ang = (float)pos * inv;
          cosT[i] = (float)cos((double)ang); sinT[i] = (float)sin((double)ang); } }
    { const float* x = a.in[0]; const float* g1 = a.in[1]; bf16_t* XN = (bf16_t*)(ws + WS_XN);
      f32x4 gv[4];
#pragma unroll
      for (int j = 0; j < 4; ++j) gv[j] = ((const f32x4*)g1)[F.lane + 64 * j];
      for (int m0 = gw; m0 < M; m0 += 4 * NGW) { f32x4 v[4][4];
#pragma unroll
          for (int q = 0; q < 4; ++q) { const int m = m0 + q * NGW; const f32x4* xr = (const f32x4*)(x + (size_t)(m < M ? m : 0) * D) + F.lane;
#pragma unroll
              for (int j = 0; j < 4; ++j) v[q][j] = xr[64 * j]; }
#pragma unroll
          for (int q = 0; q < 4; ++q) { const int m = m0 + q * NGW; float s = 0.f;
#pragma unroll
              for (int j = 0; j < 4; ++j) s += (v[q][j].x * v[q][j].x + v[q][j].y * v[q][j].y) + (v[q][j].z * v[q][j].z + v[q][j].w * v[q][j].w);
              const float rstd = rsqrtf(wave_sum(s) * (1.f / D) + EPS);
              if (m < M) { u32x2* o8 = (u32x2*)(XN + (size_t)m * D) + F.lane;
#pragma unroll
                  for (int j = 0; j < 4; ++j) { u32x2 w; w.x = cvtpk(v[q][j].x * rstd * gv[j].x, v[q][j].y * rstd * gv[j].y); w.y = cvtpk(v[q][j].z * rstd * gv[j].z, v[q][j].w * rstd * gv[j].w); o8[64 * j] = w; } } } } }
}

__device__ __forceinline__ u32x4 qk_norm_rope(const u32x4 raw, const float (&g)[8], const f32x4 c0, const f32x4 c1, const f32x4 s0, const f32x4 s1, int l7, float scale) {
    float v[8]; unpack8(raw, v); float ss = 0.f;
#pragma unroll
    for (int i = 0; i < 8; ++i) ss += v[i] * v[i];
    ss += __shfl_xor(ss, 1); ss += __shfl_xor(ss, 2); ss += __shfl_xor(ss, 4);
    const float rstd = rsqrtf(ss * (1.f / 64.f) + EPS);
    const float cc[8] = {c0.x, c0.y, c0.z, c0.w, c1.x, c1.y, c1.z, c1.w}, sn[8] = {s0.x, s0.y, s0.z, s0.w, s1.x, s1.y, s1.z, s1.w};
#pragma unroll
    for (int i = 0; i < 8; ++i) { float y = v[i] * rstd * g[i]; const float p = __shfl_xor(y, 1);
        if (l7 == 0) y = y * cc[i] - p * sn[i]; else if (l7 == 1) y = y * cc[i] + p * sn[i];
        v[i] = y * scale; }
    return pack8(v);
}
__device__ __forceinline__ void p2_prep_conv(const Frame& F, const Args& a) {
    unsigned char* ws = a.ws;
    const bf16_t* PROJ = (const bf16_t*)(ws + WS_PROJ); bf16_t* QN = (bf16_t*)(ws + WS_QN); bf16_t* KN = (bf16_t*)(ws + WS_KN); bf16_t* AC = (bf16_t*)(ws + WS_AC);
    const float* cosT = (const float*)(ws + WS_ROPE); const float* sinT = cosT + SEQ * 8;
    const float* qg = a.in[3]; const float* kg = a.in[4]; const float* conv_w = a.in[6]; const float* conv_b = a.in[7];
    const int gw = F.vcu * NWAVES + F.wave, NGW = F.G * NWAVES, lane = F.lane, l7 = lane & 7;
    float gq[8], gk[8];
#pragma unroll
    for (int k = 0; k < 8; ++k) { gq[k] = qg[8 * l7 + k]; gk[k] = kg[8 * l7 + k]; }
    float w0[8], w1[8], w2[8], bb[8];
#pragma unroll
    for (int k = 0; k < 8; ++k) { w0[k] = conv_w[8 * lane + k]; w1[k] = conv_w[CD + 8 * lane + k]; w2[k] = conv_w[2 * CD + 8 * lane + k]; bb[k] = conv_b[8 * lane + k]; }
    for (int ch = gw; ch < M / 16; ch += NGW) {
        const int t0 = ch * 16;
#pragma unroll 1
        for (int grp = 0; grp < 4; ++grp) { const int tb = t0 + 4 * grp;
            u32x4 qraw[4]; f32x4 qc[4][4];
#pragma unroll
            for (int tk = 0; tk < 4; ++tk) { const int t = tb + tk, pos = t & (SEQ - 1); qraw[tk] = *(const u32x4*)(PROJ + (size_t)t * PW + 8 * lane);
                qc[tk][0] = *(const f32x4*)(cosT + pos * 8); qc[tk][1] = *(const f32x4*)(cosT + pos * 8 + 4); qc[tk][2] = *(const f32x4*)(sinT + pos * 8); qc[tk][3] = *(const f32x4*)(sinT + pos * 8 + 4); }
            const int tkk = tb + (lane >> 4), kpos = tkk & (SEQ - 1);
            const u32x4 kraw = *(const u32x4*)(PROJ + (size_t)tkk * PW + C_K + 8 * (lane & 15));
            const f32x4 kc0 = *(const f32x4*)(cosT + kpos * 8), kc1 = *(const f32x4*)(cosT + kpos * 8 + 4), ks0 = *(const f32x4*)(sinT + kpos * 8), ks1 = *(const f32x4*)(sinT + kpos * 8 + 4);
#pragma unroll
            for (int tk = 0; tk < 4; ++tk) { const u32x4 o = qk_norm_rope(qraw[tk], gq, qc[tk][0], qc[tk][1], qc[tk][2], qc[tk][3], l7, QSCALE); *(u32x4*)(QN + (size_t)(tb + tk) * AD + 8 * lane) = o; }
            { const u32x4 o = qk_norm_rope(kraw, gk, kc0, kc1, ks0, ks1, l7, 1.0f); *(u32x4*)(KN + (size_t)tkk * 128 + 8 * (lane & 15)) = o; } }
        float up[8], uc[8];
        { float a8[8], b8[8];
          if ((t0 & (SEQ - 1)) > 0) { unpack8(*(const u32x4*)(PROJ + (size_t)(t0 - 1) * PW + C_CC + 8 * lane), a8); unpack8(*(const u32x4*)(PROJ + (size_t)(t0 - 1) * PW + C_CX + 8 * lane), b8);
#pragma unroll
              for (int k = 0; k < 8; ++k) up[k] = a8[k] * b8[k]; } else {
#pragma unroll
              for (int k = 0; k < 8; ++k) up[k] = 0.f; }
          unpack8(*(const u32x4*)(PROJ + (size_t)t0 * PW + C_CC + 8 * lane), a8); unpack8(*(const u32x4*)(PROJ + (size_t)t0 * PW + C_CX + 8 * lane), b8);
#pragma unroll
          for (int k = 0; k < 8; ++k) uc[k] = a8[k] * b8[k]; }
#pragma unroll 1
        for (int grp = 0; grp < 4; ++grp) { const int tb = t0 + 4 * grp;
            u32x4 rcc[4], rcx[4], rcb[4];
#pragma unroll
            for (int tk = 0; tk < 4; ++tk) { const int t = tb + tk; const bool hn = ((t & (SEQ - 1)) < SEQ - 1); const size_t tn = (size_t)(hn ? t + 1 : t);
                rcc[tk] = *(const u32x4*)(PROJ + tn * PW + C_CC + 8 * lane); rcx[tk] = *(const u32x4*)(PROJ + tn * PW + C_CX + 8 * lane); rcb[tk] = *(const u32x4*)(PROJ + (size_t)t * PW + C_CB + 8 * lane); }
#pragma unroll
            for (int tk = 0; tk < 4; ++tk) { const int t = tb + tk; const bool hn = ((t & (SEQ - 1)) < SEQ - 1);
                float a8[8], b8[8], cbv[8], un[8], o[8]; unpack8(rcc[tk], a8); unpack8(rcx[tk], b8); unpack8(rcb[tk], cbv);
#pragma unroll
                for (int k = 0; k < 8; ++k) { un[k] = hn ? a8[k] * b8[k] : 0.f; o[k] = cbv[k] * (up[k] * w0[k] + uc[k] * w1[k] + un[k] * w2[k] + bb[k]); up[k] = uc[k]; uc[k] = un[k]; }
                *(u32x4*)(AC + (size_t)t * 1024 + 512 + 8 * lane) = pack8(o); } }
    }
}

namespace att {
constexpr int NSLOT = 8, WSOFF = RING_BYTES + 1024, OSTOFF = WSOFF + 2048;
static_assert(OSTOFF + 8 * 2048 <= LDS_BYTES, "attention LDS map");
__device__ __forceinline__ int crow(int r, int hi) { return (r & 3) + 8 * (r >> 2) + 4 * hi; }
__device__ __forceinline__ s16x4 vtr(const LAS char* p) { return __builtin_bit_cast(s16x4, __builtin_amdgcn_ds_read_tr16_b64_v4i16((LAS s16x4*)p)); }
}
__device__ __forceinline__ u32x4 k_norm_rope(const u32x4 raw, const float (&g)[8], float cl, float sl, int l7, int lane) {
    float v[8]; unpack8(raw, v); float ss = 0.f;
#pragma unroll
    for (int i = 0; i < 8; ++i) ss += v[i] * v[i];
    ss += __shfl_xor(ss, 1); ss += __shfl_xor(ss, 2); ss += __shfl_xor(ss, 4);
    const float rstd = rsqrtf(ss * (1.f / 64.f) + EPS);
#pragma unroll
    for (int i = 0; i < 8; ++i) { float y = v[i] * rstd * g[i]; const float p = __shfl_xor(y, 1); const float c = __shfl(cl, (lane & ~7) + i), sn = __shfl(sl, (lane & ~7) + i);
        if (l7 == 0) y = y * c - p * sn; else if (l7 == 1) y = y * c + p * sn;
        v[i] = y; }
    return pack8(v);
}
__device__ __forceinline__ void conv8(const bf16_t* PROJ, bf16_t* AC, int tb, int lane, float (&up)[8], float (&uc)[8], const float* conv_w, const float* conv_b) {
    u32x4 rcc[8], rcx[8], rcb[8];
#pragma unroll
    for (int tk = 0; tk < 8; ++tk) { const int t = tb + tk; const bool hn = ((t & (SEQ - 1)) < SEQ - 1); const size_t tn = (size_t)(hn ? t + 1 : t);
        rcc[tk] = *(const u32x4*)(PROJ + tn * PW + C_CC + 8 * lane); rcx[tk] = *(const u32x4*)(PROJ + tn * PW + C_CX + 8 * lane); rcb[tk] = *(const u32x4*)(PROJ + (size_t)t * PW + C_CB + 8 * lane); }
    float w0[8], w1[8], w2[8], bb[8];
#pragma unroll
    for (int k = 0; k < 8; ++k) { w0[k] = conv_w[8 * lane + k]; w1[k] = conv_w[CD + 8 * lane + k]; w2[k] = conv_w[2 * CD + 8 * lane + k]; bb[k] = conv_b[8 * lane + k]; }
#pragma unroll
    for (int tk = 0; tk < 8; ++tk) { const int t = tb + tk; const bool hn = ((t & (SEQ - 1)) < SEQ - 1);
        float a8[8], b8[8], cbv[8], un[8], o[8]; unpack8(rcc[tk], a8); unpack8(rcx[tk], b8); unpack8(rcb[tk], cbv);
#pragma unroll
        for (int k = 0; k < 8; ++k) { un[k] = hn ? a8[k] * b8[k] : 0.f; o[k] = cbv[k] * (up[k] * w0[k] + uc[k] * w1[k] + un[k] * w2[k] + bb[k]); up[k] = uc[k]; uc[k] = un[k]; }
        *(u32x4*)(AC + (size_t)t * 1024 + 512 + 8 * lane) = pack8(o); }
}
__device__ __forceinline__ void p3_attention(const Frame& F, const Args& a) {
    using namespace att;
    unsigned char* ws = a.ws;
    const bf16_t* PROJ = (const bf16_t*)(ws + WS_PROJ); bf16_t* AC = (bf16_t*)(ws + WS_AC);
    const float* cosT = (const float*)(ws + WS_ROPE); const float* sinT = cosT + SEQ * 8;
    const float* qg = a.in[3]; const float* kg = a.in[4]; const float* sink = a.in[5];
    const int lane = F.lane, wid = F.wave, r32 = lane & 31, hi = lane >> 5, l7 = lane & 7;
    const float bound = 8.0f * wave_max(fabsf(qg[lane])) * wave_max(fabsf(kg[lane])) * 1.4426950408889634f * 1.0001f;
    LAS char* lds = (LAS char*)F.lds; LAS float* wsf = (LAS float*)(lds + WSOFF) + wid * 64;
    const int g = wid >> 1, qsub = wid & 1;
    float gk8[8];
#pragma unroll
    for (int k = 0; k < 8; ++k) gk8[k] = kg[8 * l7 + k];
    for (int su = F.vcu; su < NB * NKV * 16; su += F.G) {
        const int n0 = (su & 15) * 4, hk = (su >> 4) & 1, b = su >> 5;
        const int h = hk * 4 + g; const float snk = sink[h] * 1.4426950408889634f; const float mref = fmaxf(bound, snk);
        const size_t rowbase = (size_t)b * SEQ;
        __syncthreads();
        { u32x4 kraw[NSLOT], vraw[NSLOT]; float kcs[NSLOT][2];
#pragma unroll
          for (int sl = 0; sl < NSLOT; ++sl) { const int j = n0 - 2 + sl; const bool ok = (j >= 0 && j < 64); const int jj = ok ? j : n0;
              const int key = 8 * wid + (lane >> 3), pos = 64 * jj + key;
              kraw[sl] = *(const u32x4*)(PROJ + (rowbase + pos) * PW + C_K + hk * 64 + l7 * 8);
              kcs[sl][0] = cosT[pos * 8 + l7]; kcs[sl][1] = sinT[pos * 8 + l7];
              vraw[sl] = *(const u32x4*)(PROJ + (rowbase + 64 * jj + 16 * (wid & 3) + (lane >> 2)) * PW + C_V + hk * 64 + (wid >> 2) * 32 + (lane & 3) * 8); }
#pragma unroll
          for (int sl = 0; sl < NSLOT; ++sl) { const int key = 8 * wid + (lane >> 3);
              const u32x4 kn = k_norm_rope(kraw[sl], gk8, kcs[sl][0], kcs[sl][1], l7, lane);
              *(LAS u32x4*)(lds + sl * 16384 + l7 * 1024 + key * 16) = kn;
              *(LAS u32x4*)(lds + sl * 16384 + 8192 + wid * 1024 + lane * 16) = vraw[sl]; } }
        __syncthreads();
#pragma unroll 1
        for (int uu = 0; uu < 4; ++uu) {
        const int n64 = n0 + uu;
        const int qs = n64 * 64 + qsub * 32;
        bf16x8 qr[4];
        { float qv[4][8]; float ss = 0.f; const int pos = qs + r32;
#pragma unroll
          for (int d0 = 0; d0 < 4; ++d0) { const u32x4 raw = *(const u32x4*)(PROJ + (rowbase + pos) * PW + C_Q + h * 64 + d0 * 16 + hi * 8); unpack8(raw, qv[d0]); }
          const f32x4 c0 = *(const f32x4*)(cosT + pos * 8), c1 = *(const f32x4*)(cosT + pos * 8 + 4), s0 = *(const f32x4*)(sinT + pos * 8), s1 = *(const f32x4*)(sinT + pos * 8 + 4);
#pragma unroll
          for (int d0 = 0; d0 < 4; ++d0)
#pragma unroll
              for (int k = 0; k < 8; ++k) ss += qv[d0][k] * qv[d0][k];
          ss += __shfl_xor(ss, 32);
          const float rstd = rsqrtf(ss * (1.f / 64.f) + EPS);
#pragma unroll
          for (int d0 = 0; d0 < 4; ++d0) { const f32x4 ga = *(const f32x4*)(qg + d0 * 16 + hi * 8), gb = *(const f32x4*)(qg + d0 * 16 + hi * 8 + 4); const float gg[8] = {ga.x, ga.y, ga.z, ga.w, gb.x, gb.y, gb.z, gb.w};
#pragma unroll
              for (int k = 0; k < 8; ++k) qv[d0][k] = qv[d0][k] * rstd * gg[k]; }
          const float cc[8] = {c0.x, c0.y, c0.z, c0.w, c1.x, c1.y, c1.z, c1.w}, sn[8] = {s0.x, s0.y, s0.z, s0.w, s1.x, s1.y, s1.z, s1.w};
#pragma unroll
          for (int k = 0; k < 8; ++k) { const float y = qv[0][k], p = __shfl_xor(y, 32); qv[0][k] = (hi == 0) ? (y * cc[k] - p * sn[k]) : (y * cc[k] + p * sn[k]); }
#pragma unroll
          for (int d0 = 0; d0 < 4; ++d0) {
#pragma unroll
              for (int k = 0; k < 8; ++k) qv[d0][k] *= QSCALE;
              qr[d0] = __builtin_bit_cast(bf16x8, pack8(qv[d0])); } }
        f32x16 o0 = {}, o1 = {}; float lsum = 0.f;
        const int qi = qs + r32;
#pragma unroll 1
        for (int sl = 0; sl < 5; ++sl) { const int j = n64 - 2 + sl; if (j < 0 || j >= 64) continue;
            const LAS char* tile = lds + (uu + sl) * 16384;
            const LAS char* kb = tile + hi * 1024 + r32 * 16;
            f32x16 p0 = {}, p1 = {};
#pragma unroll
            for (int d0 = 0; d0 < 4; ++d0) { const bf16x8 b0 = *(const LAS bf16x8*)(kb + d0 * 2048), b1 = *(const LAS bf16x8*)(kb + d0 * 2048 + 512);
                p0 = __builtin_amdgcn_mfma_f32_32x32x16_bf16(b0, qr[d0], p0, 0, 0, 0); p1 = __builtin_amdgcn_mfma_f32_32x32x16_bf16(b1, qr[d0], p1, 0, 0, 0); }
            if (sl == 0 || sl == 4) {
                const int kb0 = 64 * j + 4 * hi;
#pragma unroll
                for (int r = 0; r < 16; ++r) { const int kk = kb0 + (r & 3) + 8 * (r >> 2); const int d0_ = qi - kk, d1_ = qi - (kk + 32);
                    const bool v0 = (d0_ <= 128) && (d0_ >= -128), v1 = (d1_ <= 128) && (d1_ >= -128);
                    p0[r] = v0 ? __builtin_amdgcn_exp2f(p0[r] - mref) : 0.f; p1[r] = v1 ? __builtin_amdgcn_exp2f(p1[r] - mref) : 0.f; lsum += p0[r] + p1[r]; }
            } else {
#pragma unroll
                for (int r = 0; r < 16; ++r) { p0[r] = __builtin_amdgcn_exp2f(p0[r] - mref); p1[r] = __builtin_amdgcn_exp2f(p1[r] - mref); lsum += p0[r] + p1[r]; }
            }
            u32x4 pw0, pw1, pw2, pw3;
            pw0 = (u32x4){cvtpk(p0[0], p0[1]), cvtpk(p0[2], p0[3]), cvtpk(p0[4], p0[5]), cvtpk(p0[6], p0[7])};
            pw1 = (u32x4){cvtpk(p0[8], p0[9]), cvtpk(p0[10], p0[11]), cvtpk(p0[12], p0[13]), cvtpk(p0[14], p0[15])};
            pw2 = (u32x4){cvtpk(p1[0], p1[1]), cvtpk(p1[2], p1[3]), cvtpk(p1[4], p1[5]), cvtpk(p1[6], p1[7])};
            pw3 = (u32x4){cvtpk(p1[8], p1[9]), cvtpk(p1[10], p1[11]), cvtpk(p1[12], p1[13]), cvtpk(p1[14], p1[15])};
            const LAS char* vp = tile + 8192 + ((lane >> 4) & 1) * 32 + (lane & 3) * 8 + (4 * hi + ((lane & 15) >> 2)) * 64;
#pragma unroll
            for (int dh = 0; dh < 2; ++dh) {
#pragma unroll
                for (int ks = 0; ks < 4; ++ks) { const s16x4 lo = vtr(vp + dh * 4096 + ks * 1024), hh = vtr(vp + dh * 4096 + ks * 1024 + 512);
                    const bf16x8 vf = (bf16x8){lo[0], lo[1], lo[2], lo[3], hh[0], hh[1], hh[2], hh[3]};
                    const u32x4 pw = ks == 0 ? pw0 : ks == 1 ? pw1 : ks == 2 ? pw2 : pw3;
                    if (dh == 0) o0 = __builtin_amdgcn_mfma_f32_32x32x16_bf16(__builtin_bit_cast(bf16x8, pw), vf, o0, 0, 0, 0);
                    else o1 = __builtin_amdgcn_mfma_f32_32x32x16_bf16(__builtin_bit_cast(bf16x8, pw), vf, o1, 0, 0, 0); } }
        }
        lsum += __shfl_xor(lsum, 32); lsum += __builtin_amdgcn_exp2f(snk - mref);
        if (hi == 0) wsf[r32] = lsum;
        LDS_WAIT(); asm volatile("" ::: "memory");
        float rl[16];
#pragma unroll
        for (int r = 0; r < 16; ++r) rl[r] = __builtin_amdgcn_rcpf(wsf[crow(r, hi)]);
        LAS bf16_t* stg = (LAS bf16_t*)(lds + OSTOFF) + wid * 1024;
        bf16_t* Ow = AC + (rowbase + qs) * 1024 + h * 64;
#pragma unroll
        for (int dh = 0; dh < 2; ++dh) {
#pragma unroll
            for (int r = 0; r < 16; ++r) stg[crow(r, hi) * 32 + r32] = f2bf((dh ? o1[r] : o0[r]) * rl[r]);
            LDS_WAIT(); asm volatile("" ::: "memory");
#pragma unroll
            for (int i = 0; i < 2; ++i) { const int row = i * 16 + (lane >> 2), ch = lane & 3; const u32x4 v = *(const LAS u32x4*)(stg + row * 32 + ch * 8); *(u32x4*)(Ow + (size_t)row * 1024 + dh * 32 + ch * 8) = v; }
            LDS_WAIT(); asm volatile("" ::: "memory"); }
        }
    }
    __syncthreads();
    { const float* conv_w = a.in[6]; const float* conv_b = a.in[7];
      const int gw = F.vcu * NWAVES + wid, NGW = F.G * NWAVES;
      for (int ch = gw; ch < M / 16; ch += NGW) { const int t0 = ch * 16; float up[8], uc[8];
          { float a8[8], b8[8];
            if ((t0 & (SEQ - 1)) > 0) { unpack8(*(const u32x4*)(PROJ + (size_t)(t0 - 1) * PW + C_CC + 8 * lane), a8); unpack8(*(const u32x4*)(PROJ + (size_t)(t0 - 1) * PW + C_CX + 8 * lane), b8);
#pragma unroll
                for (int k = 0; k < 8; ++k) up[k] = a8[k] * b8[k]; } else {
#pragma unroll
                for (int k = 0; k < 8; ++k) up[k] = 0.f; }
            unpack8(*(const u32x4*)(PROJ + (size_t)t0 * PW + C_CC + 8 * lane), a8); unpack8(*(const u32x4*)(PROJ + (size_t)t0 * PW + C_CX + 8 * lane), b8);
#pragma unroll
            for (int k = 0; k < 8; ++k) uc[k] = a8[k] * b8[k]; }
          conv8(PROJ, AC, t0, lane, up, uc, conv_w, conv_b); conv8(PROJ, AC, t0 + 8, lane, up, uc, conv_w, conv_b); } }
    __syncthreads();
}

__device__ __forceinline__ void p6_route(const Frame& F, const Args& a) {
    unsigned char* ws = a.ws;
    const float* X1 = a.out; const float* g2 = a.in[11]; const float* b_rg = a.in[13]; const float* b_re = a.in[15];
    bf16_t* H2 = (bf16_t*)(ws + WS_H2); const bf16_t* WrT = (const bf16_t*)(ws + WS_WR);
    int* asg = (int*)(ws + WS_ASG); f32x2* rsg = (f32x2*)(ws + WS_RSG); unsigned* gcnt = (unsigned*)(ws + WS_CTL) + CW_CNT;
    const int lane = F.lane, wid = F.wave, r = lane & 15, kg = lane >> 4;
    constexpr int WR_PITCH = 2064, WR_BYTES = 48 * WR_PITCH, G2_OFF = WR_BYTES, LG_OFF = G2_OFF + 4096;
    LAS unsigned char* wrl = F.lds; LAS float* g2l = (LAS float*)(F.lds + G2_OFF); LAS float* lg = (LAS float*)(F.lds + LG_OFF) + wid * (16 * 48);
    LAS int* hist = (LAS int*)(F.lds + LDSCTL_OFF + LC_HIST); LAS int* base = (LAS int*)(F.lds + LDSCTL_OFF + LC_BASE);
    for (int i = F.tid; i < 48 * 128; i += NTHREADS) { const int row = i >> 7, c = i & 127; *(LAS u32x4*)(wrl + row * WR_PITCH + c * 16) = *(const u32x4*)(WrT + (size_t)row * D + c * 8); }
    for (int i = F.tid; i < 256; i += NTHREADS) *(LAS f32x4*)(g2l + 4 * i) = *(const f32x4*)(g2 + 4 * i);
    const int nblk = M / 128;
    for (int blk = F.vcu; blk < nblk; blk += F.G) {
        if (F.tid < 32) hist[F.tid] = 0;
        __syncthreads();
        const int row0 = blk * 128 + wid * 16;
        f32x4 acc[3] = {{0.f, 0.f, 0.f, 0.f}, {0.f, 0.f, 0.f, 0.f}, {0.f, 0.f, 0.f, 0.f}}; float ss = 0.f;
        const float* xr = X1 + (size_t)(row0 + r) * D + 8 * kg; bf16_t* hr = H2 + (size_t)(row0 + r) * D + 8 * kg;
        const LAS unsigned char* wb = wrl + r * WR_PITCH + 16 * kg; const LAS float* gl = g2l + 8 * kg;
#pragma unroll 1
        for (int s0 = 0; s0 < 32; s0 += 8) { f32x4 xv[8][2];
#pragma unroll
            for (int q = 0; q < 8; ++q) { xv[q][0] = *(const f32x4*)(xr + 32 * (s0 + q)); xv[q][1] = *(const f32x4*)(xr + 32 * (s0 + q) + 4); }
#pragma unroll
            for (int q = 0; q < 8; ++q) { const int s = s0 + q; const f32x4 x0 = xv[q][0], x1 = xv[q][1];
                const f32x4 ga = *(const LAS f32x4*)(gl + 32 * s), gb = *(const LAS f32x4*)(gl + 32 * s + 4);
                ss += (x0.x * x0.x + x0.y * x0.y) + (x0.z * x0.z + x0.w * x0.w) + (x1.x * x1.x + x1.y * x1.y) + (x1.z * x1.z + x1.w * x1.w);
                u32x4 w; w.x = cvtpk(x0.x * ga.x, x0.y * ga.y); w.y = cvtpk(x0.z * ga.z, x0.w * ga.w); w.z = cvtpk(x1.x * gb.x, x1.y * gb.y); w.w = cvtpk(x1.z * gb.z, x1.w * gb.w);
                *(u32x4*)(hr + 32 * s) = w; const bf16x8 af = __builtin_bit_cast(bf16x8, w);
#pragma unroll
                for (int j = 0; j < 3; ++j) { const bf16x8 bfr = *(const LAS bf16x8*)(wb + 16 * j * WR_PITCH + 64 * s); acc[j] = __builtin_amdgcn_mfma_f32_16x16x32_bf16(af, bfr, acc[j], 0, 0, 0); } } }
        ss += __shfl_xor(ss, 16); ss += __shfl_xor(ss, 32);
        const float rstd = rsqrtf(ss * (1.f / D) + EPS);
#pragma unroll
        for (int j = 0; j < 3; ++j)
#pragma unroll
            for (int i = 0; i < 4; ++i) lg[(4 * kg + i) * 48 + 16 * j + r] = acc[j][i];
        LDS_WAIT(); asm volatile("" ::: "memory");
        int e0 = 0, e1 = 0, rk0 = 0, rk1 = 0; float gt0 = 0.f, gt1 = 0.f;
        if (lane < 16) {
            const LAS float* L = lg + lane * 48;
            float gl4[4]; int grp = 0; float gm;
#pragma unroll
            for (int i = 0; i < 4; ++i) gl4[i] = L[i] * rstd + b_rg[i];
            gm = gl4[0];
#pragma unroll
            for (int i = 1; i < 4; ++i) if (gl4[i] > gm) { gm = gl4[i]; grp = i; }
            float gs = 0.f;
#pragma unroll
            for (int i = 0; i < 4; ++i) gs += __expf(gl4[i] - gm);
            const float pg = 1.0f / gs;
            float el[8];
#pragma unroll
            for (int i = 0; i < 8; ++i) el[i] = L[4 + grp * 8 + i] * rstd + b_re[grp * 8 + i];
            int i0 = 0; float m0 = el[0];
#pragma unroll
            for (int i = 1; i < 8; ++i) if (el[i] > m0) { m0 = el[i]; i0 = i; }
            int i1 = -1; float m1 = -3.0e38f;
#pragma unroll
            for (int i = 0; i < 8; ++i) if (i != i0 && el[i] > m1) { m1 = el[i]; i1 = i; }
            const float ex1 = __expf(m1 - m0); const float den = 1.0f / (1.0f + ex1);
            gt0 = pg * den; gt1 = pg * ex1 * den; e0 = grp * 8 + i0; e1 = grp * 8 + i1;
            rk0 = __hip_atomic_fetch_add(&hist[e0], 1, __ATOMIC_RELAXED, __HIP_MEMORY_SCOPE_WORKGROUP);
            rk1 = __hip_atomic_fetch_add(&hist[e1], 1, __ATOMIC_RELAXED, __HIP_MEMORY_SCOPE_WORKGROUP);
        }
        __syncthreads();
        if (F.tid < 32) { const int n = hist[F.tid]; int bs = 0; if (n > 0) bs = (int)__hip_atomic_fetch_add(gcnt + F.tid, (unsigned)n, __ATOMIC_RELAXED, __HIP_MEMORY_SCOPE_AGENT); base[F.tid] = bs; }
        __syncthreads();
        if (lane < 16) { const int tok = row0 + lane;
            const size_t p0 = (size_t)e0 * CAP + base[e0] + rk0, p1 = (size_t)e1 * CAP + base[e1] + rk1;
            asg[p0] = tok * 2; asg[p1] = tok * 2 + 1; rsg[p0] = (f32x2){gt0, rstd}; rsg[p1] = (f32x2){gt1, rstd}; }
        __syncthreads();
    }
}

__device__ __forceinline__ void moe_tables(const Frame& F, const Args& a) {
    const unsigned* gcnt = (const unsigned*)(a.ws + WS_CTL) + CW_CNT;
    LAS int* mtpre = (LAS int*)(F.lds + LDSCTL_OFF + LC_MTPRE); LAS int* cnt = (LAS int*)(F.lds + LDSCTL_OFF + LC_CNT);
    __syncthreads();
    if (F.tid == 0) { int acc = 0; for (int e = 0; e < 32; ++e) { const int n = (int)__hip_atomic_load(gcnt + e, __ATOMIC_RELAXED, __HIP_MEMORY_SCOPE_AGENT); cnt[e] = n; mtpre[e] = acc; acc += (n + 255) >> 8; } mtpre[32] = acc; }
    __syncthreads();
}

__device__ __forceinline__ void p9_combine(const Frame& F, const Args& a, bool dummy = false) {
    float* out = a.out; float* lo_dst = dummy ? (float*)(a.ws + WS_AC) : a.out; float* hi_dst = dummy ? (float*)(a.ws + WS_MERGED) - (size_t)(M / 2) * D : a.out; const bf16_t* Y = (const bf16_t*)(a.ws + WS_Y);
    const unsigned gt = (unsigned)F.vcu * NTHREADS + F.tid, NGT = (unsigned)F.G * NTHREADS, TOT = (unsigned)M * 128u;
    for (unsigned i0 = gt; i0 < TOT; i0 += 4 * NGT) {
        f32x4 xa[4], xb[4]; u32x4 y0[4], y1[4];
#pragma unroll
        for (int k = 0; k < 4; ++k) { const unsigned i = i0 + k * NGT, ii = i < TOT ? i : gt; const size_t tok = ii >> 7, c8 = (ii & 127) * 8;
            xa[k] = *(const f32x4*)(out + tok * D + c8); xb[k] = *(const f32x4*)(out + tok * D + c8 + 4);
            y0[k] = *(const u32x4*)(Y + (tok * 2) * D + c8); y1[k] = *(const u32x4*)(Y + (tok * 2 + 1) * D + c8); }
#pragma unroll
        for (int k = 0; k < 4; ++k) { const unsigned i = i0 + k * NGT; if (i < TOT) { const size_t tok = i >> 7, c8 = (i & 127) * 8; f32x4 x0 = xa[k], x1 = xb[k];
            x0.x += bflo(y0[k].x) + bflo(y1[k].x); x0.y += bfhi(y0[k].x) + bfhi(y1[k].x); x0.z += bflo(y0[k].y) + bflo(y1[k].y); x0.w += bfhi(y0[k].y) + bfhi(y1[k].y);
            x1.x += bflo(y0[k].z) + bflo(y1[k].z); x1.y += bfhi(y0[k].z) + bfhi(y1[k].z); x1.z += bflo(y0[k].w) + bflo(y1[k].w); x1.w += bfhi(y0[k].w) + bfhi(y1[k].w);
            float* dst = (tok < (size_t)(M / 2)) ? lo_dst : hi_dst; *(f32x4*)(dst + tok * D + c8) = x0; *(f32x4*)(dst + tok * D + c8 + 4) = x1; } }
    }
}

constexpr int N_PHASES = 10;
__global__ void __launch_bounds__(NTHREADS, 2) fwd_kernel(Args args) {
    extern __shared__ __attribute__((aligned(16))) unsigned char lds_raw[];
    Frame F; F.lds = (LAS unsigned char*)lds_raw; F.tid = threadIdx.x; F.lane = F.tid & 63; F.wave = __builtin_amdgcn_readfirstlane(F.tid >> 6);
    F.G = gridDim.x; { const int bx = blockIdx.x; F.vcu = (F.G % 8 == 0) ? (bx % 8) * (F.G / 8) + bx / 8 : bx; }
    for (int u = F.tid; u < (LDS_BYTES - LDSCTL_OFF) / 4; u += NTHREADS) ((LAS unsigned*)(F.lds + LDSCTL_OFF))[u] = 0u;
    __syncthreads();
    unsigned char* ws = args.ws;
    const int lo = args.ph_lo, hi = args.ph_hi;
#ifndef PH_MASK
#define PH_MASK 0x3ff
#endif
#define IN(k) (((PH_MASK >> (k)) & 1) && lo <= (k) && (k) < hi)
#if MK_USE_CG
#define GRID_BAR(k) do { if (IN(k) && IN((k) + 1)) { cg::this_grid().sync(); } } while (0)
#else
    XcdBarrier bar; bar.bar = (unsigned*)(ws + WS_CTL) + CW_BAR; bar.x = 0; bar.st = nullptr;
    if (hi - lo > 1) bar = xcd_barrier_post((unsigned*)(ws + WS_CTL) + CW_BAR, (volatile LAS unsigned*)(F.lds + LDSCTL_OFF + LC_MISC) + 8);
#define GRID_BAR(k) do { if (IN(k) && IN((k) + 1)) { xcd_barrier(bar); } } while (0)
#endif
    const LAS int* mtpre = (const LAS int*)(F.lds + LDSCTL_OFF + LC_MTPRE); const LAS int* lcnt = (const LAS int*)(F.lds + LDSCTL_OFF + LC_CNT);

#define REP(k) for (int rep_ = 0; rep_ < args.rep[k]; ++rep_)
#define REPBAR() do { if (rep_) xcd_barrier(bar); } while (0)
    if (IN(0)) REP(0) { REPBAR(); p0_prologue(F, args); } GRID_BAR(0);
    if (IN(1)) REP(1) { REPBAR(); pg8::PlainOrder S{(const bf16_t*)(ws + WS_XN), (const bf16_t*)(ws + WS_WIN), 1024, 1024, M / 256, PW / 256, F.G, (int)blockIdx.x};
        pg8::EpiProj E{(bf16_t*)(ws + WS_PROJ)};
        pg8::gemm_phase<pg8::EpiProj, pg8::PlainOrder, true>(F.lds, 1024, 1024, 1024, S, E); } GRID_BAR(1);
    if (IN(3)) REP(3) { REPBAR(); p3_attention(F, args); } GRID_BAR(3);
    if (IN(4)) REP(4) { REPBAR(); pg8::PlainOrder S{(const bf16_t*)(ws + WS_AC), (const bf16_t*)(ws + WS_WA), 1024, 1024, M / 256, D / 256, F.G, (int)blockIdx.x};
        pg8::EpiGate2 E{(const bf16_t*)(ws + WS_PROJ), (bf16_t*)(ws + WS_MERGED)};
        pg8::gemm_phase<pg8::EpiGate2, pg8::PlainOrder, true>(F.lds, 1024, 1024, 1024, S, E); } GRID_BAR(4);
    if (IN(5)) REP(5) { REPBAR(); pg8::PlainOrder S{(const bf16_t*)(ws + WS_MERGED), (const bf16_t*)(ws + WS_WOUT), 1024, 1024, M / 256, D / 256, F.G, (int)blockIdx.x};
        pg8::EpiRes E{args.in[0], args.out};
        pg8::gemm_phase<pg8::EpiRes, pg8::PlainOrder, true>(F.lds, 1024, 1024, 1024, S, E); } GRID_BAR(5);
    if (IN(6)) REP(6) { if (rep_) { xcd_barrier(bar); if (blockIdx.x == 0 && F.tid < 32) ((unsigned*)(ws + WS_CTL) + CW_CNT)[F.tid] = 0u; xcd_barrier(bar); } p6_route(F, args); } GRID_BAR(6);
    if (IN(7)) REP(7) { REPBAR(); moe_tables(F, args);
        pg8::MoeGuOrder S; S.mtpre = mtpre; S.cnt = lcnt; S.NT = 2; S.G = F.G; S.c = (int)blockIdx.x; S.H2 = (const bf16_t*)(ws + WS_H2); S.Wgu = (const bf16_t*)(ws + WS_WGU); S.asg = (const int*)(ws + WS_ASG);
        pg8::EpiGU E{(bf16_t*)(ws + WS_HID), (const f32x2*)(ws + WS_RSG), mtpre};
        pg8::gemm_phase<pg8::EpiGU, pg8::MoeGuOrder, true>(F.lds, 1024, 1024, 1024, S, E); } GRID_BAR(7);
    if (IN(8)) REP(8) { REPBAR(); moe_tables(F, args);
        pg8::MoeDownOrder S; S.mtpre = mtpre; S.cnt = lcnt; S.NT = 4; S.G = F.G; S.c = (int)blockIdx.x; S.HID = (const bf16_t*)(ws + WS_HID); S.Wd = (const bf16_t*)(ws + WS_WD);
        pg8::EpiDown E{(bf16_t*)(ws + WS_Y), (const int*)(ws + WS_ASG), (const f32x2*)(ws + WS_RSG), mtpre};
        pg8::gemm_phase<pg8::EpiDown, pg8::MoeDownOrder, true>(F.lds, 256, 256, 256, S, E); } GRID_BAR(8);
    if (IN(9)) { if (args.rep[9] > 1) { p9_combine(F, args, true); xcd_barrier(bar); } p9_combine(F, args); }
#undef IN
#undef GRID_BAR
}

extern "C" void kernel_launch(void* const* d_in, const int* in_sizes, int n_in, void* d_out, int out_size, void* d_ws, size_t ws_size, hipStream_t stream) {
    static int grid = 0;
    if (grid == 0) {
        if (n_in != 19 || in_sizes[0] != M * D || out_size != M * D || ws_size < WS_END) { fprintf(stderr, "kernel_launch: unexpected shapes (n_in %d, in0 %d, out %d, ws %zu)\n", n_in, n_in > 0 ? in_sizes[0] : -1, out_size, ws_size); grid = -1; return; }
        int dev = 0, cus = 0, per_cu = 0;
        if (hipGetDevice(&dev) != hipSuccess || hipDeviceGetAttribute(&cus, hipDeviceAttributeMultiprocessorCount, dev) != hipSuccess) { grid = -1; return; }
        if (hipFuncSetAttribute((const void*)fwd_kernel, hipFuncAttributeMaxDynamicSharedMemorySize, LDS_BYTES) != hipSuccess) { fprintf(stderr, "kernel_launch: hipFuncSetAttribute failed\n"); grid = -1; return; }
        if (hipOccupancyMaxActiveBlocksPerMultiprocessor(&per_cu, (const void*)fwd_kernel, NTHREADS, LDS_BYTES) != hipSuccess || per_cu < 1) { fprintf(stderr, "kernel_launch: occupancy query says %d\n", per_cu); per_cu = 1; }
        (void)hipGetLastError();
        grid = cus * 1;
        fprintf(stderr, "kernel_launch: cus %d per_cu %d grid %d\n", cus, per_cu, grid);
    }
    if (grid < 0) return;
    (void)hipMemsetAsync((char*)d_ws + WS_CTL, 0, CTL_ZERO_BYTES, stream);
    Args a{};
    for (int i = 0; i < 19; ++i) a.in[i] = (const float*)d_in[i];
    a.out = (float*)d_out; a.ws = (unsigned char*)d_ws;
    for (int i = 0; i < 10; ++i) a.rep[i] = (i == PROBE_DUP) ? 2 : 1;
#if MK_N_LAUNCHES == 1
    a.ph_lo = 0; a.ph_hi = N_PHASES;
    void* kargs[] = {&a};
#if MK_USE_CG
    hipError_t e = hipLaunchCooperativeKernel((const void*)fwd_kernel, dim3(grid), dim3(NTHREADS), kargs, LDS_BYTES, stream);
    if (e != hipSuccess) fprintf(stderr, "kernel_launch: cooperative launch failed: %s\n", hipGetErrorString(e));
#else
    (void)kargs; hipLaunchKernelGGL(fwd_kernel, dim3(grid), dim3(NTHREADS), LDS_BYTES, stream, a);
#endif
#else
    for (int p = 0; p < N_PHASES; ++p) { a.ph_lo = p; a.ph_hi = p + 1; hipLaunchKernelGGL(fwd_kernel, dim3(grid), dim3(NTHREADS), LDS_BYTES, stream, a); }
#endif
}
```

```cpp
#include <hip/hip_runtime.h>
#include <hip/hip_cooperative_groups.h>
#include <cstdio>
#include <cstdint>
namespace cg = cooperative_groups;

#ifndef PROBE_DUP
#define PROBE_DUP -1
#endif
#ifndef MK_N_LAUNCHES
#define MK_N_LAUNCHES 1
#endif

#define LAS __attribute__((address_space(3)))
#define GAS __attribute__((address_space(1)))
typedef unsigned short bf16_t;
typedef short bf16x8 __attribute__((ext_vector_type(8)));
typedef short s16x4 __attribute__((ext_vector_type(4)));
typedef float f32x4 __attribute__((ext_vector_type(4)));
typedef float f32x2 __attribute__((ext_vector_type(2)));
typedef float f32x16 __attribute__((ext_vector_type(16)));
typedef unsigned u32x4 __attribute__((ext_vector_type(4)));
typedef unsigned u32x2 __attribute__((ext_vector_type(2)));
typedef __bf16 bf16x2_t __attribute__((ext_vector_type(2)));

constexpr int NB = 8, SEQ = 4096, M = NB * SEQ, D = 1024, PW = 4352;
constexpr int NH = 8, NKV = 2, HD = 64, AD = 512, CD = 512;
constexpr int C_Q = 0, C_K = 512, C_V = 640, C_CB = 768, C_CC = 1280, C_CX = 1792, C_GA = 2304;
constexpr int NE = 32, DFF = 256, CAP = 32768;
constexpr float EPS = 1e-6f;
constexpr float QSCALE = 0.125f * 1.4426950408889634f;
constexpr int NWAVES = 8, NTHREADS = 512;

constexpr size_t MiB = 1u << 20;
constexpr size_t WS_CTL = 0, CTL_ZERO_BYTES = 64 * 1024;
constexpr size_t WS_ROPE = 1 * MiB;
constexpr size_t WS_WR = 1 * MiB + 256 * 1024;
constexpr size_t WS_WIN = 2 * MiB;
constexpr size_t WS_WA = 11 * MiB, WS_WC = 12 * MiB;
constexpr size_t WS_WOUT = 13 * MiB;
constexpr size_t WS_WGU = 16 * MiB;
constexpr size_t WS_WD = 48 * MiB;
constexpr size_t WS_XN = 64 * MiB;
constexpr size_t WS_AC = 64 * MiB;
constexpr size_t WS_PROJ = 128 * MiB;
constexpr size_t WS_H2 = 128 * MiB;
constexpr size_t WS_HID = 192 * MiB;
constexpr size_t WS_Y = 232 * MiB;
constexpr size_t WS_QN = 400 * MiB;
constexpr size_t WS_KN = 432 * MiB;
constexpr size_t WS_MERGED = 400 * MiB;
constexpr size_t WS_ASG = 464 * MiB;
constexpr size_t WS_RSG = 468 * MiB;
constexpr size_t WS_END = 476 * MiB;
constexpr int CW_CNT = 1024;
constexpr int CW_BAR = 4096;

constexpr int RING_BYTES = 131072;
constexpr int LDSCTL_OFF = RING_BYTES;
constexpr int LC_MISC = 0;
constexpr int LC_MTPRE = 128;
constexpr int LC_CNT = 128 + 160;
constexpr int LC_HIST = LC_CNT + 128;
constexpr int LC_BASE = LC_HIST + 128;
constexpr int LDS_BYTES = 163840;

__device__ __forceinline__ unsigned cvtpk(float lo, float hi) { f32x2 v = {lo, hi}; bf16x2_t b = __builtin_convertvector(v, bf16x2_t); return __builtin_bit_cast(unsigned, b); }
__device__ __forceinline__ bf16_t f2bf(float f) { return (bf16_t)(cvtpk(f, 0.f) & 0xffffu); }
__device__ __forceinline__ float bf2f(unsigned h) { return __builtin_bit_cast(float, h << 16); }
__device__ __forceinline__ float bflo(unsigned w) { return __builtin_bit_cast(float, w << 16); }
__device__ __forceinline__ float bfhi(unsigned w) { return __builtin_bit_cast(float, w & 0xffff0000u); }
__device__ __forceinline__ float wave_sum(float v) {
#pragma unroll
    for (int o = 1; o < 64; o <<= 1) v += __shfl_xor(v, o);
    return v;
}
__device__ __forceinline__ float wave_max(float v) {
#pragma unroll
    for (int o = 1; o < 64; o <<= 1) v = fmaxf(v, __shfl_xor(v, o));
    return v;
}
__device__ __forceinline__ float sigmoidf_(float v) { return __builtin_amdgcn_rcpf(1.0f + __builtin_amdgcn_exp2f(-1.4426950408889634f * v)); }
__device__ __forceinline__ void unpack8(const u32x4 w, float (&v)[8]) { v[0] = bflo(w.x); v[1] = bfhi(w.x); v[2] = bflo(w.y); v[3] = bfhi(w.y); v[4] = bflo(w.z); v[5] = bfhi(w.z); v[6] = bflo(w.w); v[7] = bfhi(w.w); }
__device__ __forceinline__ u32x4 pack8(const float (&v)[8]) { u32x4 w; w.x = cvtpk(v[0], v[1]); w.y = cvtpk(v[2], v[3]); w.z = cvtpk(v[4], v[5]); w.w = cvtpk(v[6], v[7]); return w; }
#define LDS_WAIT() asm volatile("s_waitcnt lgkmcnt(0)" ::: "memory")
#define VM_WAIT() asm volatile("s_waitcnt vmcnt(0)" ::: "memory")

namespace pg8 {
constexpr int BM = 256, BK = 64, HALF = 128, HTB = HALF * BK * 2, STAGE_BYTES = 8 * HTB, NXCD = 8, WGM = 8;
__host__ __device__ __forceinline__ int lds_byte(int r, int c) { const int st = (r >> 4) * 2 + (c >> 5), rr = r & 15, cc = c & 31, ob = rr * 64 + cc * 2; return st * 1024 + (ob ^ (((ob >> 9) & 1) << 5)); }
__host__ __device__ __forceinline__ void stage_rc(int b, int& R, int& C) { const int st = b / 1024, sb = b % 1024, swz = sb ^ (((sb >> 9) & 1) << 5); R = (st >> 1) * 16 + swz / 64; C = (st & 1) * 32 + (swz % 64) / 2; }
__host__ __device__ __forceinline__ int perm32(int rho) { const int n = rho >> 4, i = rho & 15; return 8 * (i >> 2) + 4 * n + (i & 3); }

struct Unit { int pm, pn, z, valid; };

__device__ __forceinline__ void tile_of(int L, int nM, int nN, int& pm, int& pn) {
    const int nwg = nM * nN; int wgid = L;
    { const int q = nwg / NXCD, r = nwg % NXCD, xcd = wgid % NXCD, off = wgid / NXCD; wgid = (xcd < r ? xcd * (q + 1) : r * (q + 1) + (xcd - r) * q) + off; }
    const int nig = WGM * nN, gid = wgid / nig, fm = gid * WGM, gsz = (nM - fm) < WGM ? (nM - fm) : WGM;
    pm = fm + ((wgid % nig) % gsz); pn = (wgid % nig) / gsz;
}

struct PlainOrder {
    static constexpr bool GATHER = false;
    const bf16_t* A; const bf16_t* Bt; int lda, ldb, nM, nN, G, c;
    __device__ __forceinline__ bool next(int i, Unit& u) const { const int L = i * G + c; if (L >= nM * nN) return false; tile_of(L, nM, nN, u.pm, u.pn); u.z = 0; u.valid = 256; return true; }
    __device__ __forceinline__ void ptrs(const Unit& u, const char*& a, const char*& b) const { a = (const char*)(A + (size_t)u.pm * 256 * lda); b = (const char*)(Bt + (size_t)u.pn * 256 * ldb); }
    __device__ __forceinline__ void avoff(const Unit&, const int (&R)[2], const int (&C)[2], unsigned (&v)[2][2]) const {
#pragma unroll
        for (int h = 0; h < 2; ++h)
#pragma unroll
            for (int i = 0; i < 2; ++i) v[h][i] = (unsigned)(R[i] * lda + C[i]) * 2u;
    }
};
struct DualOrder {
    static constexpr bool GATHER = false;
    const bf16_t* AC; const bf16_t* Wa; const bf16_t* Wc; int G, c;
    __device__ __forceinline__ bool next(int i, Unit& u) const { const int L = (i >> 1) * G + c; if (L >= 128 * 4) return false; tile_of(L, 128, 4, u.pm, u.pn); u.z = i & 1; u.valid = 256; return true; }
    __device__ __forceinline__ void ptrs(const Unit& u, const char*& a, const char*& b) const { a = (const char*)(AC + (size_t)u.pm * 256 * 1024 + u.z * 512); b = (const char*)((u.z ? Wc : Wa) + (size_t)u.pn * 256 * 512); }
    __device__ __forceinline__ void avoff(const Unit&, const int (&R)[2], const int (&C)[2], unsigned (&v)[2][2]) const {
#pragma unroll
        for (int h = 0; h < 2; ++h)
#pragma unroll
            for (int i = 0; i < 2; ++i) v[h][i] = (unsigned)(R[i] * 1024 + C[i]) * 2u;
    }
};
struct MoeOrder {
    const LAS int* mtpre; const LAS int* cnt; int NT, G, c;
    __device__ __forceinline__ bool locate(int i, Unit& u) const {
        const int L = i * G + c; const int U = mtpre[32] * NT; if (L >= U) return false;
        const int tg = L / NT; u.pn = L - tg * NT; int e = 0;
#pragma unroll 1
        for (int j = 1; j < 32; ++j) e += (mtpre[j] <= tg) ? 1 : 0;
        u.z = e; u.pm = tg; const int mt = tg - mtpre[e]; const int left = cnt[e] - mt * 256; u.valid = left < 256 ? left : 256; return true;
    }
};
struct MoeGuOrder : MoeOrder {
    static constexpr bool GATHER = true;
    const bf16_t* H2; const bf16_t* Wgu; const int* asg;
    __device__ __forceinline__ bool next(int i, Unit& u) const { return locate(i, u); }
    __device__ __forceinline__ void ptrs(const Unit& u, const char*& a, const char*& b) const { a = (const char*)H2; b = (const char*)(Wgu + ((size_t)u.z * 512 + (size_t)u.pn * 256) * 1024); }
    __device__ __forceinline__ void avoff(const Unit& u, const int (&R)[2], const int (&C)[2], unsigned (&v)[2][2]) const {
        const int mt = u.pm - mtpre[u.z]; const int* ap = asg + ((size_t)u.z * CAP + mt * 256);
#pragma unroll
        for (int h = 0; h < 2; ++h)
#pragma unroll
            for (int i = 0; i < 2; ++i) { const unsigned r = (unsigned)(h * 128 + R[i]); int tok = 0; if ((int)r < u.valid) tok = ap[r] >> 1; v[h][i] = (unsigned)(tok * 1024 + C[i]) * 2u; }
    }
};
struct MoeDownOrder : MoeOrder {
    static constexpr bool GATHER = false;
    const bf16_t* HID; const bf16_t* Wd;
    __device__ __forceinline__ bool next(int i, Unit& u) const { return locate(i, u); }
    __device__ __forceinline__ void ptrs(const Unit& u, const char*& a, const char*& b) const { a = (const char*)(HID + (size_t)u.pm * 256 * 256); b = (const char*)(Wd + ((size_t)u.z * 1024 + (size_t)u.pn * 256) * 256); }
    __device__ __forceinline__ void avoff(const Unit&, const int (&R)[2], const int (&C)[2], unsigned (&v)[2][2]) const {
#pragma unroll
        for (int h = 0; h < 2; ++h)
#pragma unroll
            for (int i = 0; i < 2; ++i) v[h][i] = (unsigned)(R[i] * 256 + C[i]) * 2u;
    }
};

typedef f32x4 Acc[2][2][4][2];

struct EpiProj {
    static constexpr bool PERM = true, HAS_MID = false;
    bf16_t* O;
    __device__ __forceinline__ void operator()(const Acc& acc, const Unit& u, int wr, int wc, int fr, int fq) const {
        bf16_t* base = O + (size_t)u.pm * BM * PW + u.pn * BM;
        unsigned l0 = (unsigned)((wr * 64 + fr) * PW + wc * 32 + 8 * fq); asm volatile("" : "+v"(l0)); const bool sg = u.pn >= 9;
#pragma unroll
        for (int ai = 0; ai < 2; ++ai)
#pragma unroll
            for (int m = 0; m < 4; ++m)
#pragma unroll
                for (int bj = 0; bj < 2; ++bj) { f32x4 v0 = acc[ai][bj][m][0], v1 = acc[ai][bj][m][1];
                    if (sg) {
#pragma unroll
                        for (int k = 0; k < 4; ++k) { v0[k] = sigmoidf_(v0[k]); v1[k] = sigmoidf_(v1[k]); } }
                    u32x4 w; w.x = cvtpk(v0[0], v0[1]); w.y = cvtpk(v0[2], v0[3]); w.z = cvtpk(v1[0], v1[1]); w.w = cvtpk(v1[2], v1[3]);
                    *(u32x4*)(base + (l0 + (unsigned)((ai * HALF + m * 16) * PW + bj * HALF))) = w; }
    }
};
struct EpiGate2 {
    static constexpr bool PERM = true, HAS_MID = true;
    const bf16_t* PROJ; bf16_t* MG;
    __device__ __forceinline__ void mid(Acc& acc, const Unit& u, int wr, int wc, int fr, int fq) const {
        const bf16_t* gbase = PROJ + (size_t)u.pm * BM * PW + C_GA + u.pn * BM;
        unsigned lg = (unsigned)((wr * 64 + fr) * PW + wc * 32 + 8 * fq); asm volatile("" : "+v"(lg));
#pragma unroll
        for (int ai = 0; ai < 2; ++ai) { u32x4 ga[4][2], gc[4][2];
#pragma unroll
            for (int m = 0; m < 4; ++m)
#pragma unroll
                for (int bj = 0; bj < 2; ++bj) { const unsigned o = lg + (unsigned)((ai * HALF + m * 16) * PW + bj * HALF); ga[m][bj] = *(const u32x4*)(gbase + o); gc[m][bj] = *(const u32x4*)(gbase + 1024 + o); }
#pragma unroll
            for (int m = 0; m < 4; ++m)
#pragma unroll
                for (int bj = 0; bj < 2; ++bj) { float a8[8], c8[8]; unpack8(ga[m][bj], a8); unpack8(gc[m][bj], c8);
#pragma unroll
                    for (int k = 0; k < 8; ++k) { const float r = a8[k] * __builtin_amdgcn_rcpf(fmaxf(c8[k], 9.5367431640625e-07f)); if (k < 4) acc[ai][bj][m][0][k] *= r; else acc[ai][bj][m][1][k - 4] *= r; } }
            asm volatile("" ::: "memory"); }
    }
    __device__ __forceinline__ void operator()(const Acc& acc, const Unit& u, int wr, int wc, int fr, int fq) const {
        const bf16_t* gbase = PROJ + (size_t)u.pm * BM * PW + C_GA + 1024 + u.pn * BM;
        bf16_t* ob = MG + (size_t)u.pm * BM * 1024 + u.pn * BM;
        unsigned lg = (unsigned)((wr * 64 + fr) * PW + wc * 32 + 8 * fq), lt = (unsigned)((wr * 64 + fr) * 1024 + wc * 32 + 8 * fq); asm volatile("" : "+v"(lg), "+v"(lt));
        u32x4 gc[2][4][2];
#pragma unroll
        for (int ai = 0; ai < 2; ++ai)
#pragma unroll
            for (int m = 0; m < 4; ++m)
#pragma unroll
                for (int bj = 0; bj < 2; ++bj) gc[ai][m][bj] = *(const u32x4*)(gbase + (lg + (unsigned)((ai * HALF + m * 16) * PW + bj * HALF)));
#pragma unroll
        for (int ai = 0; ai < 2; ++ai)
#pragma unroll
            for (int m = 0; m < 4; ++m)
#pragma unroll
                for (int bj = 0; bj < 2; ++bj) { float c8[8]; unpack8(gc[ai][m][bj], c8); float v[8];
#pragma unroll
                    for (int k = 0; k < 8; ++k) v[k] = (k < 4 ? acc[ai][bj][m][0][k] : acc[ai][bj][m][1][k - 4]) * fmaxf(c8[k], 9.5367431640625e-07f);
                    *(u32x4*)(ob + (lt + (unsigned)((ai * HALF + m * 16) * 1024 + bj * HALF))) = pack8(v); }
    }
};
struct EpiRes {
    static constexpr bool PERM = false, HAS_MID = false;
    const float* X; float* O;
    __device__ __forceinline__ void operator()(const Acc& acc, const Unit& u, int wr, int wc, int fr, int fq) const {
        const size_t tb = (size_t)u.pm * BM * D + u.pn * BM; const float* xb = X + tb; float* ob = O + tb;
        unsigned l0 = (unsigned)((wr * 64 + fr) * D + wc * 32 + 4 * fq); asm volatile("" : "+v"(l0));
#pragma unroll
        for (int ai = 0; ai < 2; ++ai) { f32x4 xv[4][2][2];
#pragma unroll
            for (int m = 0; m < 4; ++m)
#pragma unroll
                for (int bj = 0; bj < 2; ++bj)
#pragma unroll
                    for (int n = 0; n < 2; ++n) xv[m][bj][n] = *(const f32x4*)(xb + (l0 + (unsigned)((ai * HALF + m * 16) * D + bj * HALF + n * 16)));
#pragma unroll
            for (int m = 0; m < 4; ++m)
#pragma unroll
                for (int bj = 0; bj < 2; ++bj)
#pragma unroll
                    for (int n = 0; n < 2; ++n) *(f32x4*)(ob + (l0 + (unsigned)((ai * HALF + m * 16) * D + bj * HALF + n * 16))) = xv[m][bj][n] + acc[ai][bj][m][n];
            asm volatile("" ::: "memory"); }
    }
};
struct EpiGU {
    static constexpr bool PERM = true, HAS_MID = false;
    bf16_t* HID; const f32x2* rsg; const LAS int* mtpre;
    __device__ __forceinline__ void operator()(const Acc& acc, const Unit& u, int wr, int wc, int fr, int fq) const {
        const int mt = u.pm - mtpre[u.z]; const f32x2* rp = rsg + ((size_t)u.z * CAP + mt * 256);
        bf16_t* hb = HID + (size_t)u.pm * 256 * 256 + u.pn * 128;
        int r0 = wr * 64 + fr; asm volatile("" : "+v"(r0)); const unsigned l0 = (unsigned)(r0 * 256 + wc * 32 + 8 * fq);
        float rsv[2][4];
#pragma unroll
        for (int ai = 0; ai < 2; ++ai)
#pragma unroll
            for (int m = 0; m < 4; ++m) { const int r = r0 + ai * HALF + m * 16; const float t = rp[(unsigned)(r < u.valid ? r : 0)].y; rsv[ai][m] = r < u.valid ? t : 0.f; }
#pragma unroll
        for (int ai = 0; ai < 2; ++ai)
#pragma unroll
            for (int m = 0; m < 4; ++m) { const int r = r0 + ai * HALF + m * 16;
                const float rs = rsv[ai][m];
                const f32x4 g0 = acc[ai][0][m][0] * rs, g1 = acc[ai][0][m][1] * rs, u0 = acc[ai][1][m][0] * rs, u1 = acc[ai][1][m][1] * rs;
                float h[8];
#pragma unroll
                for (int k = 0; k < 4; ++k) { h[k] = g0[k] * sigmoidf_(g0[k]) * u0[k]; h[4 + k] = g1[k] * sigmoidf_(g1[k]) * u1[k]; }
                u32x4 w; w.x = cvtpk(h[0], h[1]); w.y = cvtpk(h[2], h[3]); w.z = cvtpk(h[4], h[5]); w.w = cvtpk(h[6], h[7]);
                *(u32x4*)(hb + (l0 + (unsigned)((ai * HALF + m * 16) * 256))) = w; }
    }
};
struct EpiDown {
    static constexpr bool PERM = true, HAS_MID = false;
    bf16_t* Y; const int* asg; const f32x2* rsg; const LAS int* mtpre;
    __device__ __forceinline__ void operator()(const Acc& acc, const Unit& u, int wr, int wc, int fr, int fq) const {
        const int mt = u.pm - mtpre[u.z]; const size_t pb = (size_t)u.z * CAP + mt * 256; const int* ap = asg + pb; const f32x2* rp = rsg + pb;
        bf16_t* yb = Y + u.pn * BM;
        int r0 = wr * 64 + fr; unsigned c0 = (unsigned)(wc * 32 + 8 * fq); asm volatile("" : "+v"(r0), "+v"(c0));
#pragma unroll
        for (int ai = 0; ai < 2; ++ai) { int av[4]; float gv[4];
#pragma unroll
            for (int m = 0; m < 4; ++m) { const int r = r0 + ai * HALF + m * 16; const unsigned rr = (unsigned)(r < u.valid ? r : 0); av[m] = ap[rr]; gv[m] = rp[rr].x; }
#pragma unroll
            for (int m = 0; m < 4; ++m) { const int r = r0 + ai * HALF + m * 16;
                if (r < u.valid) { const float gt = gv[m];
#pragma unroll
                    for (int bj = 0; bj < 2; ++bj) { const f32x4 v0 = acc[ai][bj][m][0] * gt, v1 = acc[ai][bj][m][1] * gt;
                        u32x4 w; w.x = cvtpk(v0[0], v0[1]); w.y = cvtpk(v0[2], v0[3]); w.z = cvtpk(v1[0], v1[1]); w.w = cvtpk(v1[2], v1[3]);
                        *(u32x4*)(yb + ((unsigned)av[m] * 1024u + c0 + (unsigned)(bj * HALF))) = w; } } }
            asm volatile("" ::: "memory"); }
    }
};

template <class Epi, class Sched, bool ALIGN_EPI, bool NOUNROLL = false>
__device__ __forceinline__ void gemm_phase(LAS unsigned char* lds, const int K, const int lda, const int ldb, const Sched& S, const Epi& E) {
    int tid = threadIdx.x; asm volatile("" : "+v"(tid));
    const int wid = __builtin_amdgcn_readfirstlane(tid >> 6), lane = tid & 63, wr = wid >> 2, wc = wid & 3, fr = lane & 15, fq = lane >> 4;
    const int nt = K / BK;
    int sR[2], sC[2]; unsigned voffB[2];
#pragma unroll
    for (int i = 0; i < 2; ++i) { int R, C; stage_rc(tid * 16 + i * 8192, R, C); sR[i] = R; sC[i] = C; const int Rb = Epi::PERM ? ((R & ~31) + perm32(R & 31)) : R;
        voffB[i] = (unsigned)(Rb * ldb + C) * 2u; }
    const size_t kstep = (size_t)(BK * 2);
    const size_t hB = (size_t)HALF * ldb * 2, hA = Sched::GATHER ? (size_t)0 : (size_t)HALF * lda * 2;
    const unsigned ldsw = (unsigned)wid * 1024u;
    const int aoff = lds_byte(wr * 64 + fr, fq * 8), boff = lds_byte(wc * 32 + fr, fq * 8);
#define PG8_SA(b, h) (((b) * 2 + (h)) * HTB)
#define PG8_SB(b, h) ((4 + (b) * 2 + (h)) * HTB)
#define PG8_STAGE(bufoff, gbase, v0, v1) do { \
        __builtin_amdgcn_global_load_lds((const unsigned*)((const char*)(gbase) + (v0)), (LAS unsigned*)(lds + (bufoff) + ldsw), 16, 0, 0); \
        __builtin_amdgcn_global_load_lds((const unsigned*)((const char*)(gbase) + (v1)), (LAS unsigned*)(lds + (bufoff) + ldsw + 8192), 16, 0, 0); } while (0)
#define PG8_STB(bufoff, gbase) PG8_STAGE(bufoff, gbase, voffB[0], voffB[1])
#define PG8_STA(bufoff, gbase, h) PG8_STAGE(bufoff, (gbase) + (h) * hA, cv[Sched::GATHER ? (h) : 0][0], cv[Sched::GATHER ? (h) : 0][1])
#define PG8_LDA(dst, b, h) do { _Pragma("unroll") for (int m = 0; m < 4; ++m) _Pragma("unroll") for (int k = 0; k < 2; ++k) dst[m][k] = *(const LAS bf16x8*)(lds + PG8_SA(b, h) + aoff + m * 2048 + k * 1024); } while (0)
#define PG8_LDB(dst, b, h) do { _Pragma("unroll") for (int n = 0; n < 2; ++n) _Pragma("unroll") for (int k = 0; k < 2; ++k) dst[n][k] = *(const LAS bf16x8*)(lds + PG8_SB(b, h) + boff + n * 2048 + k * 1024); } while (0)
#define PG8_MMA(ai, bj, At, Bt) do { __builtin_amdgcn_s_setprio(1); _Pragma("unroll") for (int m = 0; m < 4; ++m) _Pragma("unroll") for (int n = 0; n < 2; ++n) _Pragma("unroll") for (int k = 0; k < 2; ++k) \
        acc[ai][bj][m][n] = __builtin_amdgcn_mfma_f32_16x16x32_bf16(Bt[n][k], At[m][k], acc[ai][bj][m][n], 0, 0, 0); __builtin_amdgcn_s_setprio(0); } while (0)
#define PG8_WAIT_V(n) asm volatile("s_waitcnt vmcnt(" #n ")" ::: "memory")
#define PG8_WAIT_L(n) asm volatile("s_waitcnt lgkmcnt(" #n ")" ::: "memory")
#define PG8_BAR __builtin_amdgcn_s_barrier()
#define PG8_SCHED __builtin_amdgcn_sched_barrier(0)
    Unit cur, nxt; int ui = 0;
    if (!S.next(0, cur)) return;
    Acc acc;
#pragma unroll
    for (int a = 0; a < 2; ++a)
#pragma unroll
        for (int b = 0; b < 2; ++b)
#pragma unroll
            for (int m = 0; m < 4; ++m)
#pragma unroll
                for (int n = 0; n < 2; ++n) acc[a][b][m][n] = (f32x4){0.f, 0.f, 0.f, 0.f};
    bf16x8 At[4][2], B0[2][2], B1[2][2];
    const char* cA; const char* cB; S.ptrs(cur, cA, cB);
    unsigned cv[2][2]; S.avoff(cur, sR, sC, cv);
    PG8_STB(PG8_SB(0, 0), cB); PG8_STB(PG8_SB(0, 1), cB + hB); PG8_STA(PG8_SA(0, 0), cA, 0); PG8_STA(PG8_SA(0, 1), cA, 1);
    if (wr == 1) PG8_BAR;
    PG8_WAIT_V(2); PG8_BAR;
    PG8_STB(PG8_SB(1, 0), cB + kstep); PG8_STA(PG8_SA(1, 0), cA + kstep, 0); PG8_STB(PG8_SB(1, 1), cB + hB + kstep);
    PG8_WAIT_V(6); PG8_BAR;
    for (;;) {
        const bool has_next = S.next(ui + 1, nxt);
        const char* nA = cA; const char* nB = cB;
        if (has_next) S.ptrs(nxt, nA, nB);
        for (int t = 0; t < nt; t += 2) {
            if constexpr (NOUNROLL) asm volatile("" : "+s"(t));
            const bool last = (t == nt - 2);
            if constexpr (Epi::HAS_MID) { if (t == (nt >> 1)) E.mid(acc, cur, wr, wc, fr, fq); }
            unsigned nv[2][2];
            if (Sched::GATHER) { if (last && has_next) { S.avoff(nxt, sR, sC, nv); cv[0][0] = nv[0][0]; cv[0][1] = nv[0][1]; } }
            const char* a1 = cA + (size_t)(t + 1) * kstep;
            const char* a2 = last ? nA : cA + (size_t)(t + 2) * kstep; const char* b2 = last ? nB : cB + (size_t)(t + 2) * kstep;
            const char* a3 = a2 + kstep; const char* b3 = b2 + kstep;
            PG8_LDB(B0, 0, 0); PG8_LDB(B1, 0, 1); PG8_SCHED; PG8_LDA(At, 0, 0); PG8_STA(PG8_SA(1, 1), a1, 1);
            if (Sched::GATHER) { if (last && has_next) { cv[1][0] = nv[1][0]; cv[1][1] = nv[1][1]; } }
            PG8_WAIT_V(8); PG8_WAIT_L(0); PG8_BAR; PG8_MMA(0, 0, At, B0); PG8_MMA(0, 1, At, B1); PG8_BAR; PG8_SCHED;
            PG8_LDA(At, 0, 1); PG8_STB(PG8_SB(0, 0), b2); PG8_STB(PG8_SB(0, 1), b2 + hB); PG8_STA(PG8_SA(0, 0), a2, 0);
            PG8_WAIT_V(8); PG8_WAIT_L(0); PG8_BAR; PG8_MMA(1, 0, At, B0); PG8_MMA(1, 1, At, B1); PG8_BAR; PG8_SCHED;
            PG8_LDB(B0, 1, 0); PG8_LDB(B1, 1, 1); PG8_SCHED; PG8_LDA(At, 1, 0); PG8_STA(PG8_SA(0, 1), a2, 1);
            PG8_WAIT_V(8); PG8_WAIT_L(0); PG8_BAR; PG8_MMA(0, 0, At, B0); PG8_MMA(0, 1, At, B1); PG8_BAR; PG8_SCHED;
            PG8_LDA(At, 1, 1); PG8_STB(PG8_SB(1, 0), b3); PG8_STB(PG8_SB(1, 1), b3 + hB); PG8_STA(PG8_SA(1, 0), a3, 0);
            PG8_WAIT_V(8); PG8_WAIT_L(0); PG8_BAR; PG8_MMA(1, 0, At, B0); PG8_MMA(1, 1, At, B1); PG8_BAR; PG8_SCHED;
        }
        if constexpr (ALIGN_EPI) { if (wr == 0) PG8_BAR; }
        E(acc, cur, wr, wc, fr, fq);
        if (!has_next) break;
#pragma unroll
        for (int a = 0; a < 2; ++a)
#pragma unroll
            for (int b = 0; b < 2; ++b)
#pragma unroll
                for (int m = 0; m < 4; ++m)
#pragma unroll
                    for (int n = 0; n < 2; ++n) acc[a][b][m][n] = (f32x4){0.f, 0.f, 0.f, 0.f};
        cur = nxt; cA = nA; cB = nB; ++ui;
        if constexpr (ALIGN_EPI) { if (wr == 1) PG8_BAR; }
    }
    PG8_WAIT_V(0);
    if constexpr (!ALIGN_EPI) { if (wr == 0) PG8_BAR; }
    PG8_BAR;
#undef PG8_SA
#undef PG8_SB
#undef PG8_STAGE
#undef PG8_STA
#undef PG8_STB
#undef PG8_LDA
#undef PG8_LDB
#undef PG8_MMA
#undef PG8_WAIT_V
#undef PG8_WAIT_L
#undef PG8_BAR
#undef PG8_SCHED
}
}

#ifndef MK_USE_CG
#define MK_USE_CG 0
#endif
#define XB_TMO      128
#define XB_XCNT(j)  (256  + 64 * (j))
#define XB_XSUB(j)  (1280 + 64 * (j))
#define XB_XGEN(j)  (2304 + 64 * (j))
#define XB_TOP      3328
#define XB_TOPGEN   3392
#define XCD_BAR_WORDS 3456
#define XB_SPIN_CAP (1u << 18)
__device__ __forceinline__ unsigned xb_ld(unsigned* p)              { return __hip_atomic_load(p, __ATOMIC_RELAXED, __HIP_MEMORY_SCOPE_AGENT); }
__device__ __forceinline__ unsigned xb_add(unsigned* p, unsigned v) { return __hip_atomic_fetch_add(p, v, __ATOMIC_RELAXED, __HIP_MEMORY_SCOPE_AGENT); }
__device__ __forceinline__ unsigned xb_xcc_id() { return (unsigned)__builtin_amdgcn_s_getreg((3 << 11) | 20) & 0xFu; }
#define XB_SPIN(cond, bar) do { unsigned _sp = 0; while (cond) { __builtin_amdgcn_s_sleep(1); \
    if ((++_sp & 255u) == 0u) { if (xb_ld(&(bar)[XB_TMO])) break; if (_sp > XB_SPIN_CAP) { atomicAdd(&(bar)[XB_TMO], 1u); break; } } } } while (0)
struct XcdBarrier { unsigned* bar; unsigned x; volatile LAS unsigned* st; };
__device__ __forceinline__ XcdBarrier xcd_barrier_post(unsigned* bar, volatile LAS unsigned* st) {
    XcdBarrier b; b.bar = bar; b.x = xb_xcc_id(); b.st = st;
    if (threadIdx.x == 0) (void)xb_add(&bar[XB_XCNT(b.x)], 1u);
    return b;
}
__device__ __forceinline__ void xcd_barrier_complete(unsigned* bar, unsigned x, unsigned& nloc, unsigned& nx) {
    const unsigned G = gridDim.x * gridDim.y * gridDim.z;
    unsigned sum, cnt, mine, sp = 0u;
    for (;;) {
        sum = 0u; cnt = 0u; mine = 0u;
#pragma unroll
        for (unsigned j = 0; j < 16; ++j) { const unsigned c = xb_ld(&bar[XB_XCNT(j)]); sum += c; cnt += (c > 0u) ? 1u : 0u; mine = (j == x) ? c : mine; }
        if (sum == G) break;
        __builtin_amdgcn_s_sleep(1);
        if ((++sp & 255u) == 0u) { if (xb_ld(&bar[XB_TMO])) break; if (sp > XB_SPIN_CAP) { atomicAdd(&bar[XB_TMO], 1u); break; } }
    }
    nloc = mine > 0u ? mine : 1u; nx = cnt > 0u ? cnt : 1u;
}
__device__ __forceinline__ void xcd_barrier(const XcdBarrier& b) {
    asm volatile("s_waitcnt vmcnt(0)" ::: "memory");
    __syncthreads();
    if (threadIdx.x == 0) {
        unsigned* bar = b.bar;
        __builtin_amdgcn_s_waitcnt(0);
        unsigned nloc = b.st[0], nx = b.st[1];
        if (nloc == 0u) { xcd_barrier_complete(bar, b.x, nloc, nx); b.st[0] = nloc; b.st[1] = nx; }
        const unsigned old = xb_add(&bar[XB_XSUB(b.x)], 1u);
        const unsigned gen = old / nloc;
        if (old + 1u == (gen + 1u) * nloc) {
            __builtin_amdgcn_fence(__ATOMIC_RELEASE, "agent");
            asm volatile("s_waitcnt vmcnt(0)" ::: "memory");
            const unsigned og = xb_add(&bar[XB_TOP], 1u);
            const unsigned tg = og / nx;
            if (og + 1u == (tg + 1u) * nx) xb_add(&bar[XB_TOPGEN], 1u);
            else XB_SPIN(xb_ld(&bar[XB_TOPGEN]) == tg, bar);
            __builtin_amdgcn_fence(__ATOMIC_ACQUIRE, "agent");
            xb_add(&bar[XB_XGEN(b.x)], 1u);
            asm volatile("s_waitcnt vmcnt(0)" ::: "memory");
        } else {
            XB_SPIN(xb_ld(&bar[XB_XGEN(b.x)]) == gen, bar);
            __builtin_amdgcn_fence(__ATOMIC_ACQUIRE, "agent");
            asm volatile("s_waitcnt vmcnt(0)" ::: "memory");
        }
    }
    __syncthreads();
}

struct Args {
    const float* in[19]; float* out; unsigned char* ws; int ph_lo, ph_hi; int rep[10];
};
struct Frame {
    LAS unsigned char* lds; int tid, lane, wave, G, vcu;
};

__device__ __forceinline__ void tr_item(const float* W, int ldw, int k0, int n0, bf16_t* WT, int ldt, int drow0, LAS float* scr, int lane) {
    float tv[32];
#pragma unroll
    for (int i = 0; i < 32; ++i) { const int kk = 2 * i + (lane >> 5); tv[i] = W[(size_t)(k0 + kk) * ldw + n0 + (lane & 31)]; }
#pragma unroll
    for (int i = 0; i < 32; ++i) { const int kk = 2 * i + (lane >> 5); scr[kk * 33 + (lane & 31)] = tv[i]; }
    LDS_WAIT(); asm volatile("" ::: "memory");
    const int c = lane & 7;
#pragma unroll
    for (int j = 0; j < 4; ++j) { const int n = (lane >> 3) + 8 * j; const LAS float* s = scr + (8 * c) * 33 + n;
        u32x4 o; o.x = cvtpk(s[0 * 33], s[1 * 33]); o.y = cvtpk(s[2 * 33], s[3 * 33]); o.z = cvtpk(s[4 * 33], s[5 * 33]); o.w = cvtpk(s[6 * 33], s[7 * 33]);
        *(u32x4*)(WT + (size_t)(drow0 + n) * ldt + k0 + 8 * c) = o; }
    LDS_WAIT(); asm volatile("" ::: "memory");
}
__device__ __forceinline__ void p0_prologue(const Frame& F, const Args& a) {
    unsigned char* ws = a.ws;
    LAS float* scr = (LAS float*)(F.lds + F.wave * 16384);
    const int gw = F.vcu * NWAVES + F.wave, NGW = F.G * NWAVES;
    const float* w_in = a.in[2]; const float* w_a = a.in[8]; const float* w_c = a.in[9]; const float* w_out = a.in[10];
    const float* w_gate = a.in[16]; const float* w_up = a.in[17]; const float* w_down = a.in[18];
    bf16_t* WinT = (bf16_t*)(ws + WS_WIN); bf16_t* WaT = (bf16_t*)(ws + WS_WA); bf16_t* WcT = (bf16_t*)(ws + WS_WC); bf16_t* WoutT = (bf16_t*)(ws + WS_WOUT);
    bf16_t* WguT = (bf16_t*)(ws + WS_WGU); bf16_t* WdT = (bf16_t*)(ws + WS_WD);
    constexpr int I_IN = 16 * 136, I_A = 8 * 32, I_OUT = 16 * 32, I_G = 32 * 128, I_D = 32 * 128;
    constexpr int NITEMS = I_IN + 2 * I_A + I_OUT + 2 * I_G + I_D;
    for (int it = gw; it < NITEMS; it += NGW) {
        int r = it;
        if (r < I_IN) { const int kb = r / 136, nb = r % 136; tr_item(w_in, PW, 64 * kb, 32 * nb, WinT, 1024, 32 * nb, scr, F.lane); continue; } r -= I_IN;
        if (r < I_A) { const int kb = r / 32, nb = r % 32; tr_item(w_a, 1024, 64 * kb, 32 * nb, WaT, 1024, 32 * nb, scr, F.lane); continue; } r -= I_A;
        if (r < I_A) { const int kb = r / 32, nb = r % 32; tr_item(w_c, 1024, 64 * kb, 32 * nb, WaT + 512, 1024, 32 * nb, scr, F.lane); continue; } r -= I_A;
        if (r < I_OUT) { const int kb = r / 32, nb = r % 32; tr_item(w_out, 1024, 64 * kb, 32 * nb, WoutT, 1024, 32 * nb, scr, F.lane); continue; } r -= I_OUT;
        if (r < 2 * I_G) { const int up = r >= I_G; if (up) r -= I_G; const int e = r / 128, q = r % 128, kb = q / 8, nb = q % 8, n0 = 32 * nb;
            tr_item((up ? w_up : w_gate) + (size_t)e * 1024 * 256, 256, 64 * kb, n0, WguT + (size_t)e * 512 * 1024, 1024, (n0 >> 7) * 256 + up * 128 + (n0 & 127), scr, F.lane); continue; } r -= 2 * I_G;
        { const int e = r / 128, q = r % 128, kb = q / 32, nb = q % 32; tr_item(w_down + (size_t)e * 256 * 1024, 1024, 64 * kb, 32 * nb, WdT + (size_t)e * 1024 * 256, 256, 32 * nb, scr, F.lane); }
    }
    const int gt = F.vcu * NTHREADS + F.tid, NGT = F.G * NTHREADS;
    { const float* w_rg = a.in[12]; const float* w_re = a.in[14]; bf16_t* WrT = (bf16_t*)(ws + WS_WR);
      for (int i = gt; i < 48 * 1024; i += NGT) { const int j = i >> 10, k = i & 1023; float v = 0.f; if (j < 4) v = w_rg[k * 4 + j]; else if (j < 36) v = w_re[k * 32 + (j - 4)]; WrT[i] = f2bf(v); } }
    { float* cosT = (float*)(ws + WS_ROPE); float* sinT = cosT + SEQ * 8;
      for (int i = gt; i < SEQ * 8; i += NGT) { const int pos = i >> 3, j = i & 7; const float inv = (float)pow(500000.0, -(double)j / 8.0); const float ang = (float)pos * inv;
          cosT[i] = (float)cos((double)ang); sinT[i] = (float)sin((double)ang); } }
    { const float* x = a.in[0]; const float* g1 = a.in[1]; bf16_t* XN = (bf16_t*)(ws + WS_XN);
      f32x4 gv[4];
#pragma unroll
      for (int j = 0; j < 4; ++j) gv[j] = ((const f32x4*)g1)[F.lane + 64 * j];
      for (int m0 = gw; m0 < M; m0 += 4 * NGW) { f32x4 v[4][4];
#pragma unroll
          for (int q = 0; q < 4; ++q) { const int m = m0 + q * NGW; const f32x4* xr = (const f32x4*)(x + (size_t)(m < M ? m : 0) * D) + F.lane;
#pragma unroll
              for (int j = 0; j < 4; ++j) v[q][j] = xr[64 * j]; }
#pragma unroll
          for (int q = 0; q < 4; ++q) { const int m = m0 + q * NGW; float s = 0.f;
#pragma unroll
              for (int j = 0; j < 4; ++j) s += (v[q][j].x * v[q][j].x + v[q][j].y * v[q][j].y) + (v[q][j].z * v[q][j].z + v[q][j].w * v[q][j].w);
              const float rstd = rsqrtf(wave_sum(s) * (1.f / D) + EPS);
              if (m < M) { u32x2* o8 = (u32x2*)(XN + (size_t)m * D) + F.lane;
#pragma unroll
                  for (int j = 0; j < 4; ++j) { u32x2 w; w.x = cvtpk(v[q][j].x * rstd * gv[j].x, v[q][j].y * rstd * gv[j].y); w.y = cvtpk(v[q][j].z * rstd * gv[j].z, v[q][j].w * rstd * gv[j].w); o8[64 * j] = w; } } } } }
}

__device__ __forceinline__ u32x4 qk_norm_rope(const u32x4 raw, const float (&g)[8], const f32x4 c0, const f32x4 c1, const f32x4 s0, const f32x4 s1, int l7, float scale) {
    float v[8]; unpack8(raw, v); float ss = 0.f;
#pragma unroll
    for (int i = 0; i < 8; ++i) ss += v[i] * v[i];
    ss += __shfl_xor(ss, 1); ss += __shfl_xor(ss, 2); ss += __shfl_xor(ss, 4);
    const float rstd = rsqrtf(ss * (1.f / 64.f) + EPS);
    const float cc[8] = {c0.x, c0.y, c0.z, c0.w, c1.x, c1.y, c1.z, c1.w}, sn[8] = {s0.x, s0.y, s0.z, s0.w, s1.x, s1.y, s1.z, s1.w};
#pragma unroll
    for (int i = 0; i < 8; ++i) { float y = v[i] * rstd * g[i]; const float p = __shfl_xor(y, 1);
        if (l7 == 0) y = y * cc[i] - p * sn[i]; else if (l7 == 1) y = y * cc[i] + p * sn[i];
        v[i] = y * scale; }
    return pack8(v);
}
__device__ __forceinline__ void p2_prep_conv(const Frame& F, const Args& a) {
    unsigned char* ws = a.ws;
    const bf16_t* PROJ = (const bf16_t*)(ws + WS_PROJ); bf16_t* QN = (bf16_t*)(ws + WS_QN); bf16_t* KN = (bf16_t*)(ws + WS_KN); bf16_t* AC = (bf16_t*)(ws + WS_AC);
    const float* cosT = (const float*)(ws + WS_ROPE); const float* sinT = cosT + SEQ * 8;
    const float* qg = a.in[3]; const float* kg = a.in[4]; const float* conv_w = a.in[6]; const float* conv_b = a.in[7];
    const int gw = F.vcu * NWAVES + F.wave, NGW = F.G * NWAVES, lane = F.lane, l7 = lane & 7;
    float gq[8], gk[8];
#pragma unroll
    for (int k = 0; k < 8; ++k) { gq[k] = qg[8 * l7 + k]; gk[k] = kg[8 * l7 + k]; }
    float w0[8], w1[8], w2[8], bb[8];
#pragma unroll
    for (int k = 0; k < 8; ++k) { w0[k] = conv_w[8 * lane + k]; w1[k] = conv_w[CD + 8 * lane + k]; w2[k] = conv_w[2 * CD + 8 * lane + k]; bb[k] = conv_b[8 * lane + k]; }
    for (int ch = gw; ch < M / 16; ch += NGW) {
        const int t0 = ch * 16;
#pragma unroll 1
        for (int grp = 0; grp < 4; ++grp) { const int tb = t0 + 4 * grp;
            u32x4 qraw[4]; f32x4 qc[4][4];
#pragma unroll
            for (int tk = 0; tk < 4; ++tk) { const int t = tb + tk, pos = t & (SEQ - 1); qraw[tk] = *(const u32x4*)(PROJ + (size_t)t * PW + 8 * lane);
                qc[tk][0] = *(const f32x4*)(cosT + pos * 8); qc[tk][1] = *(const f32x4*)(cosT + pos * 8 + 4); qc[tk][2] = *(const f32x4*)(sinT + pos * 8); qc[tk][3] = *(const f32x4*)(sinT + pos * 8 + 4); }
            const int tkk = tb + (lane >> 4), kpos = tkk & (SEQ - 1);
            const u32x4 kraw = *(const u32x4*)(PROJ + (size_t)tkk * PW + C_K + 8 * (lane & 15));
            const f32x4 kc0 = *(const f32x4*)(cosT + kpos * 8), kc1 = *(const f32x4*)(cosT + kpos * 8 + 4), ks0 = *(const f32x4*)(sinT + kpos * 8), ks1 = *(const f32x4*)(sinT + kpos * 8 + 4);
#pragma unroll
            for (int tk = 0; tk < 4; ++tk) { const u32x4 o = qk_norm_rope(qraw[tk], gq, qc[tk][0], qc[tk][1], qc[tk][2], qc[tk][3], l7, QSCALE); *(u32x4*)(QN + (size_t)(tb + tk) * AD + 8 * lane) = o; }
            { const u32x4 o = qk_norm_rope(kraw, gk, kc0, kc1, ks0, ks1, l7, 1.0f); *(u32x4*)(KN + (size_t)tkk * 128 + 8 * (lane & 15)) = o; } }
        float up[8], uc[8];
        { float a8[8], b8[8];
          if ((t0 & (SEQ - 1)) > 0) { unpack8(*(const u32x4*)(PROJ + (size_t)(t0 - 1) * PW + C_CC + 8 * lane), a8); unpack8(*(const u32x4*)(PROJ + (size_t)(t0 - 1) * PW + C_CX + 8 * lane), b8);
#pragma unroll
              for (int k = 0; k < 8; ++k) up[k] = a8[k] * b8[k]; } else {
#pragma unroll
              for (int k = 0; k < 8; ++k) up[k] = 0.f; }
          unpack8(*(const u32x4*)(PROJ + (size_t)t0 * PW + C_CC + 8 * lane), a8); unpack8(*(const u32x4*)(PROJ + (size_t)t0 * PW + C_CX + 8 * lane), b8);
#pragma unroll
          for (int k = 0; k < 8; ++k) uc[k] = a8[k] * b8[k]; }
#pragma unroll 1
        for (int grp = 0; grp < 4; ++grp) { const int tb = t0 + 4 * grp;
            u32x4 rcc[4], rcx[4], rcb[4];
#pragma unroll
            for (int tk = 0; tk < 4; ++tk) { const int t = tb + tk; const bool hn = ((t & (SEQ - 1)) < SEQ - 1); const size_t tn = (size_t)(hn ? t + 1 : t);
                rcc[tk] = *(const u32x4*)(PROJ + tn * PW + C_CC + 8 * lane); rcx[tk] = *(const u32x4*)(PROJ + tn * PW + C_CX + 8 * lane); rcb[tk] = *(const u32x4*)(PROJ + (size_t)t * PW + C_CB + 8 * lane); }
#pragma unroll
            for (int tk = 0; tk < 4; ++tk) { const int t = tb + tk; const bool hn = ((t & (SEQ - 1)) < SEQ - 1);
                float a8[8], b8[8], cbv[8], un[8], o[8]; unpack8(rcc[tk], a8); unpack8(rcx[tk], b8); unpack8(rcb[tk], cbv);
#pragma unroll
                for (int k = 0; k < 8; ++k) { un[k] = hn ? a8[k] * b8[k] : 0.f; o[k] = cbv[k] * (up[k] * w0[k] + uc[k] * w1[k] + un[k] * w2[k] + bb[k]); up[k] = uc[k]; uc[k] = un[k]; }
                *(u32x4*)(AC + (size_t)t * 1024 + 512 + 8 * lane) = pack8(o); } }
    }
}

namespace att {
constexpr int NSLOT = 8, WSOFF = RING_BYTES + 1024, OSTOFF = WSOFF + 2048;
static_assert(OSTOFF + 8 * 2048 <= LDS_BYTES, "attention LDS map");
__device__ __forceinline__ int crow(int r, int hi) { return (r & 3) + 8 * (r >> 2) + 4 * hi; }
__device__ __forceinline__ s16x4 vtr(const LAS char* p) { return __builtin_bit_cast(s16x4, __builtin_amdgcn_ds_read_tr16_b64_v4i16((LAS s16x4*)p)); }
}
__device__ __forceinline__ u32x4 k_norm_rope(const u32x4 raw, const float (&g)[8], float cl, float sl, int l7, int lane) {
    float v[8]; unpack8(raw, v); float ss = 0.f;
#pragma unroll
    for (int i = 0; i < 8; ++i) ss += v[i] * v[i];
    ss += __shfl_xor(ss, 1); ss += __shfl_xor(ss, 2); ss += __shfl_xor(ss, 4);
    const float rstd = rsqrtf(ss * (1.f / 64.f) + EPS);
#pragma unroll
    for (int i = 0; i < 8; ++i) { float y = v[i] * rstd * g[i]; const float p = __shfl_xor(y, 1); const float c = __shfl(cl, (lane & ~7) + i), sn = __shfl(sl, (lane & ~7) + i);
        if (l7 == 0) y = y * c - p * sn; else if (l7 == 1) y = y * c + p * sn;
        v[i] = y; }
    return pack8(v);
}
__device__ __forceinline__ void conv8(const bf16_t* PROJ, bf16_t* AC, int tb, int lane, float (&up)[8], float (&uc)[8], const float* conv_w, const float* conv_b) {
    u32x4 rcc[8], rcx[8], rcb[8];
#pragma unroll
    for (int tk = 0; tk < 8; ++tk) { const int t = tb + tk; const bool hn = ((t & (SEQ - 1)) < SEQ - 1); const size_t tn = (size_t)(hn ? t + 1 : t);
        rcc[tk] = *(const u32x4*)(PROJ + tn * PW + C_CC + 8 * lane); rcx[tk] = *(const u32x4*)(PROJ + tn * PW + C_CX + 8 * lane); rcb[tk] = *(const u32x4*)(PROJ + (size_t)t * PW + C_CB + 8 * lane); }
    float w0[8], w1[8], w2[8], bb[8];
#pragma unroll
    for (int k = 0; k < 8; ++k) { w0[k] = conv_w[8 * lane + k]; w1[k] = conv_w[CD + 8 * lane + k]; w2[k] = conv_w[2 * CD + 8 * lane + k]; bb[k] = conv_b[8 * lane + k]; }
#pragma unroll
    for (int tk = 0; tk < 8; ++tk) { const int t = tb + tk; const bool hn = ((t & (SEQ - 1)) < SEQ - 1);
        float a8[8], b8[8], cbv[8], un[8], o[8]; unpack8(rcc[tk], a8); unpack8(rcx[tk], b8); unpack8(rcb[tk], cbv);
#pragma unroll
        for (int k = 0; k < 8; ++k) { un[k] = hn ? a8[k] * b8[k] : 0.f; o[k] = cbv[k] * (up[k] * w0[k] + uc[k] * w1[k] + un[k] * w2[k] + bb[k]); up[k] = uc[k]; uc[k] = un[k]; }
        *(u32x4*)(AC + (size_t)t * 1024 + 512 + 8 * lane) = pack8(o); }
}
__device__ __forceinline__ void p3_attention(const Frame& F, const Args& a) {
    using namespace att;
    unsigned char* ws = a.ws;
    const bf16_t* PROJ = (const bf16_t*)(ws + WS_PROJ); bf16_t* AC = (bf16_t*)(ws + WS_AC);
    const float* cosT = (const float*)(ws + WS_ROPE); const float* sinT = cosT + SEQ * 8;
    const float* qg = a.in[3]; const float* kg = a.in[4]; const float* sink = a.in[5];
    const int lane = F.lane, wid = F.wave, r32 = lane & 31, hi = lane >> 5, l7 = lane & 7;
    const float bound = 8.0f * wave_max(fabsf(qg[lane])) * wave_max(fabsf(kg[lane])) * 1.4426950408889634f * 1.0001f;
    LAS char* lds = (LAS char*)F.lds; LAS float* wsf = (LAS float*)(lds + WSOFF) + wid * 64;
    const int g = wid >> 1, qsub = wid & 1;
    float gk8[8];
#pragma unroll
    for (int k = 0; k < 8; ++k) gk8[k] = kg[8 * l7 + k];
    for (int su = F.vcu; su < NB * NKV * 16; su += F.G) {
        const int n0 = (su & 15) * 4, hk = (su >> 4) & 1, b = su >> 5;
        const int h = hk * 4 + g; const float snk = sink[h] * 1.4426950408889634f; const float mref = fmaxf(bound, snk);
        const size_t rowbase = (size_t)b * SEQ;
        __syncthreads();
        { u32x4 kraw[NSLOT], vraw[NSLOT]; float kcs[NSLOT][2];
#pragma unroll
          for (int sl = 0; sl < NSLOT; ++sl) { const int j = n0 - 2 + sl; const bool ok = (j >= 0 && j < 64); const int jj = ok ? j : n0;
              const int key = 8 * wid + (lane >> 3), pos = 64 * jj + key;
              kraw[sl] = *(const u32x4*)(PROJ + (rowbase + pos) * PW + C_K + hk * 64 + l7 * 8);
              kcs[sl][0] = cosT[pos * 8 + l7]; kcs[sl][1] = sinT[pos * 8 + l7];
              vraw[sl] = *(const u32x4*)(PROJ + (rowbase + 64 * jj + 16 * (wid & 3) + (lane >> 2)) * PW + C_V + hk * 64 + (wid >> 2) * 32 + (lane & 3) * 8); }
#pragma unroll
          for (int sl = 0; sl < NSLOT; ++sl) { const int key = 8 * wid + (lane >> 3);
              const u32x4 kn = k_norm_rope(kraw[sl], gk8, kcs[sl][0], kcs[sl][1], l7, lane);
              *(LAS u32x4*)(lds + sl * 16384 + l7 * 1024 + key * 16) = kn;
              *(LAS u32x4*)(lds + sl * 16384 + 8192 + wid * 1024 + lane * 16) = vraw[sl]; } }
        __syncthreads();
#pragma unroll 1
        for (int uu = 0; uu < 4; ++uu) {
        const int n64 = n0 + uu;
        const int qs = n64 * 64 + qsub * 32;
        bf16x8 qr[4];
        { float qv[4][8]; float ss = 0.f; const int pos = qs + r32;
#pragma unroll
          for (int d0 = 0; d0 < 4; ++d0) { const u32x4 raw = *(const u32x4*)(PROJ + (rowbase + pos) * PW + C_Q + h * 64 + d0 * 16 + hi * 8); unpack8(raw, qv[d0]); }
          const f32x4 c0 = *(const f32x4*)(cosT + pos * 8), c1 = *(const f32x4*)(cosT + pos * 8 + 4), s0 = *(const f32x4*)(sinT + pos * 8), s1 = *(const f32x4*)(sinT + pos * 8 + 4);
#pragma unroll
          for (int d0 = 0; d0 < 4; ++d0)
#pragma unroll
              for (int k = 0; k < 8; ++k) ss += qv[d0][k] * qv[d0][k];
          ss += __shfl_xor(ss, 32);
          const float rstd = rsqrtf(ss * (1.f / 64.f) + EPS);
#pragma unroll
          for (int d0 = 0; d0 < 4; ++d0) { const f32x4 ga = *(const f32x4*)(qg + d0 * 16 + hi * 8), gb = *(const f32x4*)(qg + d0 * 16 + hi * 8 + 4); const float gg[8] = {ga.x, ga.y, ga.z, ga.w, gb.x, gb.y, gb.z, gb.w};
#pragma unroll
              for (int k = 0; k < 8; ++k) qv[d0][k] = qv[d0][k] * rstd * gg[k]; }
          const float cc[8] = {c0.x, c0.y, c0.z, c0.w, c1.x, c1.y, c1.z, c1.w}, sn[8] = {s0.x, s0.y, s0.z, s0.w, s1.x, s1.y, s1.z, s1.w};
#pragma unroll
          for (int k = 0; k < 8; ++k) { const float y = qv[0][k], p = __shfl_xor(y, 32); qv[0][k] = (hi == 0) ? (y * cc[k] - p * sn[k]) : (y * cc[k] + p * sn[k]); }
#pragma unroll
          for (int d0 = 0; d0 < 4; ++d0) {
#pragma unroll
              for (int k = 0; k < 8; ++k) qv[d0][k] *= QSCALE;
              qr[d0] = __builtin_bit_cast(bf16x8, pack8(qv[d0])); } }
        f32x16 o0 = {}, o1 = {}; float lsum = 0.f;
        const int qi = qs + r32;
#pragma unroll 1
        for (int sl = 0; sl < 5; ++sl) { const int j = n64 - 2 + sl; if (j < 0 || j >= 64) continue;
            const LAS char* tile = lds + (uu + sl) * 16384;
            const LAS char* kb = tile + hi * 1024 + r32 * 16;
            f32x16 p0 = {}, p1 = {};
#pragma unroll
            for (int d0 = 0; d0 < 4; ++d0) { const bf16x8 b0 = *(const LAS bf16x8*)(kb + d0 * 2048), b1 = *(const LAS bf16x8*)(kb + d0 * 2048 + 512);
                p0 = __builtin_amdgcn_mfma_f32_32x32x16_bf16(b0, qr[d0], p0, 0, 0, 0); p1 = __builtin_amdgcn_mfma_f32_32x32x16_bf16(b1, qr[d0], p1, 0, 0, 0); }
            if (sl == 0 || sl == 4) {
                const int kb0 = 64 * j + 4 * hi;
#pragma unroll
                for (int r = 0; r < 16; ++r) { const int kk = kb0 + (r & 3) + 8 * (r >> 2); const int d0_ = qi - kk, d1_ = qi - (kk + 32);
                    const bool v0 = (d0_ <= 128) && (d0_ >= -128), v1 = (d1_ <= 128) && (d1_ >= -128);
                    p0[r] = v0 ? __builtin_amdgcn_exp2f(p0[r] - mref) : 0.f; p1[r] = v1 ? __builtin_amdgcn_exp2f(p1[r] - mref) : 0.f; lsum += p0[r] + p1[r]; }
            } else {
#pragma unroll
                for (int r = 0; r < 16; ++r) { p0[r] = __builtin_amdgcn_exp2f(p0[r] - mref); p1[r] = __builtin_amdgcn_exp2f(p1[r] - mref); lsum += p0[r] + p1[r]; }
            }
            u32x4 pw0, pw1, pw2, pw3;
            pw0 = (u32x4){cvtpk(p0[0], p0[1]), cvtpk(p0[2], p0[3]), cvtpk(p0[4], p0[5]), cvtpk(p0[6], p0[7])};
            pw1 = (u32x4){cvtpk(p0[8], p0[9]), cvtpk(p0[10], p0[11]), cvtpk(p0[12], p0[13]), cvtpk(p0[14], p0[15])};
            pw2 = (u32x4){cvtpk(p1[0], p1[1]), cvtpk(p1[2], p1[3]), cvtpk(p1[4], p1[5]), cvtpk(p1[6], p1[7])};
            pw3 = (u32x4){cvtpk(p1[8], p1[9]), cvtpk(p1[10], p1[11]), cvtpk(p1[12], p1[13]), cvtpk(p1[14], p1[15])};
            const LAS char* vp = tile + 8192 + ((lane >> 4) & 1) * 32 + (lane & 3) * 8 + (4 * hi + ((lane & 15) >> 2)) * 64;
#pragma unroll
            for (int dh = 0; dh < 2; ++dh) {
#pragma unroll
                for (int ks = 0; ks < 4; ++ks) { const s16x4 lo = vtr(vp + dh * 4096 + ks * 1024), hh = vtr(vp + dh * 4096 + ks * 1024 + 512);
                    const bf16x8 vf = (bf16x8){lo[0], lo[1], lo[2], lo[3], hh[0], hh[1], hh[2], hh[3]};
                    const u32x4 pw = ks == 0 ? pw0 : ks == 1 ? pw1 : ks == 2 ? pw2 : pw3;
                    if (dh == 0) o0 = __builtin_amdgcn_mfma_f32_32x32x16_bf16(__builtin_bit_cast(bf16x8, pw), vf, o0, 0, 0, 0);
                    else o1 = __builtin_amdgcn_mfma_f32_32x32x16_bf16(__builtin_bit_cast(bf16x8, pw), vf, o1, 0, 0, 0); } }
        }
        lsum += __shfl_xor(lsum, 32); lsum += __builtin_amdgcn_exp2f(snk - mref);
        if (hi == 0) wsf[r32] = lsum;
        LDS_WAIT(); asm volatile("" ::: "memory");
        float rl[16];
#pragma unroll
        for (int r = 0; r < 16; ++r) rl[r] = __builtin_amdgcn_rcpf(wsf[crow(r, hi)]);
        LAS bf16_t* stg = (LAS bf16_t*)(lds + OSTOFF) + wid * 1024;
        bf16_t* Ow = AC + (rowbase + qs) * 1024 + h * 64;
#pragma unroll
        for (int dh = 0; dh < 2; ++dh) {
#pragma unroll
            for (int r = 0; r < 16; ++r) stg[crow(r, hi) * 32 + r32] = f2bf((dh ? o1[r] : o0[r]) * rl[r]);
            LDS_WAIT(); asm volatile("" ::: "memory");
#pragma unroll
            for (int i = 0; i < 2; ++i) { const int row = i * 16 + (lane >> 2), ch = lane & 3; const u32x4 v = *(const LAS u32x4*)(stg + row * 32 + ch * 8); *(u32x4*)(Ow + (size_t)row * 1024 + dh * 32 + ch * 8) = v; }
            LDS_WAIT(); asm volatile("" ::: "memory"); }
        }
    }
    __syncthreads();
    { const float* conv_w = a.in[6]; const float* conv_b = a.in[7];
      const int gw = F.vcu * NWAVES + wid, NGW = F.G * NWAVES;
      for (int ch = gw; ch < M / 16; ch += NGW) { const int t0 = ch * 16; float up[8], uc[8];
          { float a8[8], b8[8];
            if ((t0 & (SEQ - 1)) > 0) { unpack8(*(const u32x4*)(PROJ + (size_t)(t0 - 1) * PW + C_CC + 8 * lane), a8); unpack8(*(const u32x4*)(PROJ + (size_t)(t0 - 1) * PW + C_CX + 8 * lane), b8);
#pragma unroll
                for (int k = 0; k < 8; ++k) up[k] = a8[k] * b8[k]; } else {
#pragma unroll
                for (int k = 0; k < 8; ++k) up[k] = 0.f; }
            unpack8(*(const u32x4*)(PROJ + (size_t)t0 * PW + C_CC + 8 * lane), a8); unpack8(*(const u32x4*)(PROJ + (size_t)t0 * PW + C_CX + 8 * lane), b8);
#pragma unroll
            for (int k = 0; k < 8; ++k) uc[k] = a8[k] * b8[k]; }
          conv8(PROJ, AC, t0, lane, up, uc, conv_w, conv_b); conv8(PROJ, AC, t0 + 8, lane, up, uc, conv_w, conv_b); } }
    __syncthreads();
}

__device__ __forceinline__ void p6_route(const Frame& F, const Args& a) {
    unsigned char* ws = a.ws;
    const float* X1 = a.out; const float* g2 = a.in[11]; const float* b_rg = a.in[13]; const float* b_re = a.in[15];
    bf16_t* H2 = (bf16_t*)(ws + WS_H2); const bf16_t* WrT = (const bf16_t*)(ws + WS_WR);
    int* asg = (int*)(ws + WS_ASG); f32x2* rsg = (f32x2*)(ws + WS_RSG); unsigned* gcnt = (unsigned*)(ws + WS_CTL) + CW_CNT;
    const int lane = F.lane, wid = F.wave, r = lane & 15, kg = lane >> 4;
    constexpr int WR_PITCH = 2064, WR_BYTES = 48 * WR_PITCH, G2_OFF = WR_BYTES, LG_OFF = G2_OFF + 4096;
    LAS unsigned char* wrl = F.lds; LAS float* g2l = (LAS float*)(F.lds + G2_OFF); LAS float* lg = (LAS float*)(F.lds + LG_OFF) + wid * (16 * 48);
    LAS int* hist = (LAS int*)(F.lds + LDSCTL_OFF + LC_HIST); LAS int* base = (LAS int*)(F.lds + LDSCTL_OFF + LC_BASE);
    for (int i = F.tid; i < 48 * 128; i += NTHREADS) { const int row = i >> 7, c = i & 127; *(LAS u32x4*)(wrl + row * WR_PITCH + c * 16) = *(const u32x4*)(WrT + (size_t)row * D + c * 8); }
    for (int i = F.tid; i < 256; i += NTHREADS) *(LAS f32x4*)(g2l + 4 * i) = *(const f32x4*)(g2 + 4 * i);
    const int nblk = M / 128;
    for (int blk = F.vcu; blk < nblk; blk += F.G) {
        if (F.tid < 32) hist[F.tid] = 0;
        __syncthreads();
        const int row0 = blk * 128 + wid * 16;
        f32x4 acc[3] = {{0.f, 0.f, 0.f, 0.f}, {0.f, 0.f, 0.f, 0.f}, {0.f, 0.f, 0.f, 0.f}}; float ss = 0.f;
        const float* xr = X1 + (size_t)(row0 + r) * D + 8 * kg; bf16_t* hr = H2 + (size_t)(row0 + r) * D + 8 * kg;
        const LAS unsigned char* wb = wrl + r * WR_PITCH + 16 * kg; const LAS float* gl = g2l + 8 * kg;
#pragma unroll 1
        for (int s0 = 0; s0 < 32; s0 += 8) { f32x4 xv[8][2];
#pragma unroll
            for (int q = 0; q < 8; ++q) { xv[q][0] = *(const f32x4*)(xr + 32 * (s0 + q)); xv[q][1] = *(const f32x4*)(xr + 32 * (s0 + q) + 4); }
#pragma unroll
            for (int q = 0; q < 8; ++q) { const int s = s0 + q; const f32x4 x0 = xv[q][0], x1 = xv[q][1];
                const f32x4 ga = *(const LAS f32x4*)(gl + 32 * s), gb = *(const LAS f32x4*)(gl + 32 * s + 4);
                ss += (x0.x * x0.x + x0.y * x0.y) + (x0.z * x0.z + x0.w * x0.w) + (x1.x * x1.x + x1.y * x1.y) + (x1.z * x1.z + x1.w * x1.w);
                u32x4 w; w.x = cvtpk(x0.x * ga.x, x0.y * ga.y); w.y = cvtpk(x0.z * ga.z, x0.w * ga.w); w.z = cvtpk(x1.x * gb.x, x1.y * gb.y); w.w = cvtpk(x1.z * gb.z, x1.w * gb.w);
                *(u32x4*)(hr + 32 * s) = w; const bf16x8 af = __builtin_bit_cast(bf16x8, w);
#pragma unroll
                for (int j = 0; j < 3; ++j) { const bf16x8 bfr = *(const LAS bf16x8*)(wb + 16 * j * WR_PITCH + 64 * s); acc[j] = __builtin_amdgcn_mfma_f32_16x16x32_bf16(af, bfr, acc[j], 0, 0, 0); } } }
        ss += __shfl_xor(ss, 16); ss += __shfl_xor(ss, 32);
        const float rstd = rsqrtf(ss * (1.f / D) + EPS);
#pragma unroll
        for (int j = 0; j < 3; ++j)
#pragma unroll
            for (int i = 0; i < 4; ++i) lg[(4 * kg + i) * 48 + 16 * j + r] = acc[j][i];
        LDS_WAIT(); asm volatile("" ::: "memory");
        int e0 = 0, e1 = 0, rk0 = 0, rk1 = 0; float gt0 = 0.f, gt1 = 0.f;
        if (lane < 16) {
            const LAS float* L = lg + lane * 48;
            float gl4[4]; int grp = 0; float gm;
#pragma unroll
            for (int i = 0; i < 4; ++i) gl4[i] = L[i] * rstd + b_rg[i];
            gm = gl4[0];
#pragma unroll
            for (int i = 1; i < 4; ++i) if (gl4[i] > gm) { gm = gl4[i]; grp = i; }
            float gs = 0.f;
#pragma unroll
            for (int i = 0; i < 4; ++i) gs += __expf(gl4[i] - gm);
            const float pg = 1.0f / gs;
            float el[8];
#pragma unroll
            for (int i = 0; i < 8; ++i) el[i] = L[4 + grp * 8 + i] * rstd + b_re[grp * 8 + i];
            int i0 = 0; float m0 = el[0];
#pragma unroll
            for (int i = 1; i < 8; ++i) if (el[i] > m0) { m0 = el[i]; i0 = i; }
            int i1 = -1; float m1 = -3.0e38f;
#pragma unroll
            for (int i = 0; i < 8; ++i) if (i != i0 && el[i] > m1) { m1 = el[i]; i1 = i; }
            const float ex1 = __expf(m1 - m0); const float den = 1.0f / (1.0f + ex1);
            gt0 = pg * den; gt1 = pg * ex1 * den; e0 = grp * 8 + i0; e1 = grp * 8 + i1;
            rk0 = __hip_atomic_fetch_add(&hist[e0], 1, __ATOMIC_RELAXED, __HIP_MEMORY_SCOPE_WORKGROUP);
            rk1 = __hip_atomic_fetch_add(&hist[e1], 1, __ATOMIC_RELAXED, __HIP_MEMORY_SCOPE_WORKGROUP);
        }
        __syncthreads();
        if (F.tid < 32) { const int n = hist[F.tid]; int bs = 0; if (n > 0) bs = (int)__hip_atomic_fetch_add(gcnt + F.tid, (unsigned)n, __ATOMIC_RELAXED, __HIP_MEMORY_SCOPE_AGENT); base[F.tid] = bs; }
        __syncthreads();
        if (lane < 16) { const int tok = row0 + lane;
            const size_t p0 = (size_t)e0 * CAP + base[e0] + rk0, p1 = (size_t)e1 * CAP + base[e1] + rk1;
            asg[p0] = tok * 2; asg[p1] = tok * 2 + 1; rsg[p0] = (f32x2){gt0, rstd}; rsg[p1] = (f32x2){gt1, rstd}; }
        __syncthreads();
    }
}

__device__ __forceinline__ void moe_tables(const Frame& F, const Args& a) {
    const unsigned* gcnt = (const unsigned*)(a.ws + WS_CTL) + CW_CNT;
    LAS int* mtpre = (LAS int*)(F.lds + LDSCTL_OFF + LC_MTPRE); LAS int* cnt = (LAS int*)(F.lds + LDSCTL_OFF + LC_CNT);
    __syncthreads();
    if (F.tid == 0) { int acc = 0; for (int e = 0; e < 32; ++e) { const int n = (int)__hip_atomic_load(gcnt + e, __ATOMIC_RELAXED, __HIP_MEMORY_SCOPE_AGENT); cnt[e] = n; mtpre[e] = acc; acc += (n + 255) >> 8; } mtpre[32] = acc; }
    __syncthreads();
}

__device__ __forceinline__ void p9_combine(const Frame& F, const Args& a, bool dummy = false) {
    float* out = a.out; float* lo_dst = dummy ? (float*)(a.ws + WS_AC) : a.out; float* hi_dst = dummy ? (float*)(a.ws + WS_MERGED) - (size_t)(M / 2) * D : a.out; const bf16_t* Y = (const bf16_t*)(a.ws + WS_Y);
    const unsigned gt = (unsigned)F.vcu * NTHREADS + F.tid, NGT = (unsigned)F.G * NTHREADS, TOT = (unsigned)M * 128u;
    for (unsigned i0 = gt; i0 < TOT; i0 += 4 * NGT) {
        f32x4 xa[4], xb[4]; u32x4 y0[4], y1[4];
#pragma unroll
        for (int k = 0; k < 4; ++k) { const unsigned i = i0 + k * NGT, ii = i < TOT ? i : gt; const size_t tok = ii >> 7, c8 = (ii & 127) * 8;
            xa[k] = *(const f32x4*)(out + tok * D + c8); xb[k] = *(const f32x4*)(out + tok * D + c8 + 4);
            y0[k] = *(const u32x4*)(Y + (tok * 2) * D + c8); y1[k] = *(const u32x4*)(Y + (tok * 2 + 1) * D + c8); }
#pragma unroll
        for (int k = 0; k < 4; ++k) { const unsigned i = i0 + k * NGT; if (i < TOT) { const size_t tok = i >> 7, c8 = (i & 127) * 8; f32x4 x0 = xa[k], x1 = xb[k];
            x0.x += bflo(y0[k].x) + bflo(y1[k].x); x0.y += bfhi(y0[k].x) + bfhi(y1[k].x); x0.z += bflo(y0[k].y) + bflo(y1[k].y); x0.w += bfhi(y0[k].y) + bfhi(y1[k].y);
            x1.x += bflo(y0[k].z) + bflo(y1[k].z); x1.y += bfhi(y0[k].z) + bfhi(y1[k].z); x1.z += bflo(y0[k].w) + bflo(y1[k].w); x1.w += bfhi(y0[k].w) + bfhi(y1[k].w);
            float* dst = (tok < (size_t)(M / 2)) ? lo_dst : hi_dst; *(f32x4*)(dst + tok * D + c8) = x0; *(f32x4*)(dst + tok * D + c8 + 4) = x1; } }
    }
}

constexpr int N_PHASES = 10;
__global__ void __launch_bounds__(NTHREADS, 2) fwd_kernel(Args args) {
    extern __shared__ __attribute__((aligned(16))) unsigned char lds_raw[];
    Frame F; F.lds = (LAS unsigned char*)lds_raw; F.tid = threadIdx.x; F.lane = F.tid & 63; F.wave = __builtin_amdgcn_readfirstlane(F.tid >> 6);
    F.G = gridDim.x; { const int bx = blockIdx.x; F.vcu = (F.G % 8 == 0) ? (bx % 8) * (F.G / 8) + bx / 8 : bx; }
    for (int u = F.tid; u < (LDS_BYTES - LDSCTL_OFF) / 4; u += NTHREADS) ((LAS unsigned*)(F.lds + LDSCTL_OFF))[u] = 0u;
    __syncthreads();
    unsigned char* ws = args.ws;
    const int lo = args.ph_lo, hi = args.ph_hi;
#ifndef PH_MASK
#define PH_MASK 0x3ff
#endif
#define IN(k) (((PH_MASK >> (k)) & 1) && lo <= (k) && (k) < hi)
#if MK_USE_CG
#define GRID_BAR(k) do { if (IN(k) && IN((k) + 1)) { cg::this_grid().sync(); } } while (0)
#else
    XcdBarrier bar; bar.bar = (unsigned*)(ws + WS_CTL) + CW_BAR; bar.x = 0; bar.st = nullptr;
    if (hi - lo > 1) bar = xcd_barrier_post((unsigned*)(ws + WS_CTL) + CW_BAR, (volatile LAS unsigned*)(F.lds + LDSCTL_OFF + LC_MISC) + 8);
#define GRID_BAR(k) do { if (IN(k) && IN((k) + 1)) { xcd_barrier(bar); } } while (0)
#endif
    const LAS int* mtpre = (const LAS int*)(F.lds + LDSCTL_OFF + LC_MTPRE); const LAS int* lcnt = (const LAS int*)(F.lds + LDSCTL_OFF + LC_CNT);

#define REP(k) for (int rep_ = 0; rep_ < args.rep[k]; ++rep_)
#define REPBAR() do { if (rep_) xcd_barrier(bar); } while (0)
    if (IN(0)) REP(0) { REPBAR(); p0_prologue(F, args); } GRID_BAR(0);
    if (IN(1)) REP(1) { REPBAR(); pg8::PlainOrder S{(const bf16_t*)(ws + WS_XN), (const bf16_t*)(ws + WS_WIN), 1024, 1024, M / 256, PW / 256, F.G, (int)blockIdx.x};
        pg8::EpiProj E{(bf16_t*)(ws + WS_PROJ)};
        pg8::gemm_phase<pg8::EpiProj, pg8::PlainOrder, true>(F.lds, 1024, 1024, 1024, S, E); } GRID_BAR(1);
    if (IN(3)) REP(3) { REPBAR(); p3_attention(F, args); } GRID_BAR(3);
    if (IN(4)) REP(4) { REPBAR(); pg8::PlainOrder S{(const bf16_t*)(ws + WS_AC), (const bf16_t*)(ws + WS_WA), 1024, 1024, M / 256, D / 256, F.G, (int)blockIdx.x};
        pg8::EpiGate2 E{(const bf16_t*)(ws + WS_PROJ), (bf16_t*)(ws + WS_MERGED)};
        pg8::gemm_phase<pg8::EpiGate2, pg8::PlainOrder, true>(F.lds, 1024, 1024, 1024, S, E); } GRID_BAR(4);
    if (IN(5)) REP(5) { REPBAR(); pg8::PlainOrder S{(const bf16_t*)(ws + WS_MERGED), (const bf16_t*)(ws + WS_WOUT), 1024, 1024, M / 256, D / 256, F.G, (int)blockIdx.x};
        pg8::EpiRes E{args.in[0], args.out};
        pg8::gemm_phase<pg8::EpiRes, pg8::PlainOrder, true>(F.lds, 1024, 1024, 1024, S, E); } GRID_BAR(5);
    if (IN(6)) REP(6) { if (rep_) { xcd_barrier(bar); if (blockIdx.x == 0 && F.tid < 32) ((unsigned*)(ws + WS_CTL) + CW_CNT)[F.tid] = 0u; xcd_barrier(bar); } p6_route(F, args); } GRID_BAR(6);
    if (IN(7)) REP(7) { REPBAR(); moe_tables(F, args);
        pg8::MoeGuOrder S; S.mtpre = mtpre; S.cnt = lcnt; S.NT = 2; S.G = F.G; S.c = (int)blockIdx.x; S.H2 = (const bf16_t*)(ws + WS_H2); S.Wgu = (const bf16_t*)(ws + WS_WGU); S.asg = (const int*)(ws + WS_ASG);
        pg8::EpiGU E{(bf16_t*)(ws + WS_HID), (const f32x2*)(ws + WS_RSG), mtpre};
        pg8::gemm_phase<pg8::EpiGU, pg8::MoeGuOrder, true>(F.lds, 1024, 1024, 1024, S, E); } GRID_BAR(7);
    if (IN(8)) REP(8) { REPBAR(); moe_tables(F, args);
        pg8::MoeDownOrder S; S.mtpre = mtpre; S.cnt = lcnt; S.NT = 4; S.G = F.G; S.c = (int)blockIdx.x; S.HID = (const bf16_t*)(ws + WS_HID); S.Wd = (const bf16_t*)(ws + WS_WD);
        pg8::EpiDown E{(bf16_t*)(ws + WS_Y), (const int*)(ws + WS_ASG), (const f32x2*)(ws + WS_RSG), mtpre};
        pg8::gemm_phase<pg8::EpiDown, pg8::MoeDownOrder, true, true>(F.lds, 256, 256, 256, S, E); } GRID_BAR(8);
    if (IN(9)) { if (args.rep[9] > 1) { p9_combine(F, args, true); xcd_barrier(bar); } p9_combine(F, args); }
#undef IN
#undef GRID_BAR
}

extern "C" void kernel_launch(void* const* d_in, const int* in_sizes, int n_in, void* d_out, int out_size, void* d_ws, size_t ws_size, hipStream_t stream) {
    static int grid = 0;
    if (grid == 0) {
        if (n_in != 19 || in_sizes[0] != M * D || out_size != M * D || ws_size < WS_END) { fprintf(stderr, "kernel_launch: unexpected shapes (n_in %d, in0 %d, out %d, ws %zu)\n", n_in, n_in > 0 ? in_sizes[0] : -1, out_size, ws_size); grid = -1; return; }
        int dev = 0, cus = 0, per_cu = 0;
        if (hipGetDevice(&dev) != hipSuccess || hipDeviceGetAttribute(&cus, hipDeviceAttributeMultiprocessorCount, dev) != hipSuccess) { grid = -1; return; }
        if (hipFuncSetAttribute((const void*)fwd_kernel, hipFuncAttributeMaxDynamicSharedMemorySize, LDS_BYTES) != hipSuccess) { fprintf(stderr, "kernel_launch: hipFuncSetAttribute failed\n"); grid = -1; return; }
        if (hipOccupancyMaxActiveBlocksPerMultiprocessor(&per_cu, (const void*)fwd_kernel, NTHREADS, LDS_BYTES) != hipSuccess || per_cu < 1) { fprintf(stderr, "kernel_launch: occupancy query says %d\n", per_cu); per_cu = 1; }
        (void)hipGetLastError();
        grid = cus * 1;
        fprintf(stderr, "kernel_launch: cus %d per_cu %d grid %d\n", cus, per_cu, grid);
    }
    if (grid < 0) return;
    (void)hipMemsetAsync((char*)d_ws + WS_CTL, 0, CTL_ZERO_BYTES, stream);
    Args a{};
    for (int i = 0; i < 19; ++i) a.in[i] = (const float*)d_in[i];
    a.out = (float*)d_out; a.ws = (unsigned char*)d_ws;
    for (int i = 0; i < 10; ++i) a.rep[i] = (i == PROBE_DUP) ? 2 : 1;
#if MK_N_LAUNCHES == 1
    a.ph_lo = 0; a.ph_hi = N_PHASES;
    void* kargs[] = {&a};
#if MK_USE_CG
    hipError_t e = hipLaunchCooperativeKernel((const void*)fwd_kernel, dim3(grid), dim3(NTHREADS), kargs, LDS_BYTES, stream);
    if (e != hipSuccess) fprintf(stderr, "kernel_launch: cooperative launch failed: %s\n", hipGetErrorString(e));
#else
    (void)kargs; hipLaunchKernelGGL(fwd_kernel, dim3(grid), dim3(NTHREADS), LDS_BYTES, stream, a);
#endif
#else
    for (int p = 0; p < N_PHASES; ++p) { a.ph_lo = p; a.ph_hi = p + 1; hipLaunchKernelGGL(fwd_kernel, dim3(grid), dim3(NTHREADS), LDS_BYTES, stream, a); }
#endif
}
```

```cpp
#include <hip/hip_runtime.h>
#include <hip/hip_cooperative_groups.h>
#include <cstdio>
#include <cstdint>
namespace cg = cooperative_groups;

#ifndef PROBE_DUP
#define PROBE_DUP -1
#endif
#ifndef MK_N_LAUNCHES
#define MK_N_LAUNCHES 1
#endif

#define LAS __attribute__((address_space(3)))
#define GAS __attribute__((address_space(1)))
typedef unsigned short bf16_t;
typedef short bf16x8 __attribute__((ext_vector_type(8)));
typedef short s16x4 __attribute__((ext_vector_type(4)));
typedef float f32x4 __attribute__((ext_vector_type(4)));
typedef float f32x2 __attribute__((ext_vector_type(2)));
typedef float f32x16 __attribute__((ext_vector_type(16)));
typedef unsigned u32x4 __attribute__((ext_vector_type(4)));
typedef unsigned u32x2 __attribute__((ext_vector_type(2)));
typedef __bf16 bf16x2_t __attribute__((ext_vector_type(2)));

constexpr int NB = 8, SEQ = 4096, M = NB * SEQ, D = 1024, PW = 4352;
constexpr int NH = 8, NKV = 2, HD = 64, AD = 512, CD = 512;
constexpr int C_Q = 0, C_K = 512, C_V = 640, C_CB = 768, C_CC = 1280, C_CX = 1792, C_GA = 2304;
constexpr int NE = 32, DFF = 256, CAP = 32768;
constexpr float EPS = 1e-6f;
constexpr float QSCALE = 0.125f * 1.4426950408889634f;
constexpr int NWAVES = 8, NTHREADS = 512;

constexpr size_t MiB = 1u << 20;
constexpr size_t WS_CTL = 0, CTL_ZERO_BYTES = 64 * 1024;
constexpr size_t WS_ROPE = 1 * MiB;
constexpr size_t WS_WR = 1 * MiB + 256 * 1024;
constexpr size_t WS_WIN = 2 * MiB;
constexpr size_t WS_WA = 11 * MiB, WS_WC = 12 * MiB;
constexpr size_t WS_WOUT = 13 * MiB;
constexpr size_t WS_WGU = 16 * MiB;
constexpr size_t WS_WD = 48 * MiB;
constexpr size_t WS_XN = 64 * MiB;
constexpr size_t WS_AC = 64 * MiB;
constexpr size_t WS_PROJ = 128 * MiB;
constexpr size_t WS_H2 = 128 * MiB;
constexpr size_t WS_HID = 192 * MiB;
constexpr size_t WS_Y = 232 * MiB;
constexpr size_t WS_QN = 400 * MiB;
constexpr size_t WS_KN = 432 * MiB;
constexpr size_t WS_MERGED = 400 * MiB;
constexpr size_t WS_ASG = 464 * MiB;
constexpr size_t WS_RSG = 468 * MiB;
constexpr size_t WS_END = 476 * MiB;
constexpr int CW_CNT = 1024;
constexpr int CW_BAR = 4096;

constexpr int RING_BYTES = 131072;
constexpr int LDSCTL_OFF = RING_BYTES;
constexpr int LC_MISC = 0;
constexpr int LC_MTPRE = 128;
constexpr int LC_CNT = 128 + 160;
constexpr int LC_HIST = LC_CNT + 128;
constexpr int LC_BASE = LC_HIST + 128;
constexpr int LDS_BYTES = 163840;

__device__ __forceinline__ unsigned cvtpk(float lo, float hi) { f32x2 v = {lo, hi}; bf16x2_t b = __builtin_convertvector(v, bf16x2_t); return __builtin_bit_cast(unsigned, b); }
__device__ __forceinline__ bf16_t f2bf(float f) { return (bf16_t)(cvtpk(f, 0.f) & 0xffffu); }
__device__ __forceinline__ float bf2f(unsigned h) { return __builtin_bit_cast(float, h << 16); }
__device__ __forceinline__ float bflo(unsigned w) { return __builtin_bit_cast(float, w << 16); }
__device__ __forceinline__ float bfhi(unsigned w) { return __builtin_bit_cast(float, w & 0xffff0000u); }
__device__ __forceinline__ float wave_sum(float v) {
#pragma unroll
    for (int o = 1; o < 64; o <<= 1) v += __shfl_xor(v, o);
    return v;
}
__device__ __forceinline__ float wave_max(float v) {
#pragma unroll
    for (int o = 1; o < 64; o <<= 1) v = fmaxf(v, __shfl_xor(v, o));
    return v;
}
__device__ __forceinline__ float sigmoidf_(float v) { return __builtin_amdgcn_rcpf(1.0f + __builtin_amdgcn_exp2f(-1.4426950408889634f * v)); }
__device__ __forceinline__ void unpack8(const u32x4 w, float (&v)[8]) { v[0] = bflo(w.x); v[1] = bfhi(w.x); v[2] = bflo(w.y); v[3] = bfhi(w.y); v[4] = bflo(w.z); v[5] = bfhi(w.z); v[6] = bflo(w.w); v[7] = bfhi(w.w); }
__device__ __forceinline__ u32x4 pack8(const float (&v)[8]) { u32x4 w; w.x = cvtpk(v[0], v[1]); w.y = cvtpk(v[2], v[3]); w.z = cvtpk(v[4], v[5]); w.w = cvtpk(v[6], v[7]); return w; }
#define LDS_WAIT() asm volatile("s_waitcnt lgkmcnt(0)" ::: "memory")
#define VM_WAIT() asm volatile("s_waitcnt vmcnt(0)" ::: "memory")

namespace pg8 {
constexpr int BM = 256, BK = 64, HALF = 128, HTB = HALF * BK * 2, STAGE_BYTES = 8 * HTB, NXCD = 8, WGM = 8;
__host__ __device__ __forceinline__ int lds_byte(int r, int c) { const int st = (r >> 4) * 2 + (c >> 5), rr = r & 15, cc = c & 31, ob = rr * 64 + cc * 2; return st * 1024 + (ob ^ (((ob >> 9) & 1) << 5)); }
__host__ __device__ __forceinline__ void stage_rc(int b, int& R, int& C) { const int st = b / 1024, sb = b % 1024, swz = sb ^ (((sb >> 9) & 1) << 5); R = (st >> 1) * 16 + swz / 64; C = (st & 1) * 32 + (swz % 64) / 2; }
__host__ __device__ __forceinline__ int perm32(int rho) { const int n = rho >> 4, i = rho & 15; return 8 * (i >> 2) + 4 * n + (i & 3); }

struct Unit { int pm, pn, z, valid; };

__device__ __forceinline__ void tile_of(int L, int nM, int nN, int& pm, int& pn) {
    const int nwg = nM * nN; int wgid = L;
    { const int q = nwg / NXCD, r = nwg % NXCD, xcd = wgid % NXCD, off = wgid / NXCD; wgid = (xcd < r ? xcd * (q + 1) : r * (q + 1) + (xcd - r) * q) + off; }
    const int nig = WGM * nN, gid = wgid / nig, fm = gid * WGM, gsz = (nM - fm) < WGM ? (nM - fm) : WGM;
    pm = fm + ((wgid % nig) % gsz); pn = (wgid % nig) / gsz;
}

struct PlainOrder {
    static constexpr bool GATHER = false;
    const bf16_t* A; const bf16_t* Bt; int lda, ldb, nM, nN, G, c;
    __device__ __forceinline__ bool next(int i, Unit& u) const { const int L = i * G + c; if (L >= nM * nN) return false; tile_of(L, nM, nN, u.pm, u.pn); u.z = 0; u.valid = 256; return true; }
    __device__ __forceinline__ void ptrs(const Unit& u, const char*& a, const char*& b) const { a = (const char*)(A + (size_t)u.pm * 256 * lda); b = (const char*)(Bt + (size_t)u.pn * 256 * ldb); }
    __device__ __forceinline__ void avoff(const Unit&, const int (&R)[2], const int (&C)[2], unsigned (&v)[2][2]) const {
#pragma unroll
        for (int h = 0; h < 2; ++h)
#pragma unroll
            for (int i = 0; i < 2; ++i) v[h][i] = (unsigned)(R[i] * lda + C[i]) * 2u;
    }
};
struct DualOrder {
    static constexpr bool GATHER = false;
    const bf16_t* AC; const bf16_t* Wa; const bf16_t* Wc; int G, c;
    __device__ __forceinline__ bool next(int i, Unit& u) const { const int L = (i >> 1) * G + c; if (L >= 128 * 4) return false; tile_of(L, 128, 4, u.pm, u.pn); u.z = i & 1; u.valid = 256; return true; }
    __device__ __forceinline__ void ptrs(const Unit& u, const char*& a, const char*& b) const { a = (const char*)(AC + (size_t)u.pm * 256 * 1024 + u.z * 512); b = (const char*)((u.z ? Wc : Wa) + (size_t)u.pn * 256 * 512); }
    __device__ __forceinline__ void avoff(const Unit&, const int (&R)[2], const int (&C)[2], unsigned (&v)[2][2]) const {
#pragma unroll
        for (int h = 0; h < 2; ++h)
#pragma unroll
            for (int i = 0; i < 2; ++i) v[h][i] = (unsigned)(R[i] * 1024 + C[i]) * 2u;
    }
};
struct MoeOrder {
    const LAS int* mtpre; const LAS int* cnt; int NT, G, c;
    __device__ __forceinline__ bool locate(int i, Unit& u) const {
        const int L = i * G + c; const int U = mtpre[32] * NT; if (L >= U) return false;
        const int tg = L / NT; u.pn = L - tg * NT; int e = 0;
#pragma unroll 1
        for (int j = 1; j < 32; ++j) e += (mtpre[j] <= tg) ? 1 : 0;
        u.z = e; u.pm = tg; const int mt = tg - mtpre[e]; const int left = cnt[e] - mt * 256; u.valid = left < 256 ? left : 256; return true;
    }
};
struct MoeGuOrder : MoeOrder {
    static constexpr bool GATHER = true;
    const bf16_t* H2; const bf16_t* Wgu; const int* asg;
    __device__ __forceinline__ bool next(int i, Unit& u) const { return locate(i, u); }
    __device__ __forceinline__ void ptrs(const Unit& u, const char*& a, const char*& b) const { a = (const char*)H2; b = (const char*)(Wgu + ((size_t)u.z * 512 + (size_t)u.pn * 256) * 1024); }
    __device__ __forceinline__ void avoff(const Unit& u, const int (&R)[2], const int (&C)[2], unsigned (&v)[2][2]) const {
        const int mt = u.pm - mtpre[u.z]; const int* ap = asg + ((size_t)u.z * CAP + mt * 256);
#pragma unroll
        for (int h = 0; h < 2; ++h)
#pragma unroll
            for (int i = 0; i < 2; ++i) { const unsigned r = (unsigned)(h * 128 + R[i]); int tok = 0; if ((int)r < u.valid) tok = ap[r] >> 1; v[h][i] = (unsigned)(tok * 1024 + C[i]) * 2u; }
    }
};
struct MoeDownOrder : MoeOrder {
    static constexpr bool GATHER = false;
    const bf16_t* HID; const bf16_t* Wd;
    __device__ __forceinline__ bool next(int i, Unit& u) const { return locate(i, u); }
    __device__ __forceinline__ void ptrs(const Unit& u, const char*& a, const char*& b) const { a = (const char*)(HID + (size_t)u.pm * 256 * 256); b = (const char*)(Wd + ((size_t)u.z * 1024 + (size_t)u.pn * 256) * 256); }
    __device__ __forceinline__ void avoff(const Unit&, const int (&R)[2], const int (&C)[2], unsigned (&v)[2][2]) const {
#pragma unroll
        for (int h = 0; h < 2; ++h)
#pragma unroll
            for (int i = 0; i < 2; ++i) v[h][i] = (unsigned)(R[i] * 256 + C[i]) * 2u;
    }
};

typedef f32x4 Acc[2][2][4][2];

struct EpiProj {
    static constexpr bool PERM = true, HAS_MID = false;
    bf16_t* O;
    __device__ __forceinline__ void operator()(const Acc& acc, const Unit& u, int wr, int wc, int fr, int fq) const {
        bf16_t* base = O + (size_t)u.pm * BM * PW + u.pn * BM;
        unsigned l0 = (unsigned)((wr * 64 + fr) * PW + wc * 32 + 8 * fq); asm volatile("" : "+v"(l0)); const bool sg = u.pn >= 9;
#pragma unroll
        for (int ai = 0; ai < 2; ++ai)
#pragma unroll
            for (int m = 0; m < 4; ++m)
#pragma unroll
                for (int bj = 0; bj < 2; ++bj) { f32x4 v0 = acc[ai][bj][m][0], v1 = acc[ai][bj][m][1];
                    if (sg) {
#pragma unroll
                        for (int k = 0; k < 4; ++k) { v0[k] = sigmoidf_(v0[k]); v1[k] = sigmoidf_(v1[k]); } }
                    u32x4 w; w.x = cvtpk(v0[0], v0[1]); w.y = cvtpk(v0[2], v0[3]); w.z = cvtpk(v1[0], v1[1]); w.w = cvtpk(v1[2], v1[3]);
                    *(u32x4*)(base + (l0 + (unsigned)((ai * HALF + m * 16) * PW + bj * HALF))) = w; }
    }
};
struct EpiGate2 {
    static constexpr bool PERM = true, HAS_MID = true;
    const bf16_t* PROJ; bf16_t* MG;
    __device__ __forceinline__ void mid(Acc& acc, const Unit& u, int wr, int wc, int fr, int fq) const {
        const bf16_t* gbase = PROJ + (size_t)u.pm * BM * PW + C_GA + u.pn * BM;
        unsigned lg = (unsigned)((wr * 64 + fr) * PW + wc * 32 + 8 * fq); asm volatile("" : "+v"(lg));
#pragma unroll
        for (int ai = 0; ai < 2; ++ai) { u32x4 ga[4][2], gc[4][2];
#pragma unroll
            for (int m = 0; m < 4; ++m)
#pragma unroll
                for (int bj = 0; bj < 2; ++bj) { const unsigned o = lg + (unsigned)((ai * HALF + m * 16) * PW + bj * HALF); ga[m][bj] = *(const u32x4*)(gbase + o); gc[m][bj] = *(const u32x4*)(gbase + 1024 + o); }
#pragma unroll
            for (int m = 0; m < 4; ++m)
#pragma unroll
                for (int bj = 0; bj < 2; ++bj) { float a8[8], c8[8]; unpack8(ga[m][bj], a8); unpack8(gc[m][bj], c8);
#pragma unroll
                    for (int k = 0; k < 8; ++k) { const float r = a8[k] * __builtin_amdgcn_rcpf(fmaxf(c8[k], 9.5367431640625e-07f)); if (k < 4) acc[ai][bj][m][0][k] *= r; else acc[ai][bj][m][1][k - 4] *= r; } }
            asm volatile("" ::: "memory"); }
    }
    __device__ __forceinline__ void operator()(const Acc& acc, const Unit& u, int wr, int wc, int fr, int fq) const {
        const bf16_t* gbase = PROJ + (size_t)u.pm * BM * PW + C_GA + 1024 + u.pn * BM;
        bf16_t* ob = MG + (size_t)u.pm * BM * 1024 + u.pn * BM;
        unsigned lg = (unsigned)((wr * 64 + fr) * PW + wc * 32 + 8 * fq), lt = (unsigned)((wr * 64 + fr) * 1024 + wc * 32 + 8 * fq); asm volatile("" : "+v"(lg), "+v"(lt));
        u32x4 gc[2][4][2];
#pragma unroll
        for (int ai = 0; ai < 2; ++ai)
#pragma unroll
            for (int m = 0; m < 4; ++m)
#pragma unroll
                for (int bj = 0; bj < 2; ++bj) gc[ai][m][bj] = *(const u32x4*)(gbase + (lg + (unsigned)((ai * HALF + m * 16) * PW + bj * HALF)));
#pragma unroll
        for (int ai = 0; ai < 2; ++ai)
#pragma unroll
            for (int m = 0; m < 4; ++m)
#pragma unroll
                for (int bj = 0; bj < 2; ++bj) { float c8[8]; unpack8(gc[ai][m][bj], c8); float v[8];
#pragma unroll
                    for (int k = 0; k < 8; ++k) v[k] = (k < 4 ? acc[ai][bj][m][0][k] : acc[ai][bj][m][1][k - 4]) * fmaxf(c8[k], 9.5367431640625e-07f);
                    *(u32x4*)(ob + (lt + (unsigned)((ai * HALF + m * 16) * 1024 + bj * HALF))) = pack8(v); }
    }
};
struct EpiRes {
    static constexpr bool PERM = false, HAS_MID = false;
    const float* X; float* O;
    __device__ __forceinline__ void operator()(const Acc& acc, const Unit& u, int wr, int wc, int fr, int fq) const {
        const size_t tb = (size_t)u.pm * BM * D + u.pn * BM; const float* xb = X + tb; float* ob = O + tb;
        unsigned l0 = (unsigned)((wr * 64 + fr) * D + wc * 32 + 4 * fq); asm volatile("" : "+v"(l0));
#pragma unroll
        for (int ai = 0; ai < 2; ++ai) { f32x4 xv[4][2][2];
#pragma unroll
            for (int m = 0; m < 4; ++m)
#pragma unroll
                for (int bj = 0; bj < 2; ++bj)
#pragma unroll
                    for (int n = 0; n < 2; ++n) xv[m][bj][n] = *(const f32x4*)(xb + (l0 + (unsigned)((ai * HALF + m * 16) * D + bj * HALF + n * 16)));
#pragma unroll
            for (int m = 0; m < 4; ++m)
#pragma unroll
                for (int bj = 0; bj < 2; ++bj)
#pragma unroll
                    for (int n = 0; n < 2; ++n) *(f32x4*)(ob + (l0 + (unsigned)((ai * HALF + m * 16) * D + bj * HALF + n * 16))) = xv[m][bj][n] + acc[ai][bj][m][n];
            asm volatile("" ::: "memory"); }
    }
};
struct EpiGU {
    static constexpr bool PERM = true, HAS_MID = false;
    bf16_t* HID; const f32x2* rsg; const LAS int* mtpre;
    __device__ __forceinline__ void operator()(const Acc& acc, const Unit& u, int wr, int wc, int fr, int fq) const {
        const int mt = u.pm - mtpre[u.z]; const f32x2* rp = rsg + ((size_t)u.z * CAP + mt * 256);
        bf16_t* hb = HID + (size_t)u.pm * 256 * 256 + u.pn * 128;
        int r0 = wr * 64 + fr; asm volatile("" : "+v"(r0)); const unsigned l0 = (unsigned)(r0 * 256 + wc * 32 + 8 * fq);
        float rsv[2][4];
#pragma unroll
        for (int ai = 0; ai < 2; ++ai)
#pragma unroll
            for (int m = 0; m < 4; ++m) { const int r = r0 + ai * HALF + m * 16; const float t = rp[(unsigned)(r < u.valid ? r : 0)].y; rsv[ai][m] = r < u.valid ? t : 0.f; }
#pragma unroll
        for (int ai = 0; ai < 2; ++ai)
#pragma unroll
            for (int m = 0; m < 4; ++m) { const int r = r0 + ai * HALF + m * 16;
                const float rs = rsv[ai][m];
                const f32x4 g0 = acc[ai][0][m][0] * rs, g1 = acc[ai][0][m][1] * rs, u0 = acc[ai][1][m][0] * rs, u1 = acc[ai][1][m][1] * rs;
                float h[8];
#pragma unroll
                for (int k = 0; k < 4; ++k) { h[k] = g0[k] * sigmoidf_(g0[k]) * u0[k]; h[4 + k] = g1[k] * sigmoidf_(g1[k]) * u1[k]; }
                u32x4 w; w.x = cvtpk(h[0], h[1]); w.y = cvtpk(h[2], h[3]); w.z = cvtpk(h[4], h[5]); w.w = cvtpk(h[6], h[7]);
                *(u32x4*)(hb + (l0 + (unsigned)((ai * HALF + m * 16) * 256))) = w; }
    }
};
struct EpiDown {
    static constexpr bool PERM = true, HAS_MID = false;
    bf16_t* Y; const int* asg; const f32x2* rsg; const LAS int* mtpre;
    __device__ __forceinline__ void operator()(const Acc& acc, const Unit& u, int wr, int wc, int fr, int fq) const {
        const int mt = u.pm - mtpre[u.z]; const size_t pb = (size_t)u.z * CAP + mt * 256; const int* ap = asg + pb; const f32x2* rp = rsg + pb;
        bf16_t* yb = Y + u.pn * BM;
        int r0 = wr * 64 + fr; unsigned c0 = (unsigned)(wc * 32 + 8 * fq); asm volatile("" : "+v"(r0), "+v"(c0));
#pragma unroll
        for (int ai = 0; ai < 2; ++ai) { int av[4]; float gv[4];
#pragma unroll
            for (int m = 0; m < 4; ++m) { const int r = r0 + ai * HALF + m * 16; const unsigned rr = (unsigned)(r < u.valid ? r : 0); av[m] = ap[rr]; gv[m] = rp[rr].x; }
#pragma unroll
            for (int m = 0; m < 4; ++m) { const int r = r0 + ai * HALF + m * 16;
                if (r < u.valid) { const float gt = gv[m];
#pragma unroll
                    for (int bj = 0; bj < 2; ++bj) { const f32x4 v0 = acc[ai][bj][m][0] * gt, v1 = acc[ai][bj][m][1] * gt;
                        u32x4 w; w.x = cvtpk(v0[0], v0[1]); w.y = cvtpk(v0[2], v0[3]); w.z = cvtpk(v1[0], v1[1]); w.w = cvtpk(v1[2], v1[3]);
                        *(u32x4*)(yb + ((unsigned)av[m] * 1024u + c0 + (unsigned)(bj * HALF))) = w; } } }
            asm volatile("" ::: "memory"); }
    }
};

template <class Epi, class Sched, bool ALIGN_EPI, bool NOUNROLL = false>
__device__ __forceinline__ void gemm_phase(LAS unsigned char* lds, const int K, const int lda, const int ldb, const Sched& S, const Epi& E) {
    int tid = threadIdx.x; asm volatile("" : "+v"(tid));
    const int wid = __builtin_amdgcn_readfirstlane(tid >> 6), lane = tid & 63, wr = wid >> 2, wc = wid & 3, fr = lane & 15, fq = lane >> 4;
    const int nt = K / BK;
    int sR[2], sC[2]; unsigned voffB[2];
#pragma unroll
    for (int i = 0; i < 2; ++i) { int R, C; stage_rc(tid * 16 + i * 8192, R, C); sR[i] = R; sC[i] = C; const int Rb = Epi::PERM ? ((R & ~31) + perm32(R & 31)) : R;
        voffB[i] = (unsigned)(Rb * ldb + C) * 2u; }
    const size_t kstep = (size_t)(BK * 2);
    const size_t hB = (size_t)HALF * ldb * 2, hA = Sched::GATHER ? (size_t)0 : (size_t)HALF * lda * 2;
    const unsigned ldsw = (unsigned)wid * 1024u;
    const int aoff = lds_byte(wr * 64 + fr, fq * 8), boff = lds_byte(wc * 32 + fr, fq * 8);
#define PG8_SA(b, h) (((b) * 2 + (h)) * HTB)
#define PG8_SB(b, h) ((4 + (b) * 2 + (h)) * HTB)
#define PG8_STAGE(bufoff, gbase, v0, v1) do { \
        __builtin_amdgcn_global_load_lds((const unsigned*)((const char*)(gbase) + (v0)), (LAS unsigned*)(lds + (bufoff) + ldsw), 16, 0, 0); \
        __builtin_amdgcn_global_load_lds((const unsigned*)((const char*)(gbase) + (v1)), (LAS unsigned*)(lds + (bufoff) + ldsw + 8192), 16, 0, 0); } while (0)
#define PG8_STB(bufoff, gbase) PG8_STAGE(bufoff, gbase, voffB[0], voffB[1])
#define PG8_STA(bufoff, gbase, h) PG8_STAGE(bufoff, (gbase) + (h) * hA, cv[Sched::GATHER ? (h) : 0][0], cv[Sched::GATHER ? (h) : 0][1])
#define PG8_LDA(dst, b, h) do { _Pragma("unroll") for (int m = 0; m < 4; ++m) _Pragma("unroll") for (int k = 0; k < 2; ++k) dst[m][k] = *(const LAS bf16x8*)(lds + PG8_SA(b, h) + aoff + m * 2048 + k * 1024); } while (0)
#define PG8_LDB(dst, b, h) do { _Pragma("unroll") for (int n = 0; n < 2; ++n) _Pragma("unroll") for (int k = 0; k < 2; ++k) dst[n][k] = *(const LAS bf16x8*)(lds + PG8_SB(b, h) + boff + n * 2048 + k * 1024); } while (0)
#define PG8_MMA(ai, bj, At, Bt) do { __builtin_amdgcn_s_setprio(1); _Pragma("unroll") for (int m = 0; m < 4; ++m) _Pragma("unroll") for (int n = 0; n < 2; ++n) _Pragma("unroll") for (int k = 0; k < 2; ++k) \
        acc[ai][bj][m][n] = __builtin_amdgcn_mfma_f32_16x16x32_bf16(Bt[n][k], At[m][k], acc[ai][bj][m][n], 0, 0, 0); __builtin_amdgcn_s_setprio(0); } while (0)
#define PG8_WAIT_V(n) asm volatile("s_waitcnt vmcnt(" #n ")" ::: "memory")
#define PG8_WAIT_L(n) asm volatile("s_waitcnt lgkmcnt(" #n ")" ::: "memory")
#define PG8_BAR __builtin_amdgcn_s_barrier()
#define PG8_SCHED __builtin_amdgcn_sched_barrier(0)
    Unit cur, nxt; int ui = 0;
    if (!S.next(0, cur)) return;
    Acc acc;
#pragma unroll
    for (int a = 0; a < 2; ++a)
#pragma unroll
        for (int b = 0; b < 2; ++b)
#pragma unroll
            for (int m = 0; m < 4; ++m)
#pragma unroll
                for (int n = 0; n < 2; ++n) acc[a][b][m][n] = (f32x4){0.f, 0.f, 0.f, 0.f};
    bf16x8 At[4][2], B0[2][2], B1[2][2];
    const char* cA; const char* cB; S.ptrs(cur, cA, cB);
    unsigned cv[2][2]; S.avoff(cur, sR, sC, cv);
    PG8_STB(PG8_SB(0, 0), cB); PG8_STB(PG8_SB(0, 1), cB + hB); PG8_STA(PG8_SA(0, 0), cA, 0); PG8_STA(PG8_SA(0, 1), cA, 1);
    if (wr == 1) PG8_BAR;
    PG8_WAIT_V(2); PG8_BAR;
    PG8_STB(PG8_SB(1, 0), cB + kstep); PG8_STA(PG8_SA(1, 0), cA + kstep, 0); PG8_STB(PG8_SB(1, 1), cB + hB + kstep);
    PG8_WAIT_V(6); PG8_BAR;
    for (;;) {
        const bool has_next = S.next(ui + 1, nxt);
        const char* nA = cA; const char* nB = cB;
        if (has_next) S.ptrs(nxt, nA, nB);
        for (int t = 0; t < nt; t += 2) {
            if constexpr (NOUNROLL) asm volatile("" : "+s"(t));
            const bool last = (t == nt - 2);
            if constexpr (Epi::HAS_MID) { if (t == (nt >> 1)) E.mid(acc, cur, wr, wc, fr, fq); }
            unsigned nv[2][2];
            if (Sched::GATHER) { if (last && has_next) { S.avoff(nxt, sR, sC, nv); cv[0][0] = nv[0][0]; cv[0][1] = nv[0][1]; } }
            const char* a1 = cA + (size_t)(t + 1) * kstep;
            const char* a2 = last ? nA : cA + (size_t)(t + 2) * kstep; const char* b2 = last ? nB : cB + (size_t)(t + 2) * kstep;
            const char* a3 = a2 + kstep; const char* b3 = b2 + kstep;
            PG8_LDB(B0, 0, 0); PG8_LDB(B1, 0, 1); PG8_SCHED; PG8_LDA(At, 0, 0); PG8_STA(PG8_SA(1, 1), a1, 1);
            if (Sched::GATHER) { if (last && has_next) { cv[1][0] = nv[1][0]; cv[1][1] = nv[1][1]; } }
            PG8_WAIT_V(8); PG8_WAIT_L(0); PG8_BAR; PG8_MMA(0, 0, At, B0); PG8_MMA(0, 1, At, B1); PG8_BAR; PG8_SCHED;
            PG8_LDA(At, 0, 1); PG8_STB(PG8_SB(0, 0), b2); PG8_STB(PG8_SB(0, 1), b2 + hB); PG8_STA(PG8_SA(0, 0), a2, 0);
            PG8_WAIT_V(8); PG8_WAIT_L(0); PG8_BAR; PG8_MMA(1, 0, At, B0); PG8_MMA(1, 1, At, B1); PG8_BAR; PG8_SCHED;
            PG8_LDB(B0, 1, 0); PG8_LDB(B1, 1, 1); PG8_SCHED; PG8_LDA(At, 1, 0); PG8_STA(PG8_SA(0, 1), a2, 1);
            PG8_WAIT_V(8); PG8_WAIT_L(0); PG8_BAR; PG8_MMA(0, 0, At, B0); PG8_MMA(0, 1, At, B1); PG8_BAR; PG8_SCHED;
            PG8_LDA(At, 1, 1); PG8_STB(PG8_SB(1, 0), b3); PG8_STB(PG8_SB(1, 1), b3 + hB); PG8_STA(PG8_SA(1, 0), a3, 0);
            PG8_WAIT_V(8); PG8_WAIT_L(0); PG8_BAR; PG8_MMA(1, 0, At, B0); PG8_MMA(1, 1, At, B1); PG8_BAR; PG8_SCHED;
        }
        if constexpr (ALIGN_EPI) { if (wr == 0) PG8_BAR; }
        E(acc, cur, wr, wc, fr, fq);
        if (!has_next) break;
#pragma unroll
        for (int a = 0; a < 2; ++a)
#pragma unroll
            for (int b = 0; b < 2; ++b)
#pragma unroll
                for (int m = 0; m < 4; ++m)
#pragma unroll
                    for (int n = 0; n < 2; ++n) acc[a][b][m][n] = (f32x4){0.f, 0.f, 0.f, 0.f};
        cur = nxt; cA = nA; cB = nB; ++ui;
        if constexpr (ALIGN_EPI) { if (wr == 1) PG8_BAR; }
    }
    PG8_WAIT_V(0);
    if constexpr (!ALIGN_EPI) { if (wr == 0) PG8_BAR; }
    PG8_BAR;
#undef PG8_SA
#undef PG8_SB
#undef PG8_STAGE
#undef PG8_STA
#undef PG8_STB
#undef PG8_LDA
#undef PG8_LDB
#undef PG8_MMA
#undef PG8_WAIT_V
#undef PG8_WAIT_L
#undef PG8_BAR
#undef PG8_SCHED
}
}

#ifndef MK_USE_CG
#define MK_USE_CG 0
#endif
#define XB_TMO      128
#define XB_XCNT(j)  (256  + 64 * (j))
#define XB_XSUB(j)  (1280 + 64 * (j))
#define XB_XGEN(j)  (2304 + 64 * (j))
#define XB_TOP      3328
#define XB_TOPGEN   3392
#define XCD_BAR_WORDS 3456
#define XB_SPIN_CAP (1u << 18)
__device__ __forceinline__ unsigned xb_ld(unsigned* p)              { return __hip_atomic_load(p, __ATOMIC_RELAXED, __HIP_MEMORY_SCOPE_AGENT); }
__device__ __forceinline__ unsigned xb_add(unsigned* p, unsigned v) { return __hip_atomic_fetch_add(p, v, __ATOMIC_RELAXED, __HIP_MEMORY_SCOPE_AGENT); }
__device__ __forceinline__ unsigned xb_xcc_id() { return (unsigned)__builtin_amdgcn_s_getreg((3 << 11) | 20) & 0xFu; }
#define XB_SPIN(cond, bar) do { unsigned _sp = 0; while (cond) { __builtin_amdgcn_s_sleep(1); \
    if ((++_sp & 255u) == 0u) { if (xb_ld(&(bar)[XB_TMO])) break; if (_sp > XB_SPIN_CAP) { atomicAdd(&(bar)[XB_TMO], 1u); break; } } } } while (0)
struct XcdBarrier { unsigned* bar; unsigned x; volatile LAS unsigned* st; };
__device__ __forceinline__ XcdBarrier xcd_barrier_post(unsigned* bar, volatile LAS unsigned* st) {
    XcdBarrier b; b.bar = bar; b.x = xb_xcc_id(); b.st = st;
    if (threadIdx.x == 0) (void)xb_add(&bar[XB_XCNT(b.x)], 1u);
    return b;
}
__device__ __forceinline__ void xcd_barrier_complete(unsigned* bar, unsigned x, unsigned& nloc, unsigned& nx) {
    const unsigned G = gridDim.x * gridDim.y * gridDim.z;
    unsigned sum, cnt, mine, sp = 0u;
    for (;;) {
        sum = 0u; cnt = 0u; mine = 0u;
#pragma unroll
        for (unsigned j = 0; j < 16; ++j) { const unsigned c = xb_ld(&bar[XB_XCNT(j)]); sum += c; cnt += (c > 0u) ? 1u : 0u; mine = (j == x) ? c : mine; }
        if (sum == G) break;
        __builtin_amdgcn_s_sleep(1);
        if ((++sp & 255u) == 0u) { if (xb_ld(&bar[XB_TMO])) break; if (sp > XB_SPIN_CAP) { atomicAdd(&bar[XB_TMO], 1u); break; } }
    }
    nloc = mine > 0u ? mine : 1u; nx = cnt > 0u ? cnt : 1u;
}
__device__ __forceinline__ void xcd_barrier(const XcdBarrier& b) {
    asm volatile("s_waitcnt vmcnt(0)" ::: "memory");
    __syncthreads();
    if (threadIdx.x == 0) {
        unsigned* bar = b.bar;
        __builtin_amdgcn_s_waitcnt(0);
        unsigned nloc = b.st[0], nx = b.st[1];
        if (nloc == 0u) { xcd_barrier_complete(bar, b.x, nloc, nx); b.st[0] = nloc; b.st[1] = nx; }
        const unsigned old = xb_add(&bar[XB_XSUB(b.x)], 1u);
        const unsigned gen = old / nloc;
        if (old + 1u == (gen + 1u) * nloc) {
            __builtin_amdgcn_fence(__ATOMIC_RELEASE, "agent");
            asm volatile("s_waitcnt vmcnt(0)" ::: "memory");
            const unsigned og = xb_add(&bar[XB_TOP], 1u);
            const unsigned tg = og / nx;
            if (og + 1u == (tg + 1u) * nx) xb_add(&bar[XB_TOPGEN], 1u);
            else XB_SPIN(xb_ld(&bar[XB_TOPGEN]) == tg, bar);
            __builtin_amdgcn_fence(__ATOMIC_ACQUIRE, "agent");
            xb_add(&bar[XB_XGEN(b.x)], 1u);
            asm volatile("s_waitcnt vmcnt(0)" ::: "memory");
        } else {
            XB_SPIN(xb_ld(&bar[XB_XGEN(b.x)]) == gen, bar);
            __builtin_amdgcn_fence(__ATOMIC_ACQUIRE, "agent");
            asm volatile("s_waitcnt vmcnt(0)" ::: "memory");
        }
    }
    __syncthreads();
}

struct Args {
    const float* in[19]; float* out; unsigned char* ws; int ph_lo, ph_hi; int rep[10];
};
struct Frame {
    LAS unsigned char* lds; int tid, lane, wave, G, vcu;
};

__device__ __forceinline__ void tr_item(const float* W, int ldw, int k0, int n0, bf16_t* WT, int ldt, int drow0, LAS float* scr, int lane) {
    float tv[32];
#pragma unroll
    for (int i = 0; i < 32; ++i) { const int kk = 2 * i + (lane >> 5); tv[i] = W[(size_t)(k0 + kk) * ldw + n0 + (lane & 31)]; }
#pragma unroll
    for (int i = 0; i < 32; ++i) { const int kk = 2 * i + (lane >> 5); scr[kk * 33 + (lane & 31)] = tv[i]; }
    LDS_WAIT(); asm volatile("" ::: "memory");
    const int c = lane & 7;
#pragma unroll
    for (int j = 0; j < 4; ++j) { const int n = (lane >> 3) + 8 * j; const LAS float* s = scr + (8 * c) * 33 + n;
        u32x4 o; o.x = cvtpk(s[0 * 33], s[1 * 33]); o.y = cvtpk(s[2 * 33], s[3 * 33]); o.z = cvtpk(s[4 * 33], s[5 * 33]); o.w = cvtpk(s[6 * 33], s[7 * 33]);
        *(u32x4*)(WT + (size_t)(drow0 + n) * ldt + k0 + 8 * c) = o; }
    LDS_WAIT(); asm volatile("" ::: "memory");
}
constexpr int I_IN = 16 * 136, I_A = 8 * 32, I_OUT = 16 * 32, I_G = 32 * 128, I_D = 32 * 128;
constexpr int I_SMALL = I_IN + 2 * I_A + I_OUT, NITEMS = I_SMALL + 2 * I_G + I_D;
__device__ __forceinline__ void convert_items(const Frame& F, const Args& a, int first, int last, int worker, int nworkers) {
    unsigned char* ws = a.ws;
    LAS float* scr = (LAS float*)(F.lds + F.wave * 16384);
    const float* w_in = a.in[2]; const float* w_a = a.in[8]; const float* w_c = a.in[9]; const float* w_out = a.in[10];
    const float* w_gate = a.in[16]; const float* w_up = a.in[17]; const float* w_down = a.in[18];
    bf16_t* WinT = (bf16_t*)(ws + WS_WIN); bf16_t* WaT = (bf16_t*)(ws + WS_WA); bf16_t* WoutT = (bf16_t*)(ws + WS_WOUT);
    bf16_t* WguT = (bf16_t*)(ws + WS_WGU); bf16_t* WdT = (bf16_t*)(ws + WS_WD);
    for (int it = first + worker * NWAVES + F.wave; it < last; it += nworkers * NWAVES) {
        int r = it;
        if (r < I_IN) { const int kb = r / 136, nb = r % 136; tr_item(w_in, PW, 64 * kb, 32 * nb, WinT, 1024, 32 * nb, scr, F.lane); continue; } r -= I_IN;
        if (r < I_A) { const int kb = r / 32, nb = r % 32; tr_item(w_a, 1024, 64 * kb, 32 * nb, WaT, 1024, 32 * nb, scr, F.lane); continue; } r -= I_A;
        if (r < I_A) { const int kb = r / 32, nb = r % 32; tr_item(w_c, 1024, 64 * kb, 32 * nb, WaT + 512, 1024, 32 * nb, scr, F.lane); continue; } r -= I_A;
        if (r < I_OUT) { const int kb = r / 32, nb = r % 32; tr_item(w_out, 1024, 64 * kb, 32 * nb, WoutT, 1024, 32 * nb, scr, F.lane); continue; } r -= I_OUT;
        if (r < 2 * I_G) { const int up = r >= I_G; if (up) r -= I_G; const int e = r / 128, q = r % 128, kb = q / 8, nb = q % 8, n0 = 32 * nb;
            tr_item((up ? w_up : w_gate) + (size_t)e * 1024 * 256, 256, 64 * kb, n0, WguT + (size_t)e * 512 * 1024, 1024, (n0 >> 7) * 256 + up * 128 + (n0 & 127), scr, F.lane); continue; } r -= 2 * I_G;
        { const int e = r / 128, q = r % 128, kb = q / 32, nb = q % 32; tr_item(w_down + (size_t)e * 256 * 1024, 1024, 64 * kb, 32 * nb, WdT + (size_t)e * 1024 * 256, 256, 32 * nb, scr, F.lane); }
    }
}
__device__ __forceinline__ void p0_prologue(const Frame& F, const Args& a) {
    unsigned char* ws = a.ws;
    const int gw = F.vcu * NWAVES + F.wave, NGW = F.G * NWAVES;
    convert_items(F, a, 0, I_SMALL, F.vcu, F.G);
    const int gt = F.vcu * NTHREADS + F.tid, NGT = F.G * NTHREADS;
    { const float* w_rg = a.in[12]; const float* w_re = a.in[14]; bf16_t* WrT = (bf16_t*)(ws + WS_WR);
      for (int i = gt; i < 48 * 1024; i += NGT) { const int j = i >> 10, k = i & 1023; float v = 0.f; if (j < 4) v = w_rg[k * 4 + j]; else if (j < 36) v = w_re[k * 32 + (j - 4)]; WrT[i] = f2bf(v); } }
    { float* cosT = (float*)(ws + WS_ROPE); float* sinT = cosT + SEQ * 8;
      for (int i = gt; i < SEQ * 8; i += NGT) { const int pos = i >> 3, j = i & 7; const float inv = (float)pow(500000.0, -(double)j / 8.0); const float ang = (float)pos * inv;
          cosT[i] = (float)cos((double)ang); sinT[i] = (float)sin((double)ang); } }
    { const float* x = a.in[0]; const float* g1 = a.in[1]; bf16_t* XN = (bf16_t*)(ws + WS_XN);
      f32x4 gv[4];
#pragma unroll
      for (int j = 0; j < 4; ++j) gv[j] = ((const f32x4*)g1)[F.lane + 64 * j];
      for (int m0 = gw; m0 < M; m0 += 4 * NGW) { f32x4 v[4][4];
#pragma unroll
          for (int q = 0; q < 4; ++q) { const int m = m0 + q * NGW; const f32x4* xr = (const f32x4*)(x + (size_t)(m < M ? m : 0) * D) + F.lane;
#pragma unroll
              for (int j = 0; j < 4; ++j) v[q][j] = xr[64 * j]; }
#pragma unroll
          for (int q = 0; q < 4; ++q) { const int m = m0 + q * NGW; float s = 0.f;
#pragma unroll
              for (int j = 0; j < 4; ++j) s += (v[q][j].x * v[q][j].x + v[q][j].y * v[q][j].y) + (v[q][j].z * v[q][j].z + v[q][j].w * v[q][j].w);
              const float rstd = rsqrtf(wave_sum(s) * (1.f / D) + EPS);
              if (m < M) { u32x2* o8 = (u32x2*)(XN + (size_t)m * D) + F.lane;
#pragma unroll
                  for (int j = 0; j < 4; ++j) { u32x2 w; w.x = cvtpk(v[q][j].x * rstd * gv[j].x, v[q][j].y * rstd * gv[j].y); w.y = cvtpk(v[q][j].z * rstd * gv[j].z, v[q][j].w * rstd * gv[j].w); o8[64 * j] = w; } } } } }
}

__device__ __forceinline__ u32x4 qk_norm_rope(const u32x4 raw, const float (&g)[8], const f32x4 c0, const f32x4 c1, const f32x4 s0, const f32x4 s1, int l7, float scale) {
    float v[8]; unpack8(raw, v); float ss = 0.f;
#pragma unroll
    for (int i = 0; i < 8; ++i) ss += v[i] * v[i];
    ss += __shfl_xor(ss, 1); ss += __shfl_xor(ss, 2); ss += __shfl_xor(ss, 4);
    const float rstd = rsqrtf(ss * (1.f / 64.f) + EPS);
    const float cc[8] = {c0.x, c0.y, c0.z, c0.w, c1.x, c1.y, c1.z, c1.w}, sn[8] = {s0.x, s0.y, s0.z, s0.w, s1.x, s1.y, s1.z, s1.w};
#pragma unroll
    for (int i = 0; i < 8; ++i) { float y = v[i] * rstd * g[i]; const float p = __shfl_xor(y, 1);
        if (l7 == 0) y = y * cc[i] - p * sn[i]; else if (l7 == 1) y = y * cc[i] + p * sn[i];
        v[i] = y * scale; }
    return pack8(v);
}
__device__ __forceinline__ void p2_prep_conv(const Frame& F, const Args& a) {
    unsigned char* ws = a.ws;
    const bf16_t* PROJ = (const bf16_t*)(ws + WS_PROJ); bf16_t* QN = (bf16_t*)(ws + WS_QN); bf16_t* KN = (bf16_t*)(ws + WS_KN); bf16_t* AC = (bf16_t*)(ws + WS_AC);
    const float* cosT = (const float*)(ws + WS_ROPE); const float* sinT = cosT + SEQ * 8;
    const float* qg = a.in[3]; const float* kg = a.in[4]; const float* conv_w = a.in[6]; const float* conv_b = a.in[7];
    const int gw = F.vcu * NWAVES + F.wave, NGW = F.G * NWAVES, lane = F.lane, l7 = lane & 7;
    float gq[8], gk[8];
#pragma unroll
    for (int k = 0; k < 8; ++k) { gq[k] = qg[8 * l7 + k]; gk[k] = kg[8 * l7 + k]; }
    float w0[8], w1[8], w2[8], bb[8];
#pragma unroll
    for (int k = 0; k < 8; ++k) { w0[k] = conv_w[8 * lane + k]; w1[k] = conv_w[CD + 8 * lane + k]; w2[k] = conv_w[2 * CD + 8 * lane + k]; bb[k] = conv_b[8 * lane + k]; }
    for (int ch = gw; ch < M / 16; ch += NGW) {
        const int t0 = ch * 16;
#pragma unroll 1
        for (int grp = 0; grp < 4; ++grp) { const int tb = t0 + 4 * grp;
            u32x4 qraw[4]; f32x4 qc[4][4];
#pragma unroll
            for (int tk = 0; tk < 4; ++tk) { const int t = tb + tk, pos = t & (SEQ - 1); qraw[tk] = *(const u32x4*)(PROJ + (size_t)t * PW + 8 * lane);
                qc[tk][0] = *(const f32x4*)(cosT + pos * 8); qc[tk][1] = *(const f32x4*)(cosT + pos * 8 + 4); qc[tk][2] = *(const f32x4*)(sinT + pos * 8); qc[tk][3] = *(const f32x4*)(sinT + pos * 8 + 4); }
            const int tkk = tb + (lane >> 4), kpos = tkk & (SEQ - 1);
            const u32x4 kraw = *(const u32x4*)(PROJ + (size_t)tkk * PW + C_K + 8 * (lane & 15));
            const f32x4 kc0 = *(const f32x4*)(cosT + kpos * 8), kc1 = *(const f32x4*)(cosT + kpos * 8 + 4), ks0 = *(const f32x4*)(sinT + kpos * 8), ks1 = *(const f32x4*)(sinT + kpos * 8 + 4);
#pragma unroll
            for (int tk = 0; tk < 4; ++tk) { const u32x4 o = qk_norm_rope(qraw[tk], gq, qc[tk][0], qc[tk][1], qc[tk][2], qc[tk][3], l7, QSCALE); *(u32x4*)(QN + (size_t)(tb + tk) * AD + 8 * lane) = o; }
            { const u32x4 o = qk_norm_rope(kraw, gk, kc0, kc1, ks0, ks1, l7, 1.0f); *(u32x4*)(KN + (size_t)tkk * 128 + 8 * (lane & 15)) = o; } }
        float up[8], uc[8];
        { float a8[8], b8[8];
          if ((t0 & (SEQ - 1)) > 0) { unpack8(*(const u32x4*)(PROJ + (size_t)(t0 - 1) * PW + C_CC + 8 * lane), a8); unpack8(*(const u32x4*)(PROJ + (size_t)(t0 - 1) * PW + C_CX + 8 * lane), b8);
#pragma unroll
              for (int k = 0; k < 8; ++k) up[k] = a8[k] * b8[k]; } else {
#pragma unroll
              for (int k = 0; k < 8; ++k) up[k] = 0.f; }
          unpack8(*(const u32x4*)(PROJ + (size_t)t0 * PW + C_CC + 8 * lane), a8); unpack8(*(const u32x4*)(PROJ + (size_t)t0 * PW + C_CX + 8 * lane), b8);
#pragma unroll
          for (int k = 0; k < 8; ++k) uc[k] = a8[k] * b8[k]; }
#pragma unroll 1
        for (int grp = 0; grp < 4; ++grp) { const int tb = t0 + 4 * grp;
            u32x4 rcc[4], rcx[4], rcb[4];
#pragma unroll
            for (int tk = 0; tk < 4; ++tk) { const int t = tb + tk; const bool hn = ((t & (SEQ - 1)) < SEQ - 1); const size_t tn = (size_t)(hn ? t + 1 : t);
                rcc[tk] = *(const u32x4*)(PROJ + tn * PW + C_CC + 8 * lane); rcx[tk] = *(const u32x4*)(PROJ + tn * PW + C_CX + 8 * lane); rcb[tk] = *(const u32x4*)(PROJ + (size_t)t * PW + C_CB + 8 * lane); }
#pragma unroll
            for (int tk = 0; tk < 4; ++tk) { const int t = tb + tk; const bool hn = ((t & (SEQ - 1)) < SEQ - 1);
                float a8[8], b8[8], cbv[8], un[8], o[8]; unpack8(rcc[tk], a8); unpack8(rcx[tk], b8); unpack8(rcb[tk], cbv);
#pragma unroll
                for (int k = 0; k < 8; ++k) { un[k] = hn ? a8[k] * b8[k] : 0.f; o[k] = cbv[k] * (up[k] * w0[k] + uc[k] * w1[k] + un[k] * w2[k] + bb[k]); up[k] = uc[k]; uc[k] = un[k]; }
                *(u32x4*)(AC + (size_t)t * 1024 + 512 + 8 * lane) = pack8(o); } }
    }
}

namespace att {
constexpr int NSLOT = 8, WSOFF = RING_BYTES + 1024, OSTOFF = WSOFF + 2048;
static_assert(OSTOFF + 8 * 2048 <= LDS_BYTES, "attention LDS map");
__device__ __forceinline__ int crow(int r, int hi) { return (r & 3) + 8 * (r >> 2) + 4 * hi; }
__device__ __forceinline__ s16x4 vtr(const LAS char* p) { return __builtin_bit_cast(s16x4, __builtin_amdgcn_ds_read_tr16_b64_v4i16((LAS s16x4*)p)); }
}
__device__ __forceinline__ u32x4 k_norm_rope(const u32x4 raw, const float (&g)[8], float cl, float sl, int l7, int lane) {
    float v[8]; unpack8(raw, v); float ss = 0.f;
#pragma unroll
    for (int i = 0; i < 8; ++i) ss += v[i] * v[i];
    ss += __shfl_xor(ss, 1); ss += __shfl_xor(ss, 2); ss += __shfl_xor(ss, 4);
    const float rstd = rsqrtf(ss * (1.f / 64.f) + EPS);
#pragma unroll
    for (int i = 0; i < 8; ++i) { float y = v[i] * rstd * g[i]; const float p = __shfl_xor(y, 1); const float c = __shfl(cl, (lane & ~7) + i), sn = __shfl(sl, (lane & ~7) + i);
        if (l7 == 0) y = y * c - p * sn; else if (l7 == 1) y = y * c + p * sn;
        v[i] = y; }
    return pack8(v);
}
__device__ __forceinline__ void conv8(const bf16_t* PROJ, bf16_t* AC, int tb, int lane, float (&up)[8], float (&uc)[8], const float* conv_w, const float* conv_b) {
    u32x4 rcc[8], rcx[8], rcb[8];
#pragma unroll
    for (int tk = 0; tk < 8; ++tk) { const int t = tb + tk; const bool hn = ((t & (SEQ - 1)) < SEQ - 1); const size_t tn = (size_t)(hn ? t + 1 : t);
        rcc[tk] = *(const u32x4*)(PROJ + tn * PW + C_CC + 8 * lane); rcx[tk] = *(const u32x4*)(PROJ + tn * PW + C_CX + 8 * lane); rcb[tk] = *(const u32x4*)(PROJ + (size_t)t * PW + C_CB + 8 * lane); }
    float w0[8], w1[8], w2[8], bb[8];
#pragma unroll
    for (int k = 0; k < 8; ++k) { w0[k] = conv_w[8 * lane + k]; w1[k] = conv_w[CD + 8 * lane + k]; w2[k] = conv_w[2 * CD + 8 * lane + k]; bb[k] = conv_b[8 * lane + k]; }
#pragma unroll
    for (int tk = 0; tk < 8; ++tk) { const int t = tb + tk; const bool hn = ((t & (SEQ - 1)) < SEQ - 1);
        float a8[8], b8[8], cbv[8], un[8], o[8]; unpack8(rcc[tk], a8); unpack8(rcx[tk], b8); unpack8(rcb[tk], cbv);
#pragma unroll
        for (int k = 0; k < 8; ++k) { un[k] = hn ? a8[k] * b8[k] : 0.f; o[k] = cbv[k] * (up[k] * w0[k] + uc[k] * w1[k] + un[k] * w2[k] + bb[k]); up[k] = uc[k]; uc[k] = un[k]; }
        *(u32x4*)(AC + (size_t)t * 1024 + 512 + 8 * lane) = pack8(o); }
}
__device__ __forceinline__ void p3_attention(const Frame& F, const Args& a) {
    using namespace att;
    unsigned char* ws = a.ws;
    const bf16_t* PROJ = (const bf16_t*)(ws + WS_PROJ); bf16_t* AC = (bf16_t*)(ws + WS_AC);
    const float* cosT = (const float*)(ws + WS_ROPE); const float* sinT = cosT + SEQ * 8;
    const float* qg = a.in[3]; const float* kg = a.in[4]; const float* sink = a.in[5];
    const int lane = F.lane, wid = F.wave, r32 = lane & 31, hi = lane >> 5, l7 = lane & 7;
    const float bound = 8.0f * wave_max(fabsf(qg[lane])) * wave_max(fabsf(kg[lane])) * 1.4426950408889634f * 1.0001f;
    LAS char* lds = (LAS char*)F.lds; LAS float* wsf = (LAS float*)(lds + WSOFF) + wid * 64;
    const int g = wid >> 1, qsub = wid & 1;
    float gk8[8];
#pragma unroll
    for (int k = 0; k < 8; ++k) gk8[k] = kg[8 * l7 + k];
    for (int su = F.vcu; su < NB * NKV * 16; su += F.G) {
        const int n0 = (su & 15) * 4, hk = (su >> 4) & 1, b = su >> 5;
        const int h = hk * 4 + g; const float snk = sink[h] * 1.4426950408889634f; const float mref = fmaxf(bound, snk);
        const size_t rowbase = (size_t)b * SEQ;
        __syncthreads();
        { u32x4 kraw[NSLOT], vraw[NSLOT]; float kcs[NSLOT][2];
#pragma unroll
          for (int sl = 0; sl < NSLOT; ++sl) { const int j = n0 - 2 + sl; const bool ok = (j >= 0 && j < 64); const int jj = ok ? j : n0;
              const int key = 8 * wid + (lane >> 3), pos = 64 * jj + key;
              kraw[sl] = *(const u32x4*)(PROJ + (rowbase + pos) * PW + C_K + hk * 64 + l7 * 8);
              kcs[sl][0] = cosT[pos * 8 + l7]; kcs[sl][1] = sinT[pos * 8 + l7];
              vraw[sl] = *(const u32x4*)(PROJ + (rowbase + 64 * jj + 16 * (wid & 3) + (lane >> 2)) * PW + C_V + hk * 64 + (wid >> 2) * 32 + (lane & 3) * 8); }
#pragma unroll
          for (int sl = 0; sl < NSLOT; ++sl) { const int key = 8 * wid + (lane >> 3);
              const u32x4 kn = k_norm_rope(kraw[sl], gk8, kcs[sl][0], kcs[sl][1], l7, lane);
              *(LAS u32x4*)(lds + sl * 16384 + l7 * 1024 + key * 16) = kn;
              *(LAS u32x4*)(lds + sl * 16384 + 8192 + wid * 1024 + lane * 16) = vraw[sl]; } }
        __syncthreads();
#pragma unroll 1
        for (int uu = 0; uu < 4; ++uu) {
        const int n64 = n0 + uu;
        const int qs = n64 * 64 + qsub * 32;
        bf16x8 qr[4];
        { float qv[4][8]; float ss = 0.f; const int pos = qs + r32;
#pragma unroll
          for (int d0 = 0; d0 < 4; ++d0) { const u32x4 raw = *(const u32x4*)(PROJ + (rowbase + pos) * PW + C_Q + h * 64 + d0 * 16 + hi * 8); unpack8(raw, qv[d0]); }
          const f32x4 c0 = *(const f32x4*)(cosT + pos * 8), c1 = *(const f32x4*)(cosT + pos * 8 + 4), s0 = *(const f32x4*)(sinT + pos * 8), s1 = *(const f32x4*)(sinT + pos * 8 + 4);
#pragma unroll
          for (int d0 = 0; d0 < 4; ++d0)
#pragma unroll
              for (int k = 0; k < 8; ++k) ss += qv[d0][k] * qv[d0][k];
          ss += __shfl_xor(ss, 32);
          const float rstd = rsqrtf(ss * (1.f / 64.f) + EPS);
#pragma unroll
          for (int d0 = 0; d0 < 4; ++d0) { const f32x4 ga = *(const f32x4*)(qg + d0 * 16 + hi * 8), gb = *(const f32x4*)(qg + d0 * 16 + hi * 8 + 4); const float gg[8] = {ga.x, ga.y, ga.z, ga.w, gb.x, gb.y, gb.z, gb.w};
#pragma unroll
              for (int k = 0; k < 8; ++k) qv[d0][k] = qv[d0][k] * rstd * gg[k]; }
          const float cc[8] = {c0.x, c0.y, c0.z, c0.w, c1.x, c1.y, c1.z, c1.w}, sn[8] = {s0.x, s0.y, s0.z, s0.w, s1.x, s1.y, s1.z, s1.w};
#pragma unroll
          for (int k = 0; k < 8; ++k) { const float y = qv[0][k], p = __shfl_xor(y, 32); qv[0][k] = (hi == 0) ? (y * cc[k] - p * sn[k]) : (y * cc[k] + p * sn[k]); }
#pragma unroll
          for (int d0 = 0; d0 < 4; ++d0) {
#pragma unroll
              for (int k = 0; k < 8; ++k) qv[d0][k] *= QSCALE;
              qr[d0] = __builtin_bit_cast(bf16x8, pack8(qv[d0])); } }
        f32x16 o0 = {}, o1 = {}; float lsum = 0.f;
        const int qi = qs + r32;
#pragma unroll 1
        for (int sl = 0; sl < 5; ++sl) { const int j = n64 - 2 + sl; if (j < 0 || j >= 64) continue;
            const LAS char* tile = lds + (uu + sl) * 16384;
            const LAS char* kb = tile + hi * 1024 + r32 * 16;
            f32x16 p0 = {}, p1 = {};
#pragma unroll
            for (int d0 = 0; d0 < 4; ++d0) { const bf16x8 b0 = *(const LAS bf16x8*)(kb + d0 * 2048), b1 = *(const LAS bf16x8*)(kb + d0 * 2048 + 512);
                p0 = __builtin_amdgcn_mfma_f32_32x32x16_bf16(b0, qr[d0], p0, 0, 0, 0); p1 = __builtin_amdgcn_mfma_f32_32x32x16_bf16(b1, qr[d0], p1, 0, 0, 0); }
            if (sl == 0 || sl == 4) {
                const int kb0 = 64 * j + 4 * hi;
#pragma unroll
                for (int r = 0; r < 16; ++r) { const int kk = kb0 + (r & 3) + 8 * (r >> 2); const int d0_ = qi - kk, d1_ = qi - (kk + 32);
                    const bool v0 = (d0_ <= 128) && (d0_ >= -128), v1 = (d1_ <= 128) && (d1_ >= -128);
                    p0[r] = v0 ? __builtin_amdgcn_exp2f(p0[r] - mref) : 0.f; p1[r] = v1 ? __builtin_amdgcn_exp2f(p1[r] - mref) : 0.f; lsum += p0[r] + p1[r]; }
            } else {
#pragma unroll
                for (int r = 0; r < 16; ++r) { p0[r] = __builtin_amdgcn_exp2f(p0[r] - mref); p1[r] = __builtin_amdgcn_exp2f(p1[r] - mref); lsum += p0[r] + p1[r]; }
            }
            u32x4 pw0, pw1, pw2, pw3;
            pw0 = (u32x4){cvtpk(p0[0], p0[1]), cvtpk(p0[2], p0[3]), cvtpk(p0[4], p0[5]), cvtpk(p0[6], p0[7])};
            pw1 = (u32x4){cvtpk(p0[8], p0[9]), cvtpk(p0[10], p0[11]), cvtpk(p0[12], p0[13]), cvtpk(p0[14], p0[15])};
            pw2 = (u32x4){cvtpk(p1[0], p1[1]), cvtpk(p1[2], p1[3]), cvtpk(p1[4], p1[5]), cvtpk(p1[6], p1[7])};
            pw3 = (u32x4){cvtpk(p1[8], p1[9]), cvtpk(p1[10], p1[11]), cvtpk(p1[12], p1[13]), cvtpk(p1[14], p1[15])};
            const LAS char* vp = tile + 8192 + ((lane >> 4) & 1) * 32 + (lane & 3) * 8 + (4 * hi + ((lane & 15) >> 2)) * 64;
#pragma unroll
            for (int dh = 0; dh < 2; ++dh) {
#pragma unroll
                for (int ks = 0; ks < 4; ++ks) { const s16x4 lo = vtr(vp + dh * 4096 + ks * 1024), hh = vtr(vp + dh * 4096 + ks * 1024 + 512);
                    const bf16x8 vf = (bf16x8){lo[0], lo[1], lo[2], lo[3], hh[0], hh[1], hh[2], hh[3]};
                    const u32x4 pw = ks == 0 ? pw0 : ks == 1 ? pw1 : ks == 2 ? pw2 : pw3;
                    if (dh == 0) o0 = __builtin_amdgcn_mfma_f32_32x32x16_bf16(__builtin_bit_cast(bf16x8, pw), vf, o0, 0, 0, 0);
                    else o1 = __builtin_amdgcn_mfma_f32_32x32x16_bf16(__builtin_bit_cast(bf16x8, pw), vf, o1, 0, 0, 0); } }
        }
        lsum += __shfl_xor(lsum, 32); lsum += __builtin_amdgcn_exp2f(snk - mref);
        if (hi == 0) wsf[r32] = lsum;
        LDS_WAIT(); asm volatile("" ::: "memory");
        float rl[16];
#pragma unroll
        for (int r = 0; r < 16; ++r) rl[r] = __builtin_amdgcn_rcpf(wsf[crow(r, hi)]);
        LAS bf16_t* stg = (LAS bf16_t*)(lds + OSTOFF) + wid * 1024;
        bf16_t* Ow = AC + (rowbase + qs) * 1024 + h * 64;
#pragma unroll
        for (int dh = 0; dh < 2; ++dh) {
#pragma unroll
            for (int r = 0; r < 16; ++r) stg[crow(r, hi) * 32 + r32] = f2bf((dh ? o1[r] : o0[r]) * rl[r]);
            LDS_WAIT(); asm volatile("" ::: "memory");
#pragma unroll
            for (int i = 0; i < 2; ++i) { const int row = i * 16 + (lane >> 2), ch = lane & 3; const u32x4 v = *(const LAS u32x4*)(stg + row * 32 + ch * 8); *(u32x4*)(Ow + (size_t)row * 1024 + dh * 32 + ch * 8) = v; }
            LDS_WAIT(); asm volatile("" ::: "memory"); }
        }
    }
    __syncthreads();
    { const float* conv_w = a.in[6]; const float* conv_b = a.in[7];
      const int gw = F.vcu * NWAVES + wid, NGW = F.G * NWAVES;
      for (int ch = gw; ch < M / 16; ch += NGW) { const int t0 = ch * 16; float up[8], uc[8];
          { float a8[8], b8[8];
            if ((t0 & (SEQ - 1)) > 0) { unpack8(*(const u32x4*)(PROJ + (size_t)(t0 - 1) * PW + C_CC + 8 * lane), a8); unpack8(*(const u32x4*)(PROJ + (size_t)(t0 - 1) * PW + C_CX + 8 * lane), b8);
#pragma unroll
                for (int k = 0; k < 8; ++k) up[k] = a8[k] * b8[k]; } else {
#pragma unroll
                for (int k = 0; k < 8; ++k) up[k] = 0.f; }
            unpack8(*(const u32x4*)(PROJ + (size_t)t0 * PW + C_CC + 8 * lane), a8); unpack8(*(const u32x4*)(PROJ + (size_t)t0 * PW + C_CX + 8 * lane), b8);
#pragma unroll
            for (int k = 0; k < 8; ++k) uc[k] = a8[k] * b8[k]; }
          conv8(PROJ, AC, t0, lane, up, uc, conv_w, conv_b); conv8(PROJ, AC, t0 + 8, lane, up, uc, conv_w, conv_b); } }
    __syncthreads();
}

__device__ __forceinline__ void p6_route(const Frame& F, const Args& a) {
    unsigned char* ws = a.ws;
    const float* X1 = a.out; const float* g2 = a.in[11]; const float* b_rg = a.in[13]; const float* b_re = a.in[15];
    bf16_t* H2 = (bf16_t*)(ws + WS_H2); const bf16_t* WrT = (const bf16_t*)(ws + WS_WR);
    int* asg = (int*)(ws + WS_ASG); f32x2* rsg = (f32x2*)(ws + WS_RSG); unsigned* gcnt = (unsigned*)(ws + WS_CTL) + CW_CNT;
    const int lane = F.lane, wid = F.wave, r = lane & 15, kg = lane >> 4;
    constexpr int WR_PITCH = 2064, WR_BYTES = 48 * WR_PITCH, G2_OFF = WR_BYTES, LG_OFF = G2_OFF + 4096;
    LAS unsigned char* wrl = F.lds; LAS float* g2l = (LAS float*)(F.lds + G2_OFF); LAS float* lg = (LAS float*)(F.lds + LG_OFF) + wid * (16 * 48);
    LAS int* hist = (LAS int*)(F.lds + LDSCTL_OFF + LC_HIST); LAS int* base = (LAS int*)(F.lds + LDSCTL_OFF + LC_BASE);
    for (int i = F.tid; i < 48 * 128; i += NTHREADS) { const int row = i >> 7, c = i & 127; *(LAS u32x4*)(wrl + row * WR_PITCH + c * 16) = *(const u32x4*)(WrT + (size_t)row * D + c * 8); }
    for (int i = F.tid; i < 256; i += NTHREADS) *(LAS f32x4*)(g2l + 4 * i) = *(const f32x4*)(g2 + 4 * i);
    const int nblk = M / 128;
    for (int blk = F.vcu; blk < nblk; blk += F.G) {
        if (F.tid < 32) hist[F.tid] = 0;
        __syncthreads();
        const int row0 = blk * 128 + wid * 16;
        f32x4 acc[3] = {{0.f, 0.f, 0.f, 0.f}, {0.f, 0.f, 0.f, 0.f}, {0.f, 0.f, 0.f, 0.f}}; float ss = 0.f;
        const float* xr = X1 + (size_t)(row0 + r) * D + 8 * kg; bf16_t* hr = H2 + (size_t)(row0 + r) * D + 8 * kg;
        const LAS unsigned char* wb = wrl + r * WR_PITCH + 16 * kg; const LAS float* gl = g2l + 8 * kg;
#pragma unroll 1
        for (int s0 = 0; s0 < 32; s0 += 8) { f32x4 xv[8][2];
#pragma unroll
            for (int q = 0; q < 8; ++q) { xv[q][0] = *(const f32x4*)(xr + 32 * (s0 + q)); xv[q][1] = *(const f32x4*)(xr + 32 * (s0 + q) + 4); }
#pragma unroll
            for (int q = 0; q < 8; ++q) { const int s = s0 + q; const f32x4 x0 = xv[q][0], x1 = xv[q][1];
                const f32x4 ga = *(const LAS f32x4*)(gl + 32 * s), gb = *(const LAS f32x4*)(gl + 32 * s + 4);
                ss += (x0.x * x0.x + x0.y * x0.y) + (x0.z * x0.z + x0.w * x0.w) + (x1.x * x1.x + x1.y * x1.y) + (x1.z * x1.z + x1.w * x1.w);
                u32x4 w; w.x = cvtpk(x0.x * ga.x, x0.y * ga.y); w.y = cvtpk(x0.z * ga.z, x0.w * ga.w); w.z = cvtpk(x1.x * gb.x, x1.y * gb.y); w.w = cvtpk(x1.z * gb.z, x1.w * gb.w);
                *(u32x4*)(hr + 32 * s) = w; const bf16x8 af = __builtin_bit_cast(bf16x8, w);
#pragma unroll
                for (int j = 0; j < 3; ++j) { const bf16x8 bfr = *(const LAS bf16x8*)(wb + 16 * j * WR_PITCH + 64 * s); acc[j] = __builtin_amdgcn_mfma_f32_16x16x32_bf16(af, bfr, acc[j], 0, 0, 0); } } }
        ss += __shfl_xor(ss, 16); ss += __shfl_xor(ss, 32);
        const float rstd = rsqrtf(ss * (1.f / D) + EPS);
#pragma unroll
        for (int j = 0; j < 3; ++j)
#pragma unroll
            for (int i = 0; i < 4; ++i) lg[(4 * kg + i) * 48 + 16 * j + r] = acc[j][i];
        LDS_WAIT(); asm volatile("" ::: "memory");
        int e0 = 0, e1 = 0, rk0 = 0, rk1 = 0; float gt0 = 0.f, gt1 = 0.f;
        if (lane < 16) {
            const LAS float* L = lg + lane * 48;
            float gl4[4]; int grp = 0; float gm;
#pragma unroll
            for (int i = 0; i < 4; ++i) gl4[i] = L[i] * rstd + b_rg[i];
            gm = gl4[0];
#pragma unroll
            for (int i = 1; i < 4; ++i) if (gl4[i] > gm) { gm = gl4[i]; grp = i; }
            float gs = 0.f;
#pragma unroll
            for (int i = 0; i < 4; ++i) gs += __expf(gl4[i] - gm);
            const float pg = 1.0f / gs;
            float el[8];
#pragma unroll
            for (int i = 0; i < 8; ++i) el[i] = L[4 + grp * 8 + i] * rstd + b_re[grp * 8 + i];
            int i0 = 0; float m0 = el[0];
#pragma unroll
            for (int i = 1; i < 8; ++i) if (el[i] > m0) { m0 = el[i]; i0 = i; }
            int i1 = -1; float m1 = -3.0e38f;
#pragma unroll
            for (int i = 0; i < 8; ++i) if (i != i0 && el[i] > m1) { m1 = el[i]; i1 = i; }
            const float ex1 = __expf(m1 - m0); const float den = 1.0f / (1.0f + ex1);
            gt0 = pg * den; gt1 = pg * ex1 * den; e0 = grp * 8 + i0; e1 = grp * 8 + i1;
            rk0 = __hip_atomic_fetch_add(&hist[e0], 1, __ATOMIC_RELAXED, __HIP_MEMORY_SCOPE_WORKGROUP);
            rk1 = __hip_atomic_fetch_add(&hist[e1], 1, __ATOMIC_RELAXED, __HIP_MEMORY_SCOPE_WORKGROUP);
        }
        __syncthreads();
        if (F.tid < 32) { const int n = hist[F.tid]; int bs = 0; if (n > 0) bs = (int)__hip_atomic_fetch_add(gcnt + F.tid, (unsigned)n, __ATOMIC_RELAXED, __HIP_MEMORY_SCOPE_AGENT); base[F.tid] = bs; }
        __syncthreads();
        if (lane < 16) { const int tok = row0 + lane;
            const size_t p0 = (size_t)e0 * CAP + base[e0] + rk0, p1 = (size_t)e1 * CAP + base[e1] + rk1;
            asg[p0] = tok * 2; asg[p1] = tok * 2 + 1; rsg[p0] = (f32x2){gt0, rstd}; rsg[p1] = (f32x2){gt1, rstd}; }
        __syncthreads();
    }
}

__device__ __forceinline__ void moe_tables(const Frame& F, const Args& a) {
    const unsigned* gcnt = (const unsigned*)(a.ws + WS_CTL) + CW_CNT;
    LAS int* mtpre = (LAS int*)(F.lds + LDSCTL_OFF + LC_MTPRE); LAS int* cnt = (LAS int*)(F.lds + LDSCTL_OFF + LC_CNT);
    __syncthreads();
    if (F.tid == 0) { int acc = 0; for (int e = 0; e < 32; ++e) { const int n = (int)__hip_atomic_load(gcnt + e, __ATOMIC_RELAXED, __HIP_MEMORY_SCOPE_AGENT); cnt[e] = n; mtpre[e] = acc; acc += (n + 255) >> 8; } mtpre[32] = acc; }
    __syncthreads();
}

__device__ __forceinline__ void p9_combine(const Frame& F, const Args& a, bool dummy = false) {
    float* out = a.out; float* lo_dst = dummy ? (float*)(a.ws + WS_AC) : a.out; float* hi_dst = dummy ? (float*)(a.ws + WS_MERGED) - (size_t)(M / 2) * D : a.out; const bf16_t* Y = (const bf16_t*)(a.ws + WS_Y);
    const unsigned gt = (unsigned)F.vcu * NTHREADS + F.tid, NGT = (unsigned)F.G * NTHREADS, TOT = (unsigned)M * 128u;
    for (unsigned i0 = gt; i0 < TOT; i0 += 4 * NGT) {
        f32x4 xa[4], xb[4]; u32x4 y0[4], y1[4];
#pragma unroll
        for (int k = 0; k < 4; ++k) { const unsigned i = i0 + k * NGT, ii = i < TOT ? i : gt; const size_t tok = ii >> 7, c8 = (ii & 127) * 8;
            xa[k] = *(const f32x4*)(out + tok * D + c8); xb[k] = *(const f32x4*)(out + tok * D + c8 + 4);
            y0[k] = *(const u32x4*)(Y + (tok * 2) * D + c8); y1[k] = *(const u32x4*)(Y + (tok * 2 + 1) * D + c8); }
#pragma unroll
        for (int k = 0; k < 4; ++k) { const unsigned i = i0 + k * NGT; if (i < TOT) { const size_t tok = i >> 7, c8 = (i & 127) * 8; f32x4 x0 = xa[k], x1 = xb[k];
            x0.x += bflo(y0[k].x) + bflo(y1[k].x); x0.y += bfhi(y0[k].x) + bfhi(y1[k].x); x0.z += bflo(y0[k].y) + bflo(y1[k].y); x0.w += bfhi(y0[k].y) + bfhi(y1[k].y);
            x1.x += bflo(y0[k].z) + bflo(y1[k].z); x1.y += bfhi(y0[k].z) + bfhi(y1[k].z); x1.z += bflo(y0[k].w) + bflo(y1[k].w); x1.w += bfhi(y0[k].w) + bfhi(y1[k].w);
            float* dst = (tok < (size_t)(M / 2)) ? lo_dst : hi_dst; *(f32x4*)(dst + tok * D + c8) = x0; *(f32x4*)(dst + tok * D + c8 + 4) = x1; } }
    }
}

constexpr int N_PHASES = 10;
__global__ void __launch_bounds__(NTHREADS, 2) fwd_kernel(Args args) {
    extern __shared__ __attribute__((aligned(16))) unsigned char lds_raw[];
    Frame F; F.lds = (LAS unsigned char*)lds_raw; F.tid = threadIdx.x; F.lane = F.tid & 63; F.wave = __builtin_amdgcn_readfirstlane(F.tid >> 6);
    F.G = gridDim.x; { const int bx = blockIdx.x; F.vcu = (F.G % 8 == 0) ? (bx % 8) * (F.G / 8) + bx / 8 : bx; }
    for (int u = F.tid; u < (LDS_BYTES - LDSCTL_OFF) / 4; u += NTHREADS) ((LAS unsigned*)(F.lds + LDSCTL_OFF))[u] = 0u;
    __syncthreads();
    unsigned char* ws = args.ws;
    const int lo = args.ph_lo, hi = args.ph_hi;
#ifndef PH_MASK
#define PH_MASK 0x3ff
#endif
#define IN(k) (((PH_MASK >> (k)) & 1) && lo <= (k) && (k) < hi)
#if MK_USE_CG
#define GRID_BAR(k) do { if (IN(k) && IN((k) + 1)) { cg::this_grid().sync(); } } while (0)
#else
    XcdBarrier bar; bar.bar = (unsigned*)(ws + WS_CTL) + CW_BAR; bar.x = 0; bar.st = nullptr;
    if (hi - lo > 1) bar = xcd_barrier_post((unsigned*)(ws + WS_CTL) + CW_BAR, (volatile LAS unsigned*)(F.lds + LDSCTL_OFF + LC_MISC) + 8);
#define GRID_BAR(k) do { if (IN(k) && IN((k) + 1)) { xcd_barrier(bar); } } while (0)
#endif
    const LAS int* mtpre = (const LAS int*)(F.lds + LDSCTL_OFF + LC_MTPRE); const LAS int* lcnt = (const LAS int*)(F.lds + LDSCTL_OFF + LC_CNT);

#define REP(k) for (int rep_ = 0; rep_ < args.rep[k]; ++rep_)
#define REFRESH() do { F.tid = threadIdx.x; asm volatile("" : "+v"(F.tid)); F.lane = F.tid & 63; } while (0)
#define REPBAR() do { if (rep_) xcd_barrier(bar); REFRESH(); } while (0)
    if (IN(0)) REP(0) { REPBAR(); p0_prologue(F, args); } GRID_BAR(0);
    if (IN(1)) REP(1) { REPBAR(); pg8::PlainOrder S{(const bf16_t*)(ws + WS_XN), (const bf16_t*)(ws + WS_WIN), 1024, 1024, M / 256, PW / 256, F.G, (int)blockIdx.x};
        pg8::EpiProj E{(bf16_t*)(ws + WS_PROJ)};
        pg8::gemm_phase<pg8::EpiProj, pg8::PlainOrder, true>(F.lds, 1024, 1024, 1024, S, E);
        if (rep_ == 0) { const int nwg = (M / 256) * (PW / 256), maxc = (nwg + F.G - 1) / F.G, full = nwg - (maxc - 1) * F.G;
            if (full >= F.G) convert_items(F, args, I_SMALL, NITEMS, (int)blockIdx.x, F.G);
            else if ((int)blockIdx.x >= full) convert_items(F, args, I_SMALL, NITEMS, (int)blockIdx.x - full, F.G - full); } } GRID_BAR(1);
    if (IN(3)) REP(3) { REPBAR(); p3_attention(F, args); } GRID_BAR(3);
    if (IN(4)) REP(4) { REPBAR(); pg8::PlainOrder S{(const bf16_t*)(ws + WS_AC), (const bf16_t*)(ws + WS_WA), 1024, 1024, M / 256, D / 256, F.G, (int)blockIdx.x};
        pg8::EpiGate2 E{(const bf16_t*)(ws + WS_PROJ), (bf16_t*)(ws + WS_MERGED)};
        pg8::gemm_phase<pg8::EpiGate2, pg8::PlainOrder, true>(F.lds, 1024, 1024, 1024, S, E); } GRID_BAR(4);
    if (IN(5)) REP(5) { REPBAR(); pg8::PlainOrder S{(const bf16_t*)(ws + WS_MERGED), (const bf16_t*)(ws + WS_WOUT), 1024, 1024, M / 256, D / 256, F.G, (int)blockIdx.x};
        pg8::EpiRes E{args.in[0], args.out};
        pg8::gemm_phase<pg8::EpiRes, pg8::PlainOrder, true>(F.lds, 1024, 1024, 1024, S, E); } GRID_BAR(5);
    if (IN(6)) REP(6) { REFRESH(); if (rep_) { xcd_barrier(bar); if (blockIdx.x == 0 && F.tid < 32) ((unsigned*)(ws + WS_CTL) + CW_CNT)[F.tid] = 0u; xcd_barrier(bar); } p6_route(F, args); } GRID_BAR(6);
    if (IN(7)) REP(7) { REPBAR(); moe_tables(F, args);
        pg8::MoeGuOrder S; S.mtpre = mtpre; S.cnt = lcnt; S.NT = 2; S.G = F.G; S.c = (int)blockIdx.x; S.H2 = (const bf16_t*)(ws + WS_H2); S.Wgu = (const bf16_t*)(ws + WS_WGU); S.asg = (const int*)(ws + WS_ASG);
        pg8::EpiGU E{(bf16_t*)(ws + WS_HID), (const f32x2*)(ws + WS_RSG), mtpre};
        pg8::gemm_phase<pg8::EpiGU, pg8::MoeGuOrder, true>(F.lds, 1024, 1024, 1024, S, E); } GRID_BAR(7);
    if (IN(8)) REP(8) { REPBAR(); moe_tables(F, args);
        pg8::MoeDownOrder S; S.mtpre = mtpre; S.cnt = lcnt; S.NT = 4; S.G = F.G; S.c = (int)blockIdx.x; S.HID = (const bf16_t*)(ws + WS_HID); S.Wd = (const bf16_t*)(ws + WS_WD);
        pg8::EpiDown E{(bf16_t*)(ws + WS_Y), (const int*)(ws + WS_ASG), (const f32x2*)(ws + WS_RSG), mtpre};
        pg8::gemm_phase<pg8::EpiDown, pg8::MoeDownOrder, true, true>(F.lds, 256, 256, 256, S, E); } GRID_BAR(8);
    if (IN(9)) { REFRESH(); if (args.rep[9] > 1) { p9_combine(F, args, true); xcd_barrier(bar); } p9_combine(F, args); }
#undef IN
#undef GRID_BAR
}

extern "C" void kernel_launch(void* const* d_in, const int* in_sizes, int n_in, void* d_out, int out_size, void* d_ws, size_t ws_size, hipStream_t stream) {
    static int grid = 0;
    if (grid == 0) {
        if (n_in != 19 || in_sizes[0] != M * D || out_size != M * D || ws_size < WS_END) { fprintf(stderr, "kernel_launch: unexpected shapes (n_in %d, in0 %d, out %d, ws %zu)\n", n_in, n_in > 0 ? in_sizes[0] : -1, out_size, ws_size); grid = -1; return; }
        int dev = 0, cus = 0, per_cu = 0;
        if (hipGetDevice(&dev) != hipSuccess || hipDeviceGetAttribute(&cus, hipDeviceAttributeMultiprocessorCount, dev) != hipSuccess) { grid = -1; return; }
        if (hipFuncSetAttribute((const void*)fwd_kernel, hipFuncAttributeMaxDynamicSharedMemorySize, LDS_BYTES) != hipSuccess) { fprintf(stderr, "kernel_launch: hipFuncSetAttribute failed\n"); grid = -1; return; }
        if (hipOccupancyMaxActiveBlocksPerMultiprocessor(&per_cu, (const void*)fwd_kernel, NTHREADS, LDS_BYTES) != hipSuccess || per_cu < 1) { fprintf(stderr, "kernel_launch: occupancy query says %d\n", per_cu); per_cu = 1; }
        (void)hipGetLastError();
        grid = cus * 1;
        fprintf(stderr, "kernel_launch: cus %d per_cu %d grid %d\n", cus, per_cu, grid);
    }
    if (grid < 0) return;
    (void)hipMemsetAsync((char*)d_ws + WS_CTL, 0, CTL_ZERO_BYTES, stream);
    Args a{};
    for (int i = 0; i < 19; ++i) a.in[i] = (const float*)d_in[i];
    a.out = (float*)d_out; a.ws = (unsigned char*)d_ws;
    for (int i = 0; i < 10; ++i) a.rep[i] = (i == PROBE_DUP) ? 2 : 1;
#if MK_N_LAUNCHES == 1
    a.ph_lo = 0; a.ph_hi = N_PHASES;
    void* kargs[] = {&a};
#if MK_USE_CG
    hipError_t e = hipLaunchCooperativeKernel((const void*)fwd_kernel, dim3(grid), dim3(NTHREADS), kargs, LDS_BYTES, stream);
    if (e != hipSuccess) fprintf(stderr, "kernel_launch: cooperative launch failed: %s\n", hipGetErrorString(e));
#else
    (void)kargs; hipLaunchKernelGGL(fwd_kernel, dim3(grid), dim3(NTHREADS), LDS_BYTES, stream, a);
#endif
#else
    for (int p = 0; p < N_PHASES; ++p) { a.ph_lo = p; a.ph_hi = p + 1; hipLaunchKernelGGL(fwd_kernel, dim3(grid), dim3(NTHREADS), LDS_BYTES, stream, a); }
#endif
}
```

```cpp
#include <hip/hip_runtime.h>
#include <hip/hip_cooperative_groups.h>
#include <cstdio>
#include <cstdint>
namespace cg = cooperative_groups;

#ifndef PROBE_DUP
#define PROBE_DUP -1
#endif
#ifndef MK_N_LAUNCHES
#define MK_N_LAUNCHES 1
#endif

#define LAS __attribute__((address_space(3)))
#define GAS __attribute__((address_space(1)))
typedef unsigned short bf16_t;
typedef short bf16x8 __attribute__((ext_vector_type(8)));
typedef short s16x4 __attribute__((ext_vector_type(4)));
typedef float f32x4 __attribute__((ext_vector_type(4)));
typedef float f32x2 __attribute__((ext_vector_type(2)));
typedef float f32x16 __attribute__((ext_vector_type(16)));
typedef unsigned u32x4 __attribute__((ext_vector_type(4)));
typedef unsigned u32x2 __attribute__((ext_vector_type(2)));
typedef __bf16 bf16x2_t __attribute__((ext_vector_type(2)));

constexpr int NB = 8, SEQ = 4096, M = NB * SEQ, D = 1024, PW = 4352;
constexpr int NH = 8, NKV = 2, HD = 64, AD = 512, CD = 512;
constexpr int C_Q = 0, C_K = 512, C_V = 640, C_CB = 768, C_CC = 1280, C_CX = 1792, C_GA = 2304;
constexpr int NE = 32, DFF = 256, CAP = 32768;
constexpr float EPS = 1e-6f;
constexpr float QSCALE = 0.125f * 1.4426950408889634f;
constexpr int NWAVES = 8, NTHREADS = 512;

constexpr size_t MiB = 1u << 20;
constexpr size_t WS_CTL = 0, CTL_ZERO_BYTES = 64 * 1024;
constexpr size_t WS_ROPE = 1 * MiB;
constexpr size_t WS_WR = 1 * MiB + 256 * 1024;
constexpr size_t WS_WIN = 2 * MiB;
constexpr size_t WS_WA = 11 * MiB, WS_WC = 12 * MiB;
constexpr size_t WS_WOUT = 13 * MiB;
constexpr size_t WS_WGU = 16 * MiB;
constexpr size_t WS_WD = 48 * MiB;
constexpr size_t WS_XN = 64 * MiB;
constexpr size_t WS_AC = 64 * MiB;
constexpr size_t WS_PROJ = 128 * MiB;
constexpr size_t WS_H2 = 128 * MiB;
constexpr size_t WS_HID = 192 * MiB;
constexpr size_t WS_Y = 232 * MiB;
constexpr size_t WS_D1 = 64 * MiB;
constexpr size_t WS_QN = 400 * MiB;
constexpr size_t WS_KN = 432 * MiB;
constexpr size_t WS_MERGED = 400 * MiB;
constexpr size_t WS_ASG = 464 * MiB;
constexpr size_t WS_RSG = 468 * MiB;
constexpr size_t WS_END = 476 * MiB;
constexpr int CW_CNT = 1024;
constexpr int CW_BAR = 4096;

constexpr int RING_BYTES = 131072;
constexpr int LDSCTL_OFF = RING_BYTES;
constexpr int LC_MISC = 0;
constexpr int LC_MTPRE = 128;
constexpr int LC_CNT = 128 + 160;
constexpr int LC_HIST = LC_CNT + 128;
constexpr int LC_BASE = LC_HIST + 128;
constexpr int LDS_BYTES = 163840;

__device__ __forceinline__ unsigned cvtpk(float lo, float hi) { f32x2 v = {lo, hi}; bf16x2_t b = __builtin_convertvector(v, bf16x2_t); return __builtin_bit_cast(unsigned, b); }
__device__ __forceinline__ bf16_t f2bf(float f) { return (bf16_t)(cvtpk(f, 0.f) & 0xffffu); }
__device__ __forceinline__ float bf2f(unsigned h) { return __builtin_bit_cast(float, h << 16); }
__device__ __forceinline__ float bflo(unsigned w) { return __builtin_bit_cast(float, w << 16); }
__device__ __forceinline__ float bfhi(unsigned w) { return __builtin_bit_cast(float, w & 0xffff0000u); }
__device__ __forceinline__ float wave_sum(float v) {
#pragma unroll
    for (int o = 1; o < 64; o <<= 1) v += __shfl_xor(v, o);
    return v;
}
__device__ __forceinline__ float wave_max(float v) {
#pragma unroll
    for (int o = 1; o < 64; o <<= 1) v = fmaxf(v, __shfl_xor(v, o));
    return v;
}
__device__ __forceinline__ float sigmoidf_(float v) { return __builtin_amdgcn_rcpf(1.0f + __builtin_amdgcn_exp2f(-1.4426950408889634f * v)); }
__device__ __forceinline__ void unpack8(const u32x4 w, float (&v)[8]) { v[0] = bflo(w.x); v[1] = bfhi(w.x); v[2] = bflo(w.y); v[3] = bfhi(w.y); v[4] = bflo(w.z); v[5] = bfhi(w.z); v[6] = bflo(w.w); v[7] = bfhi(w.w); }
__device__ __forceinline__ u32x4 pack8(const float (&v)[8]) { u32x4 w; w.x = cvtpk(v[0], v[1]); w.y = cvtpk(v[2], v[3]); w.z = cvtpk(v[4], v[5]); w.w = cvtpk(v[6], v[7]); return w; }
#define LDS_WAIT() asm volatile("s_waitcnt lgkmcnt(0)" ::: "memory")
#define VM_WAIT() asm volatile("s_waitcnt vmcnt(0)" ::: "memory")

namespace pg8 {
constexpr int BM = 256, BK = 64, HALF = 128, HTB = HALF * BK * 2, STAGE_BYTES = 8 * HTB, NXCD = 8, WGM = 8;
__host__ __device__ __forceinline__ int lds_byte(int r, int c) { const int st = (r >> 4) * 2 + (c >> 5), rr = r & 15, cc = c & 31, ob = rr * 64 + cc * 2; return st * 1024 + (ob ^ (((ob >> 9) & 1) << 5)); }
__host__ __device__ __forceinline__ void stage_rc(int b, int& R, int& C) { const int st = b / 1024, sb = b % 1024, swz = sb ^ (((sb >> 9) & 1) << 5); R = (st >> 1) * 16 + swz / 64; C = (st & 1) * 32 + (swz % 64) / 2; }
__host__ __device__ __forceinline__ int perm32(int rho) { const int n = rho >> 4, i = rho & 15; return 8 * (i >> 2) + 4 * n + (i & 3); }

struct Unit { int pm, pn, z, valid; };

__device__ __forceinline__ void tile_of(int L, int nM, int nN, int& pm, int& pn) {
    const int nwg = nM * nN; int wgid = L;
    { const int q = nwg / NXCD, r = nwg % NXCD, xcd = wgid % NXCD, off = wgid / NXCD; wgid = (xcd < r ? xcd * (q + 1) : r * (q + 1) + (xcd - r) * q) + off; }
    const int nig = WGM * nN, gid = wgid / nig, fm = gid * WGM, gsz = (nM - fm) < WGM ? (nM - fm) : WGM;
    pm = fm + ((wgid % nig) % gsz); pn = (wgid % nig) / gsz;
}

struct PlainOrder {
    static constexpr bool GATHER = false;
    const bf16_t* A; const bf16_t* Bt; int lda, ldb, nM, nN, G, c;
    __device__ __forceinline__ bool next(int i, Unit& u) const { const int L = i * G + c; if (L >= nM * nN) return false; tile_of(L, nM, nN, u.pm, u.pn); u.z = 0; u.valid = 256; return true; }
    __device__ __forceinline__ void ptrs(const Unit& u, const char*& a, const char*& b) const { a = (const char*)(A + (size_t)u.pm * 256 * lda); b = (const char*)(Bt + (size_t)u.pn * 256 * ldb); }
    __device__ __forceinline__ void avoff(const Unit&, const int (&R)[2], const int (&C)[2], unsigned (&v)[2][2]) const {
#pragma unroll
        for (int h = 0; h < 2; ++h)
#pragma unroll
            for (int i = 0; i < 2; ++i) v[h][i] = (unsigned)(R[i] * lda + C[i]) * 2u;
    }
};
struct DualOrder {
    static constexpr bool GATHER = false;
    const bf16_t* AC; const bf16_t* Wa; const bf16_t* Wc; int G, c;
    __device__ __forceinline__ bool next(int i, Unit& u) const { const int L = (i >> 1) * G + c; if (L >= 128 * 4) return false; tile_of(L, 128, 4, u.pm, u.pn); u.z = i & 1; u.valid = 256; return true; }
    __device__ __forceinline__ void ptrs(const Unit& u, const char*& a, const char*& b) const { a = (const char*)(AC + (size_t)u.pm * 256 * 1024 + u.z * 512); b = (const char*)((u.z ? Wc : Wa) + (size_t)u.pn * 256 * 512); }
    __device__ __forceinline__ void avoff(const Unit&, const int (&R)[2], const int (&C)[2], unsigned (&v)[2][2]) const {
#pragma unroll
        for (int h = 0; h < 2; ++h)
#pragma unroll
            for (int i = 0; i < 2; ++i) v[h][i] = (unsigned)(R[i] * 1024 + C[i]) * 2u;
    }
};
struct MoeOrder {
    const LAS int* mtpre; const LAS int* cnt; int NT, G, c;
    __device__ __forceinline__ bool locate(int i, Unit& u) const {
        const int L = i * G + c; const int U = mtpre[32] * NT; if (L >= U) return false;
        const int tg = L / NT; u.pn = L - tg * NT; int e = 0;
#pragma unroll 1
        for (int j = 1; j < 32; ++j) e += (mtpre[j] <= tg) ? 1 : 0;
        u.z = e; u.pm = tg; const int mt = tg - mtpre[e]; const int left = cnt[e] - mt * 256; u.valid = left < 256 ? left : 256; return true;
    }
};
struct MoeGuOrder : MoeOrder {
    static constexpr bool GATHER = true;
    const bf16_t* H2; const bf16_t* Wgu; const int* asg;
    __device__ __forceinline__ bool next(int i, Unit& u) const { return locate(i, u); }
    __device__ __forceinline__ void ptrs(const Unit& u, const char*& a, const char*& b) const { a = (const char*)H2; b = (const char*)(Wgu + ((size_t)u.z * 512 + (size_t)u.pn * 256) * 1024); }
    __device__ __forceinline__ void avoff(const Unit& u, const int (&R)[2], const int (&C)[2], unsigned (&v)[2][2]) const {
        const int mt = u.pm - mtpre[u.z]; const int* ap = asg + ((size_t)u.z * CAP + mt * 256);
#pragma unroll
        for (int h = 0; h < 2; ++h)
#pragma unroll
            for (int i = 0; i < 2; ++i) { const unsigned r = (unsigned)(h * 128 + R[i]); int tok = 0; if ((int)r < u.valid) tok = ap[r] >> 1; v[h][i] = (unsigned)(tok * 1024 + C[i]) * 2u; }
    }
};
struct MoeDownOrder : MoeOrder {
    static constexpr bool GATHER = false;
    const bf16_t* HID; const bf16_t* Wd;
    __device__ __forceinline__ bool next(int i, Unit& u) const { return locate(i, u); }
    __device__ __forceinline__ void ptrs(const Unit& u, const char*& a, const char*& b) const { a = (const char*)(HID + (size_t)u.pm * 256 * 256); b = (const char*)(Wd + ((size_t)u.z * 1024 + (size_t)u.pn * 256) * 256); }
    __device__ __forceinline__ void avoff(const Unit&, const int (&R)[2], const int (&C)[2], unsigned (&v)[2][2]) const {
#pragma unroll
        for (int h = 0; h < 2; ++h)
#pragma unroll
            for (int i = 0; i < 2; ++i) v[h][i] = (unsigned)(R[i] * 256 + C[i]) * 2u;
    }
};

typedef f32x4 Acc[2][2][4][2];

struct EpiProj {
    static constexpr bool PERM = true, HAS_MID = false;
    bf16_t* O;
    __device__ __forceinline__ void operator()(const Acc& acc, const Unit& u, int wr, int wc, int fr, int fq) const {
        bf16_t* base = O + (size_t)u.pm * BM * PW + u.pn * BM;
        unsigned l0 = (unsigned)((wr * 64 + fr) * PW + wc * 32 + 8 * fq); asm volatile("" : "+v"(l0)); const bool sg = u.pn >= 9;
#pragma unroll
        for (int ai = 0; ai < 2; ++ai)
#pragma unroll
            for (int m = 0; m < 4; ++m)
#pragma unroll
                for (int bj = 0; bj < 2; ++bj) { f32x4 v0 = acc[ai][bj][m][0], v1 = acc[ai][bj][m][1];
                    if (sg) {
#pragma unroll
                        for (int k = 0; k < 4; ++k) { v0[k] = sigmoidf_(v0[k]); v1[k] = sigmoidf_(v1[k]); } }
                    u32x4 w; w.x = cvtpk(v0[0], v0[1]); w.y = cvtpk(v0[2], v0[3]); w.z = cvtpk(v1[0], v1[1]); w.w = cvtpk(v1[2], v1[3]);
                    *(u32x4*)(base + (l0 + (unsigned)((ai * HALF + m * 16) * PW + bj * HALF))) = w; }
    }
};
struct EpiGate2 {
    static constexpr bool PERM = true, HAS_MID = true;
    const bf16_t* PROJ; bf16_t* MG;
    __device__ __forceinline__ void mid(Acc& acc, const Unit& u, int wr, int wc, int fr, int fq) const {
        const bf16_t* gbase = PROJ + (size_t)u.pm * BM * PW + C_GA + u.pn * BM;
        unsigned lg = (unsigned)((wr * 64 + fr) * PW + wc * 32 + 8 * fq); asm volatile("" : "+v"(lg));
#pragma unroll
        for (int ai = 0; ai < 2; ++ai) { u32x4 ga[4][2], gc[4][2];
#pragma unroll
            for (int m = 0; m < 4; ++m)
#pragma unroll
                for (int bj = 0; bj < 2; ++bj) { const unsigned o = lg + (unsigned)((ai * HALF + m * 16) * PW + bj * HALF); ga[m][bj] = *(const u32x4*)(gbase + o); gc[m][bj] = *(const u32x4*)(gbase + 1024 + o); }
#pragma unroll
            for (int m = 0; m < 4; ++m)
#pragma unroll
                for (int bj = 0; bj < 2; ++bj) { float a8[8], c8[8]; unpack8(ga[m][bj], a8); unpack8(gc[m][bj], c8);
#pragma unroll
                    for (int k = 0; k < 8; ++k) { const float r = a8[k] * __builtin_amdgcn_rcpf(fmaxf(c8[k], 9.5367431640625e-07f)); if (k < 4) acc[ai][bj][m][0][k] *= r; else acc[ai][bj][m][1][k - 4] *= r; } }
            asm volatile("" ::: "memory"); }
    }
    __device__ __forceinline__ void operator()(const Acc& acc, const Unit& u, int wr, int wc, int fr, int fq) const {
        const bf16_t* gbase = PROJ + (size_t)u.pm * BM * PW + C_GA + 1024 + u.pn * BM;
        bf16_t* ob = MG + (size_t)u.pm * BM * 1024 + u.pn * BM;
        unsigned lg = (unsigned)((wr * 64 + fr) * PW + wc * 32 + 8 * fq), lt = (unsigned)((wr * 64 + fr) * 1024 + wc * 32 + 8 * fq); asm volatile("" : "+v"(lg), "+v"(lt));
        u32x4 gc[2][4][2];
#pragma unroll
        for (int ai = 0; ai < 2; ++ai)
#pragma unroll
            for (int m = 0; m < 4; ++m)
#pragma unroll
                for (int bj = 0; bj < 2; ++bj) gc[ai][m][bj] = *(const u32x4*)(gbase + (lg + (unsigned)((ai * HALF + m * 16) * PW + bj * HALF)));
#pragma unroll
        for (int ai = 0; ai < 2; ++ai)
#pragma unroll
            for (int m = 0; m < 4; ++m)
#pragma unroll
                for (int bj = 0; bj < 2; ++bj) { float c8[8]; unpack8(gc[ai][m][bj], c8); float v[8];
#pragma unroll
                    for (int k = 0; k < 8; ++k) v[k] = (k < 4 ? acc[ai][bj][m][0][k] : acc[ai][bj][m][1][k - 4]) * fmaxf(c8[k], 9.5367431640625e-07f);
                    *(u32x4*)(ob + (lt + (unsigned)((ai * HALF + m * 16) * 1024 + bj * HALF))) = pack8(v); }
    }
};
struct EpiD1 {
    static constexpr bool PERM = true, HAS_MID = false;
    bf16_t* O;
    __device__ __forceinline__ void operator()(const Acc& acc, const Unit& u, int wr, int wc, int fr, int fq) const {
        bf16_t* ob = O + (size_t)u.pm * BM * D + u.pn * BM;
        unsigned l0 = (unsigned)((wr * 64 + fr) * D + wc * 32 + 8 * fq); asm volatile("" : "+v"(l0));
#pragma unroll
        for (int ai = 0; ai < 2; ++ai)
#pragma unroll
            for (int m = 0; m < 4; ++m)
#pragma unroll
                for (int bj = 0; bj < 2; ++bj) { const f32x4 v0 = acc[ai][bj][m][0], v1 = acc[ai][bj][m][1];
                    u32x4 w; w.x = cvtpk(v0[0], v0[1]); w.y = cvtpk(v0[2], v0[3]); w.z = cvtpk(v1[0], v1[1]); w.w = cvtpk(v1[2], v1[3]);
                    *(u32x4*)(ob + (l0 + (unsigned)((ai * HALF + m * 16) * D + bj * HALF))) = w; }
    }
};
struct EpiGU {
    static constexpr bool PERM = true, HAS_MID = false;
    bf16_t* HID; const f32x2* rsg; const LAS int* mtpre;
    __device__ __forceinline__ void operator()(const Acc& acc, const Unit& u, int wr, int wc, int fr, int fq) const {
        const int mt = u.pm - mtpre[u.z]; const f32x2* rp = rsg + ((size_t)u.z * CAP + mt * 256);
        bf16_t* hb = HID + (size_t)u.pm * 256 * 256 + u.pn * 128;
        int r0 = wr * 64 + fr; asm volatile("" : "+v"(r0)); const unsigned l0 = (unsigned)(r0 * 256 + wc * 32 + 8 * fq);
        float rsv[2][4];
#pragma unroll
        for (int ai = 0; ai < 2; ++ai)
#pragma unroll
            for (int m = 0; m < 4; ++m) { const int r = r0 + ai * HALF + m * 16; const float t = rp[(unsigned)(r < u.valid ? r : 0)].y; rsv[ai][m] = r < u.valid ? t : 0.f; }
#pragma unroll
        for (int ai = 0; ai < 2; ++ai)
#pragma unroll
            for (int m = 0; m < 4; ++m) { const int r = r0 + ai * HALF + m * 16;
                const float rs = rsv[ai][m];
                const f32x4 g0 = acc[ai][0][m][0] * rs, g1 = acc[ai][0][m][1] * rs, u0 = acc[ai][1][m][0] * rs, u1 = acc[ai][1][m][1] * rs;
                float h[8];
#pragma unroll
                for (int k = 0; k < 4; ++k) { h[k] = g0[k] * sigmoidf_(g0[k]) * u0[k]; h[4 + k] = g1[k] * sigmoidf_(g1[k]) * u1[k]; }
                u32x4 w; w.x = cvtpk(h[0], h[1]); w.y = cvtpk(h[2], h[3]); w.z = cvtpk(h[4], h[5]); w.w = cvtpk(h[6], h[7]);
                *(u32x4*)(hb + (l0 + (unsigned)((ai * HALF + m * 16) * 256))) = w; }
    }
};
struct EpiDown {
    static constexpr bool PERM = true, HAS_MID = false;
    bf16_t* Y; const int* asg; const f32x2* rsg; const LAS int* mtpre;
    __device__ __forceinline__ void operator()(const Acc& acc, const Unit& u, int wr, int wc, int fr, int fq) const {
        const int mt = u.pm - mtpre[u.z]; const size_t pb = (size_t)u.z * CAP + mt * 256; const int* ap = asg + pb; const f32x2* rp = rsg + pb;
        bf16_t* yb = Y + u.pn * BM;
        int r0 = wr * 64 + fr; unsigned c0 = (unsigned)(wc * 32 + 8 * fq); asm volatile("" : "+v"(r0), "+v"(c0));
#pragma unroll
        for (int ai = 0; ai < 2; ++ai) { int av[4]; float gv[4];
#pragma unroll
            for (int m = 0; m < 4; ++m) { const int r = r0 + ai * HALF + m * 16; const unsigned rr = (unsigned)(r < u.valid ? r : 0); av[m] = ap[rr]; gv[m] = rp[rr].x; }
#pragma unroll
            for (int m = 0; m < 4; ++m) { const int r = r0 + ai * HALF + m * 16;
                if (r < u.valid) { const float gt = gv[m];
#pragma unroll
                    for (int bj = 0; bj < 2; ++bj) { const f32x4 v0 = acc[ai][bj][m][0] * gt, v1 = acc[ai][bj][m][1] * gt;
                        u32x4 w; w.x = cvtpk(v0[0], v0[1]); w.y = cvtpk(v0[2], v0[3]); w.z = cvtpk(v1[0], v1[1]); w.w = cvtpk(v1[2], v1[3]);
                        *(u32x4*)(yb + ((unsigned)av[m] * 1024u + c0 + (unsigned)(bj * HALF))) = w; } } }
            asm volatile("" ::: "memory"); }
    }
};

template <class Epi, class Sched, bool ALIGN_EPI, bool NOUNROLL = false>
__device__ __forceinline__ void gemm_phase(LAS unsigned char* lds, const int K, const int lda, const int ldb, const Sched& S, const Epi& E) {
    int tid = threadIdx.x; asm volatile("" : "+v"(tid));
    const int wid = __builtin_amdgcn_readfirstlane(tid >> 6), lane = tid & 63, wr = wid >> 2, wc = wid & 3, fr = lane & 15, fq = lane >> 4;
    const int nt = K / BK;
    int sR[2], sC[2]; unsigned voffB[2];
#pragma unroll
    for (int i = 0; i < 2; ++i) { int R, C; stage_rc(tid * 16 + i * 8192, R, C); sR[i] = R; sC[i] = C; const int Rb = Epi::PERM ? ((R & ~31) + perm32(R & 31)) : R;
        voffB[i] = (unsigned)(Rb * ldb + C) * 2u; }
    const size_t kstep = (size_t)(BK * 2);
    const size_t hB = (size_t)HALF * ldb * 2, hA = Sched::GATHER ? (size_t)0 : (size_t)HALF * lda * 2;
    const unsigned ldsw = (unsigned)wid * 1024u;
    const int aoff = lds_byte(wr * 64 + fr, fq * 8), boff = lds_byte(wc * 32 + fr, fq * 8);
#define PG8_SA(b, h) (((b) * 2 + (h)) * HTB)
#define PG8_SB(b, h) ((4 + (b) * 2 + (h)) * HTB)
#define PG8_STAGE(bufoff, gbase, v0, v1) do { \
        __builtin_amdgcn_global_load_lds((const unsigned*)((const char*)(gbase) + (v0)), (LAS unsigned*)(lds + (bufoff) + ldsw), 16, 0, 0); \
        __builtin_amdgcn_global_load_lds((const unsigned*)((const char*)(gbase) + (v1)), (LAS unsigned*)(lds + (bufoff) + ldsw + 8192), 16, 0, 0); } while (0)
#define PG8_STB(bufoff, gbase) PG8_STAGE(bufoff, gbase, voffB[0], voffB[1])
#define PG8_STA(bufoff, gbase, h) PG8_STAGE(bufoff, (gbase) + (h) * hA, cv[Sched::GATHER ? (h) : 0][0], cv[Sched::GATHER ? (h) : 0][1])
#define PG8_LDA(dst, b, h) do { _Pragma("unroll") for (int m = 0; m < 4; ++m) _Pragma("unroll") for (int k = 0; k < 2; ++k) dst[m][k] = *(const LAS bf16x8*)(lds + PG8_SA(b, h) + aoff + m * 2048 + k * 1024); } while (0)
#define PG8_LDB(dst, b, h) do { _Pragma("unroll") for (int n = 0; n < 2; ++n) _Pragma("unroll") for (int k = 0; k < 2; ++k) dst[n][k] = *(const LAS bf16x8*)(lds + PG8_SB(b, h) + boff + n * 2048 + k * 1024); } while (0)
#define PG8_MMA(ai, bj, At, Bt) do { __builtin_amdgcn_s_setprio(1); _Pragma("unroll") for (int m = 0; m < 4; ++m) _Pragma("unroll") for (int n = 0; n < 2; ++n) _Pragma("unroll") for (int k = 0; k < 2; ++k) \
        acc[ai][bj][m][n] = __builtin_amdgcn_mfma_f32_16x16x32_bf16(Bt[n][k], At[m][k], acc[ai][bj][m][n], 0, 0, 0); __builtin_amdgcn_s_setprio(0); } while (0)
#define PG8_WAIT_V(n) asm volatile("s_waitcnt vmcnt(" #n ")" ::: "memory")
#define PG8_WAIT_L(n) asm volatile("s_waitcnt lgkmcnt(" #n ")" ::: "memory")
#define PG8_BAR __builtin_amdgcn_s_barrier()
#define PG8_SCHED __builtin_amdgcn_sched_barrier(0)
    Unit cur, nxt; int ui = 0;
    if (!S.next(0, cur)) return;
    Acc acc;
#pragma unroll
    for (int a = 0; a < 2; ++a)
#pragma unroll
        for (int b = 0; b < 2; ++b)
#pragma unroll
            for (int m = 0; m < 4; ++m)
#pragma unroll
                for (int n = 0; n < 2; ++n) acc[a][b][m][n] = (f32x4){0.f, 0.f, 0.f, 0.f};
    bf16x8 At[4][2], B0[2][2], B1[2][2];
    const char* cA; const char* cB; S.ptrs(cur, cA, cB);
    unsigned cv[2][2]; S.avoff(cur, sR, sC, cv);
    PG8_STB(PG8_SB(0, 0), cB); PG8_STB(PG8_SB(0, 1), cB + hB); PG8_STA(PG8_SA(0, 0), cA, 0); PG8_STA(PG8_SA(0, 1), cA, 1);
    if (wr == 1) PG8_BAR;
    PG8_WAIT_V(2); PG8_BAR;
    PG8_STB(PG8_SB(1, 0), cB + kstep); PG8_STA(PG8_SA(1, 0), cA + kstep, 0); PG8_STB(PG8_SB(1, 1), cB + hB + kstep);
    PG8_WAIT_V(6); PG8_BAR;
    for (;;) {
        const bool has_next = S.next(ui + 1, nxt);
        const char* nA = cA; const char* nB = cB;
        if (has_next) S.ptrs(nxt, nA, nB);
        for (int t = 0; t < nt; t += 2) {
            if constexpr (NOUNROLL) asm volatile("" : "+s"(t));
            const bool last = (t == nt - 2);
            if constexpr (Epi::HAS_MID) { if (t == (nt >> 1)) E.mid(acc, cur, wr, wc, fr, fq); }
            unsigned nv[2][2];
            if (Sched::GATHER) { if (last && has_next) { S.avoff(nxt, sR, sC, nv); cv[0][0] = nv[0][0]; cv[0][1] = nv[0][1]; } }
            const char* a1 = cA + (size_t)(t + 1) * kstep;
            const char* a2 = last ? nA : cA + (size_t)(t + 2) * kstep; const char* b2 = last ? nB : cB + (size_t)(t + 2) * kstep;
            const char* a3 = a2 + kstep; const char* b3 = b2 + kstep;
            PG8_LDB(B0, 0, 0); PG8_LDB(B1, 0, 1); PG8_SCHED; PG8_LDA(At, 0, 0); PG8_STA(PG8_SA(1, 1), a1, 1);
            if (Sched::GATHER) { if (last && has_next) { cv[1][0] = nv[1][0]; cv[1][1] = nv[1][1]; } }
            PG8_WAIT_V(8); PG8_WAIT_L(0); PG8_BAR; PG8_MMA(0, 0, At, B0); PG8_MMA(0, 1, At, B1); PG8_BAR; PG8_SCHED;
            PG8_LDA(At, 0, 1); PG8_STB(PG8_SB(0, 0), b2); PG8_STB(PG8_SB(0, 1), b2 + hB); PG8_STA(PG8_SA(0, 0), a2, 0);
            PG8_WAIT_V(8); PG8_WAIT_L(0); PG8_BAR; PG8_MMA(1, 0, At, B0); PG8_MMA(1, 1, At, B1); PG8_BAR; PG8_SCHED;
            PG8_LDB(B0, 1, 0); PG8_LDB(B1, 1, 1); PG8_SCHED; PG8_LDA(At, 1, 0); PG8_STA(PG8_SA(0, 1), a2, 1);
            PG8_WAIT_V(8); PG8_WAIT_L(0); PG8_BAR; PG8_MMA(0, 0, At, B0); PG8_MMA(0, 1, At, B1); PG8_BAR; PG8_SCHED;
            PG8_LDA(At, 1, 1); PG8_STB(PG8_SB(1, 0), b3); PG8_STB(PG8_SB(1, 1), b3 + hB); PG8_STA(PG8_SA(1, 0), a3, 0);
            PG8_WAIT_V(8); PG8_WAIT_L(0); PG8_BAR; PG8_MMA(1, 0, At, B0); PG8_MMA(1, 1, At, B1); PG8_BAR; PG8_SCHED;
        }
        if constexpr (ALIGN_EPI) { if (wr == 0) PG8_BAR; }
        E(acc, cur, wr, wc, fr, fq);
        if (!has_next) break;
#pragma unroll
        for (int a = 0; a < 2; ++a)
#pragma unroll
            for (int b = 0; b < 2; ++b)
#pragma unroll
                for (int m = 0; m < 4; ++m)
#pragma unroll
                    for (int n = 0; n < 2; ++n) acc[a][b][m][n] = (f32x4){0.f, 0.f, 0.f, 0.f};
        cur = nxt; cA = nA; cB = nB; ++ui;
        if constexpr (ALIGN_EPI) { if (wr == 1) PG8_BAR; }
    }
    PG8_WAIT_V(0);
    if constexpr (!ALIGN_EPI) { if (wr == 0) PG8_BAR; }
    PG8_BAR;
#undef PG8_SA
#undef PG8_SB
#undef PG8_STAGE
#undef PG8_STA
#undef PG8_STB
#undef PG8_LDA
#undef PG8_LDB
#undef PG8_MMA
#undef PG8_WAIT_V
#undef PG8_WAIT_L
#undef PG8_BAR
#undef PG8_SCHED
}
}

#ifndef MK_USE_CG
#define MK_USE_CG 0
#endif
#define XB_TMO      128
#define XB_XCNT(j)  (256  + 64 * (j))
#define XB_XSUB(j)  (1280 + 64 * (j))
#define XB_XGEN(j)  (2304 + 64 * (j))
#define XB_TOP      3328
#define XB_TOPGEN   3392
#define XCD_BAR_WORDS 3456
#define XB_SPIN_CAP (1u << 18)
__device__ __forceinline__ unsigned xb_ld(unsigned* p)              { return __hip_atomic_load(p, __ATOMIC_RELAXED, __HIP_MEMORY_SCOPE_AGENT); }
__device__ __forceinline__ unsigned xb_add(unsigned* p, unsigned v) { return __hip_atomic_fetch_add(p, v, __ATOMIC_RELAXED, __HIP_MEMORY_SCOPE_AGENT); }
__device__ __forceinline__ unsigned xb_xcc_id() { return (unsigned)__builtin_amdgcn_s_getreg((3 << 11) | 20) & 0xFu; }
#define XB_SPIN(cond, bar) do { unsigned _sp = 0; while (cond) { __builtin_amdgcn_s_sleep(1); \
    if ((++_sp & 255u) == 0u) { if (xb_ld(&(bar)[XB_TMO])) break; if (_sp > XB_SPIN_CAP) { atomicAdd(&(bar)[XB_TMO], 1u); break; } } } } while (0)
struct XcdBarrier { unsigned* bar; unsigned x; volatile LAS unsigned* st; };
__device__ __forceinline__ XcdBarrier xcd_barrier_post(unsigned* bar, volatile LAS unsigned* st) {
    XcdBarrier b; b.bar = bar; b.x = xb_xcc_id(); b.st = st;
    if (threadIdx.x == 0) (void)xb_add(&bar[XB_XCNT(b.x)], 1u);
    return b;
}
__device__ __forceinline__ void xcd_barrier_complete(unsigned* bar, unsigned x, unsigned& nloc, unsigned& nx) {
    const unsigned G = gridDim.x * gridDim.y * gridDim.z;
    unsigned sum, cnt, mine, sp = 0u;
    for (;;) {
        sum = 0u; cnt = 0u; mine = 0u;
#pragma unroll
        for (unsigned j = 0; j < 16; ++j) { const unsigned c = xb_ld(&bar[XB_XCNT(j)]); sum += c; cnt += (c > 0u) ? 1u : 0u; mine = (j == x) ? c : mine; }
        if (sum == G) break;
        __builtin_amdgcn_s_sleep(1);
        if ((++sp & 255u) == 0u) { if (xb_ld(&bar[XB_TMO])) break; if (sp > XB_SPIN_CAP) { atomicAdd(&bar[XB_TMO], 1u); break; } }
    }
    nloc = mine > 0u ? mine : 1u; nx = cnt > 0u ? cnt : 1u;
}
__device__ __forceinline__ void xcd_barrier(const XcdBarrier& b) {
    asm volatile("s_waitcnt vmcnt(0)" ::: "memory");
    __syncthreads();
    if (threadIdx.x == 0) {
        unsigned* bar = b.bar;
        __builtin_amdgcn_s_waitcnt(0);
        unsigned nloc = b.st[0], nx = b.st[1];
        if (nloc == 0u) { xcd_barrier_complete(bar, b.x, nloc, nx); b.st[0] = nloc; b.st[1] = nx; }
        const unsigned old = xb_add(&bar[XB_XSUB(b.x)], 1u);
        const unsigned gen = old / nloc;
        if (old + 1u == (gen + 1u) * nloc) {
            __builtin_amdgcn_fence(__ATOMIC_RELEASE, "agent");
            asm volatile("s_waitcnt vmcnt(0)" ::: "memory");
            const unsigned og = xb_add(&bar[XB_TOP], 1u);
            const unsigned tg = og / nx;
            if (og + 1u == (tg + 1u) * nx) xb_add(&bar[XB_TOPGEN], 1u);
            else XB_SPIN(xb_ld(&bar[XB_TOPGEN]) == tg, bar);
            __builtin_amdgcn_fence(__ATOMIC_ACQUIRE, "agent");
            xb_add(&bar[XB_XGEN(b.x)], 1u);
            asm volatile("s_waitcnt vmcnt(0)" ::: "memory");
        } else {
            XB_SPIN(xb_ld(&bar[XB_XGEN(b.x)]) == gen, bar);
            __builtin_amdgcn_fence(__ATOMIC_ACQUIRE, "agent");
            asm volatile("s_waitcnt vmcnt(0)" ::: "memory");
        }
    }
    __syncthreads();
}

struct Args {
    const float* in[19]; float* out; unsigned char* ws; int ph_lo, ph_hi; int rep[10];
};
struct Frame {
    LAS unsigned char* lds; int tid, lane, wave, G, vcu;
};

__device__ __forceinline__ void tr_item(const float* W, int ldw, int k0, int n0, bf16_t* WT, int ldt, int drow0, LAS float* scr, int lane) {
    float tv[32];
#pragma unroll
    for (int i = 0; i < 32; ++i) { const int kk = 2 * i + (lane >> 5); tv[i] = W[(size_t)(k0 + kk) * ldw + n0 + (lane & 31)]; }
#pragma unroll
    for (int i = 0; i < 32; ++i) { const int kk = 2 * i + (lane >> 5); scr[kk * 33 + (lane & 31)] = tv[i]; }
    LDS_WAIT(); asm volatile("" ::: "memory");
    const int c = lane & 7;
#pragma unroll
    for (int j = 0; j < 4; ++j) { const int n = (lane >> 3) + 8 * j; const LAS float* s = scr + (8 * c) * 33 + n;
        u32x4 o; o.x = cvtpk(s[0 * 33], s[1 * 33]); o.y = cvtpk(s[2 * 33], s[3 * 33]); o.z = cvtpk(s[4 * 33], s[5 * 33]); o.w = cvtpk(s[6 * 33], s[7 * 33]);
        *(u32x4*)(WT + (size_t)(drow0 + n) * ldt + k0 + 8 * c) = o; }
    LDS_WAIT(); asm volatile("" ::: "memory");
}
constexpr int I_IN = 16 * 136, I_A = 8 * 32, I_OUT = 16 * 32, I_G = 32 * 128, I_D = 32 * 128;
constexpr int I_SMALL = I_IN + 2 * I_A + I_OUT, NITEMS = I_SMALL + 2 * I_G + I_D;
__device__ __forceinline__ void convert_items(const Frame& F, const Args& a, int first, int last, int worker, int nworkers) {
    unsigned char* ws = a.ws;
    LAS float* scr = (LAS float*)(F.lds + F.wave * 16384);
    const float* w_in = a.in[2]; const float* w_a = a.in[8]; const float* w_c = a.in[9]; const float* w_out = a.in[10];
    const float* w_gate = a.in[16]; const float* w_up = a.in[17]; const float* w_down = a.in[18];
    bf16_t* WinT = (bf16_t*)(ws + WS_WIN); bf16_t* WaT = (bf16_t*)(ws + WS_WA); bf16_t* WoutT = (bf16_t*)(ws + WS_WOUT);
    bf16_t* WguT = (bf16_t*)(ws + WS_WGU); bf16_t* WdT = (bf16_t*)(ws + WS_WD);
    for (int it = first + worker * NWAVES + F.wave; it < last; it += nworkers * NWAVES) {
        int r = it;
        if (r < I_IN) { const int kb = r / 136, nb = r % 136; tr_item(w_in, PW, 64 * kb, 32 * nb, WinT, 1024, 32 * nb, scr, F.lane); continue; } r -= I_IN;
        if (r < I_A) { const int kb = r / 32, nb = r % 32; tr_item(w_a, 1024, 64 * kb, 32 * nb, WaT, 1024, 32 * nb, scr, F.lane); continue; } r -= I_A;
        if (r < I_A) { const int kb = r / 32, nb = r % 32; tr_item(w_c, 1024, 64 * kb, 32 * nb, WaT + 512, 1024, 32 * nb, scr, F.lane); continue; } r -= I_A;
        if (r < I_OUT) { const int kb = r / 32, nb = r % 32; tr_item(w_out, 1024, 64 * kb, 32 * nb, WoutT, 1024, 32 * nb, scr, F.lane); continue; } r -= I_OUT;
        if (r < 2 * I_G) { const int up = r >= I_G; if (up) r -= I_G; const int e = r / 128, q = r % 128, kb = q / 8, nb = q % 8, n0 = 32 * nb;
            tr_item((up ? w_up : w_gate) + (size_t)e * 1024 * 256, 256, 64 * kb, n0, WguT + (size_t)e * 512 * 1024, 1024, (n0 >> 7) * 256 + up * 128 + (n0 & 127), scr, F.lane); continue; } r -= 2 * I_G;
        { const int e = r / 128, q = r % 128, kb = q / 32, nb = q % 32; tr_item(w_down + (size_t)e * 256 * 1024, 1024, 64 * kb, 32 * nb, WdT + (size_t)e * 1024 * 256, 256, 32 * nb, scr, F.lane); }
    }
}
__device__ __forceinline__ void p0_prologue(const Frame& F, const Args& a) {
    unsigned char* ws = a.ws;
    const int gw = F.vcu * NWAVES + F.wave, NGW = F.G * NWAVES;
    convert_items(F, a, 0, I_SMALL, F.vcu, F.G);
    const int gt = F.vcu * NTHREADS + F.tid, NGT = F.G * NTHREADS;
    { const float* w_rg = a.in[12]; const float* w_re = a.in[14]; bf16_t* WrT = (bf16_t*)(ws + WS_WR);
      for (int i = gt; i < 48 * 1024; i += NGT) { const int j = i >> 10, k = i & 1023; float v = 0.f; if (j < 4) v = w_rg[k * 4 + j]; else if (j < 36) v = w_re[k * 32 + (j - 4)]; WrT[i] = f2bf(v); } }
    { float* cosT = (float*)(ws + WS_ROPE); float* sinT = cosT + SEQ * 8;
      for (int i = gt; i < SEQ * 8; i += NGT) { const int pos = i >> 3, j = i & 7; const float inv = (float)pow(500000.0, -(double)j / 8.0); const float ang = (float)pos * inv;
          cosT[i] = (float)cos((double)ang); sinT[i] = (float)sin((double)ang); } }
    { const float* x = a.in[0]; const float* g1 = a.in[1]; bf16_t* XN = (bf16_t*)(ws + WS_XN);
      f32x4 gv[4];
#pragma unroll
      for (int j = 0; j < 4; ++j) gv[j] = ((const f32x4*)g1)[F.lane + 64 * j];
      for (int m0 = gw; m0 < M; m0 += 4 * NGW) { f32x4 v[4][4];
#pragma unroll
          for (int q = 0; q < 4; ++q) { const int m = m0 + q * NGW; const f32x4* xr = (const f32x4*)(x + (size_t)(m < M ? m : 0) * D) + F.lane;
#pragma unroll
              for (int j = 0; j < 4; ++j) v[q][j] = xr[64 * j]; }
#pragma unroll
          for (int q = 0; q < 4; ++q) { const int m = m0 + q * NGW; float s = 0.f;
#pragma unroll
              for (int j = 0; j < 4; ++j) s += (v[q][j].x * v[q][j].x + v[q][j].y * v[q][j].y) + (v[q][j].z * v[q][j].z + v[q][j].w * v[q][j].w);
              const float rstd = rsqrtf(wave_sum(s) * (1.f / D) + EPS);
              if (m < M) { u32x2* o8 = (u32x2*)(XN + (size_t)m * D) + F.lane;
#pragma unroll
                  for (int j = 0; j < 4; ++j) { u32x2 w; w.x = cvtpk(v[q][j].x * rstd * gv[j].x, v[q][j].y * rstd * gv[j].y); w.y = cvtpk(v[q][j].z * rstd * gv[j].z, v[q][j].w * rstd * gv[j].w); o8[64 * j] = w; } } } } }
}

__device__ __forceinline__ u32x4 qk_norm_rope(const u32x4 raw, const float (&g)[8], const f32x4 c0, const f32x4 c1, const f32x4 s0, const f32x4 s1, int l7, float scale) {
    float v[8]; unpack8(raw, v); float ss = 0.f;
#pragma unroll
    for (int i = 0; i < 8; ++i) ss += v[i] * v[i];
    ss += __shfl_xor(ss, 1); ss += __shfl_xor(ss, 2); ss += __shfl_xor(ss, 4);
    const float rstd = rsqrtf(ss * (1.f / 64.f) + EPS);
    const float cc[8] = {c0.x, c0.y, c0.z, c0.w, c1.x, c1.y, c1.z, c1.w}, sn[8] = {s0.x, s0.y, s0.z, s0.w, s1.x, s1.y, s1.z, s1.w};
#pragma unroll
    for (int i = 0; i < 8; ++i) { float y = v[i] * rstd * g[i]; const float p = __shfl_xor(y, 1);
        if (l7 == 0) y = y * cc[i] - p * sn[i]; else if (l7 == 1) y = y * cc[i] + p * sn[i];
        v[i] = y * scale; }
    return pack8(v);
}
__device__ __forceinline__ void p2_prep_conv(const Frame& F, const Args& a) {
    unsigned char* ws = a.ws;
    const bf16_t* PROJ = (const bf16_t*)(ws + WS_PROJ); bf16_t* QN = (bf16_t*)(ws + WS_QN); bf16_t* KN = (bf16_t*)(ws + WS_KN); bf16_t* AC = (bf16_t*)(ws + WS_AC);
    const float* cosT = (const float*)(ws + WS_ROPE); const float* sinT = cosT + SEQ * 8;
    const float* qg = a.in[3]; const float* kg = a.in[4]; const float* conv_w = a.in[6]; const float* conv_b = a.in[7];
    const int gw = F.vcu * NWAVES + F.wave, NGW = F.G * NWAVES, lane = F.lane, l7 = lane & 7;
    float gq[8], gk[8];
#pragma unroll
    for (int k = 0; k < 8; ++k) { gq[k] = qg[8 * l7 + k]; gk[k] = kg[8 * l7 + k]; }
    float w0[8], w1[8], w2[8], bb[8];
#pragma unroll
    for (int k = 0; k < 8; ++k) { w0[k] = conv_w[8 * lane + k]; w1[k] = conv_w[CD + 8 * lane + k]; w2[k] = conv_w[2 * CD + 8 * lane + k]; bb[k] = conv_b[8 * lane + k]; }
    for (int ch = gw; ch < M / 16; ch += NGW) {
        const int t0 = ch * 16;
#pragma unroll 1
        for (int grp = 0; grp < 4; ++grp) { const int tb = t0 + 4 * grp;
            u32x4 qraw[4]; f32x4 qc[4][4];
#pragma unroll
            for (int tk = 0; tk < 4; ++tk) { const int t = tb + tk, pos = t & (SEQ - 1); qraw[tk] = *(const u32x4*)(PROJ + (size_t)t * PW + 8 * lane);
                qc[tk][0] = *(const f32x4*)(cosT + pos * 8); qc[tk][1] = *(const f32x4*)(cosT + pos * 8 + 4); qc[tk][2] = *(const f32x4*)(sinT + pos * 8); qc[tk][3] = *(const f32x4*)(sinT + pos * 8 + 4); }
            const int tkk = tb + (lane >> 4), kpos = tkk & (SEQ - 1);
            const u32x4 kraw = *(const u32x4*)(PROJ + (size_t)tkk * PW + C_K + 8 * (lane & 15));
            const f32x4 kc0 = *(const f32x4*)(cosT + kpos * 8), kc1 = *(const f32x4*)(cosT + kpos * 8 + 4), ks0 = *(const f32x4*)(sinT + kpos * 8), ks1 = *(const f32x4*)(sinT + kpos * 8 + 4);
#pragma unroll
            for (int tk = 0; tk < 4; ++tk) { const u32x4 o = qk_norm_rope(qraw[tk], gq, qc[tk][0], qc[tk][1], qc[tk][2], qc[tk][3], l7, QSCALE); *(u32x4*)(QN + (size_t)(tb + tk) * AD + 8 * lane) = o; }
            { const u32x4 o = qk_norm_rope(kraw, gk, kc0, kc1, ks0, ks1, l7, 1.0f); *(u32x4*)(KN + (size_t)tkk * 128 + 8 * (lane & 15)) = o; } }
        float up[8], uc[8];
        { float a8[8], b8[8];
          if ((t0 & (SEQ - 1)) > 0) { unpack8(*(const u32x4*)(PROJ + (size_t)(t0 - 1) * PW + C_CC + 8 * lane), a8); unpack8(*(const u32x4*)(PROJ + (size_t)(t0 - 1) * PW + C_CX + 8 * lane), b8);
#pragma unroll
              for (int k = 0; k < 8; ++k) up[k] = a8[k] * b8[k]; } else {
#pragma unroll
              for (int k = 0; k < 8; ++k) up[k] = 0.f; }
          unpack8(*(const u32x4*)(PROJ + (size_t)t0 * PW + C_CC + 8 * lane), a8); unpack8(*(const u32x4*)(PROJ + (size_t)t0 * PW + C_CX + 8 * lane), b8);
#pragma unroll
          for (int k = 0; k < 8; ++k) uc[k] = a8[k] * b8[k]; }
#pragma unroll 1
        for (int grp = 0; grp < 4; ++grp) { const int tb = t0 + 4 * grp;
            u32x4 rcc[4], rcx[4], rcb[4];
#pragma unroll
            for (int tk = 0; tk < 4; ++tk) { const int t = tb + tk; const bool hn = ((t & (SEQ - 1)) < SEQ - 1); const size_t tn = (size_t)(hn ? t + 1 : t);
                rcc[tk] = *(const u32x4*)(PROJ + tn * PW + C_CC + 8 * lane); rcx[tk] = *(const u32x4*)(PROJ + tn * PW + C_CX + 8 * lane); rcb[tk] = *(const u32x4*)(PROJ + (size_t)t * PW + C_CB + 8 * lane); }
#pragma unroll
            for (int tk = 0; tk < 4; ++tk) { const int t = tb + tk; const bool hn = ((t & (SEQ - 1)) < SEQ - 1);
                float a8[8], b8[8], cbv[8], un[8], o[8]; unpack8(rcc[tk], a8); unpack8(rcx[tk], b8); unpack8(rcb[tk], cbv);
#pragma unroll
                for (int k = 0; k < 8; ++k) { un[k] = hn ? a8[k] * b8[k] : 0.f; o[k] = cbv[k] * (up[k] * w0[k] + uc[k] * w1[k] + un[k] * w2[k] + bb[k]); up[k] = uc[k]; uc[k] = un[k]; }
                *(u32x4*)(AC + (size_t)t * 1024 + 512 + 8 * lane) = pack8(o); } }
    }
}

namespace att {
constexpr int NSLOT = 8, WSOFF = RING_BYTES + 1024, OSTOFF = WSOFF + 2048;
static_assert(OSTOFF + 8 * 2048 <= LDS_BYTES, "attention LDS map");
__device__ __forceinline__ int crow(int r, int hi) { return (r & 3) + 8 * (r >> 2) + 4 * hi; }
__device__ __forceinline__ s16x4 vtr(const LAS char* p) { return __builtin_bit_cast(s16x4, __builtin_amdgcn_ds_read_tr16_b64_v4i16((LAS s16x4*)p)); }
}
__device__ __forceinline__ u32x4 k_norm_rope(const u32x4 raw, const float (&g)[8], float cl, float sl, int l7, int lane) {
    float v[8]; unpack8(raw, v); float ss = 0.f;
#pragma unroll
    for (int i = 0; i < 8; ++i) ss += v[i] * v[i];
    ss += __shfl_xor(ss, 1); ss += __shfl_xor(ss, 2); ss += __shfl_xor(ss, 4);
    const float rstd = rsqrtf(ss * (1.f / 64.f) + EPS);
#pragma unroll
    for (int i = 0; i < 8; ++i) { float y = v[i] * rstd * g[i]; const float p = __shfl_xor(y, 1); const float c = __shfl(cl, (lane & ~7) + i), sn = __shfl(sl, (lane & ~7) + i);
        if (l7 == 0) y = y * c - p * sn; else if (l7 == 1) y = y * c + p * sn;
        v[i] = y; }
    return pack8(v);
}
__device__ __forceinline__ void conv8(const bf16_t* PROJ, bf16_t* AC, int tb, int lane, float (&up)[8], float (&uc)[8], const float* conv_w, const float* conv_b) {
    u32x4 rcc[8], rcx[8], rcb[8];
#pragma unroll
    for (int tk = 0; tk < 8; ++tk) { const int t = tb + tk; const bool hn = ((t & (SEQ - 1)) < SEQ - 1); const size_t tn = (size_t)(hn ? t + 1 : t);
        rcc[tk] = *(const u32x4*)(PROJ + tn * PW + C_CC + 8 * lane); rcx[tk] = *(const u32x4*)(PROJ + tn * PW + C_CX + 8 * lane); rcb[tk] = *(const u32x4*)(PROJ + (size_t)t * PW + C_CB + 8 * lane); }
    float w0[8], w1[8], w2[8], bb[8];
#pragma unroll
    for (int k = 0; k < 8; ++k) { w0[k] = conv_w[8 * lane + k]; w1[k] = conv_w[CD + 8 * lane + k]; w2[k] = conv_w[2 * CD + 8 * lane + k]; bb[k] = conv_b[8 * lane + k]; }
#pragma unroll
    for (int tk = 0; tk < 8; ++tk) { const int t = tb + tk; const bool hn = ((t & (SEQ - 1)) < SEQ - 1);
        float a8[8], b8[8], cbv[8], un[8], o[8]; unpack8(rcc[tk], a8); unpack8(rcx[tk], b8); unpack8(rcb[tk], cbv);
#pragma unroll
        for (int k = 0; k < 8; ++k) { un[k] = hn ? a8[k] * b8[k] : 0.f; o[k] = cbv[k] * (up[k] * w0[k] + uc[k] * w1[k] + un[k] * w2[k] + bb[k]); up[k] = uc[k]; uc[k] = un[k]; }
        *(u32x4*)(AC + (size_t)t * 1024 + 512 + 8 * lane) = pack8(o); }
}
__device__ __forceinline__ void p3_attention(const Frame& F, const Args& a) {
    using namespace att;
    unsigned char* ws = a.ws;
    const bf16_t* PROJ = (const bf16_t*)(ws + WS_PROJ); bf16_t* AC = (bf16_t*)(ws + WS_AC);
    const float* cosT = (const float*)(ws + WS_ROPE); const float* sinT = cosT + SEQ * 8;
    const float* qg = a.in[3]; const float* kg = a.in[4]; const float* sink = a.in[5];
    const int lane = F.lane, wid = F.wave, r32 = lane & 31, hi = lane >> 5, l7 = lane & 7;
    const float bound = 8.0f * wave_max(fabsf(qg[lane])) * wave_max(fabsf(kg[lane])) * 1.4426950408889634f * 1.0001f;
    LAS char* lds = (LAS char*)F.lds; LAS float* wsf = (LAS float*)(lds + WSOFF) + wid * 64;
    const int g = wid >> 1, qsub = wid & 1;
    float gk8[8];
#pragma unroll
    for (int k = 0; k < 8; ++k) gk8[k] = kg[8 * l7 + k];
    for (int su = F.vcu; su < NB * NKV * 16; su += F.G) {
        const int n0 = (su & 15) * 4, hk = (su >> 4) & 1, b = su >> 5;
        const int h = hk * 4 + g; const float snk = sink[h] * 1.4426950408889634f; const float mref = fmaxf(bound, snk);
        const size_t rowbase = (size_t)b * SEQ;
        __syncthreads();
        { u32x4 kraw[NSLOT], vraw[NSLOT]; float kcs[NSLOT][2];
#pragma unroll
          for (int sl = 0; sl < NSLOT; ++sl) { const int j = n0 - 2 + sl; const bool ok = (j >= 0 && j < 64); const int jj = ok ? j : n0;
              const int key = 8 * wid + (lane >> 3), pos = 64 * jj + key;
              kraw[sl] = *(const u32x4*)(PROJ + (rowbase + pos) * PW + C_K + hk * 64 + l7 * 8);
              kcs[sl][0] = cosT[pos * 8 + l7]; kcs[sl][1] = sinT[pos * 8 + l7];
              vraw[sl] = *(const u32x4*)(PROJ + (rowbase + 64 * jj + 16 * (wid & 3) + (lane >> 2)) * PW + C_V + hk * 64 + (wid >> 2) * 32 + (lane & 3) * 8); }
#pragma unroll
          for (int sl = 0; sl < NSLOT; ++sl) { const int key = 8 * wid + (lane >> 3);
              const u32x4 kn = k_norm_rope(kraw[sl], gk8, kcs[sl][0], kcs[sl][1], l7, lane);
              *(LAS u32x4*)(lds + sl * 16384 + l7 * 1024 + key * 16) = kn;
              *(LAS u32x4*)(lds + sl * 16384 + 8192 + wid * 1024 + lane * 16) = vraw[sl]; } }
        __syncthreads();
#pragma unroll 1
        for (int uu = 0; uu < 4; ++uu) {
        const int n64 = n0 + uu;
        const int qs = n64 * 64 + qsub * 32;
        bf16x8 qr[4];
        { float qv[4][8]; float ss = 0.f; const int pos = qs + r32;
#pragma unroll
          for (int d0 = 0; d0 < 4; ++d0) { const u32x4 raw = *(const u32x4*)(PROJ + (rowbase + pos) * PW + C_Q + h * 64 + d0 * 16 + hi * 8); unpack8(raw, qv[d0]); }
          const f32x4 c0 = *(const f32x4*)(cosT + pos * 8), c1 = *(const f32x4*)(cosT + pos * 8 + 4), s0 = *(const f32x4*)(sinT + pos * 8), s1 = *(const f32x4*)(sinT + pos * 8 + 4);
#pragma unroll
          for (int d0 = 0; d0 < 4; ++d0)
#pragma unroll
              for (int k = 0; k < 8; ++k) ss += qv[d0][k] * qv[d0][k];
          ss += __shfl_xor(ss, 32);
          const float rstd = rsqrtf(ss * (1.f / 64.f) + EPS);
#pragma unroll
          for (int d0 = 0; d0 < 4; ++d0) { const f32x4 ga = *(const f32x4*)(qg + d0 * 16 + hi * 8), gb = *(const f32x4*)(qg + d0 * 16 + hi * 8 + 4); const float gg[8] = {ga.x, ga.y, ga.z, ga.w, gb.x, gb.y, gb.z, gb.w};
#pragma unroll
              for (int k = 0; k < 8; ++k) qv[d0][k] = qv[d0][k] * rstd * gg[k]; }
          const float cc[8] = {c0.x, c0.y, c0.z, c0.w, c1.x, c1.y, c1.z, c1.w}, sn[8] = {s0.x, s0.y, s0.z, s0.w, s1.x, s1.y, s1.z, s1.w};
#pragma unroll
          for (int k = 0; k < 8; ++k) { const float y = qv[0][k], p = __shfl_xor(y, 32); qv[0][k] = (hi == 0) ? (y * cc[k] - p * sn[k]) : (y * cc[k] + p * sn[k]); }
#pragma unroll
          for (int d0 = 0; d0 < 4; ++d0) {
#pragma unroll
              for (int k = 0; k < 8; ++k) qv[d0][k] *= QSCALE;
              qr[d0] = __builtin_bit_cast(bf16x8, pack8(qv[d0])); } }
        f32x16 o0 = {}, o1 = {}; float lsum = 0.f;
        const int qi = qs + r32;
#pragma unroll 1
        for (int sl = 0; sl < 5; ++sl) { const int j = n64 - 2 + sl; if (j < 0 || j >= 64) continue;
            const LAS char* tile = lds + (uu + sl) * 16384;
            const LAS char* kb = tile + hi * 1024 + r32 * 16;
            f32x16 p0 = {}, p1 = {};
#pragma unroll
            for (int d0 = 0; d0 < 4; ++d0) { const bf16x8 b0 = *(const LAS bf16x8*)(kb + d0 * 2048), b1 = *(const LAS bf16x8*)(kb + d0 * 2048 + 512);
                p0 = __builtin_amdgcn_mfma_f32_32x32x16_bf16(b0, qr[d0], p0, 0, 0, 0); p1 = __builtin_amdgcn_mfma_f32_32x32x16_bf16(b1, qr[d0], p1, 0, 0, 0); }
            if (sl == 0 || sl == 4) {
                const int kb0 = 64 * j + 4 * hi;
#pragma unroll
                for (int r = 0; r < 16; ++r) { const int kk = kb0 + (r & 3) + 8 * (r >> 2); const int d0_ = qi - kk, d1_ = qi - (kk + 32);
                    const bool v0 = (d0_ <= 128) && (d0_ >= -128), v1 = (d1_ <= 128) && (d1_ >= -128);
                    p0[r] = v0 ? __builtin_amdgcn_exp2f(p0[r] - mref) : 0.f; p1[r] = v1 ? __builtin_amdgcn_exp2f(p1[r] - mref) : 0.f; lsum += p0[r] + p1[r]; }
            } else {
#pragma unroll
                for (int r = 0; r < 16; ++r) { p0[r] = __builtin_amdgcn_exp2f(p0[r] - mref); p1[r] = __builtin_amdgcn_exp2f(p1[r] - mref); lsum += p0[r] + p1[r]; }
            }
            u32x4 pw0, pw1, pw2, pw3;
            pw0 = (u32x4){cvtpk(p0[0], p0[1]), cvtpk(p0[2], p0[3]), cvtpk(p0[4], p0[5]), cvtpk(p0[6], p0[7])};
            pw1 = (u32x4){cvtpk(p0[8], p0[9]), cvtpk(p0[10], p0[11]), cvtpk(p0[12], p0[13]), cvtpk(p0[14], p0[15])};
            pw2 = (u32x4){cvtpk(p1[0], p1[1]), cvtpk(p1[2], p1[3]), cvtpk(p1[4], p1[5]), cvtpk(p1[6], p1[7])};
            pw3 = (u32x4){cvtpk(p1[8], p1[9]), cvtpk(p1[10], p1[11]), cvtpk(p1[12], p1[13]), cvtpk(p1[14], p1[15])};
            const LAS char* vp = tile + 8192 + ((lane >> 4) & 1) * 32 + (lane & 3) * 8 + (4 * hi + ((lane & 15) >> 2)) * 64;
#pragma unroll
            for (int dh = 0; dh < 2; ++dh) {
#pragma unroll
                for (int ks = 0; ks < 4; ++ks) { const s16x4 lo = vtr(vp + dh * 4096 + ks * 1024), hh = vtr(vp + dh * 4096 + ks * 1024 + 512);
                    const bf16x8 vf = (bf16x8){lo[0], lo[1], lo[2], lo[3], hh[0], hh[1], hh[2], hh[3]};
                    const u32x4 pw = ks == 0 ? pw0 : ks == 1 ? pw1 : ks == 2 ? pw2 : pw3;
                    if (dh == 0) o0 = __builtin_amdgcn_mfma_f32_32x32x16_bf16(__builtin_bit_cast(bf16x8, pw), vf, o0, 0, 0, 0);
                    else o1 = __builtin_amdgcn_mfma_f32_32x32x16_bf16(__builtin_bit_cast(bf16x8, pw), vf, o1, 0, 0, 0); } }
        }
        lsum += __shfl_xor(lsum, 32); lsum += __builtin_amdgcn_exp2f(snk - mref);
        if (hi == 0) wsf[r32] = lsum;
        LDS_WAIT(); asm volatile("" ::: "memory");
        float rl[16];
#pragma unroll
        for (int r = 0; r < 16; ++r) rl[r] = __builtin_amdgcn_rcpf(wsf[crow(r, hi)]);
        LAS bf16_t* stg = (LAS bf16_t*)(lds + OSTOFF) + wid * 1024;
        bf16_t* Ow = AC + (rowbase + qs) * 1024 + h * 64;
#pragma unroll
        for (int dh = 0; dh < 2; ++dh) {
#pragma unroll
            for (int r = 0; r < 16; ++r) stg[crow(r, hi) * 32 + r32] = f2bf((dh ? o1[r] : o0[r]) * rl[r]);
            LDS_WAIT(); asm volatile("" ::: "memory");
#pragma unroll
            for (int i = 0; i < 2; ++i) { const int row = i * 16 + (lane >> 2), ch = lane & 3; const u32x4 v = *(const LAS u32x4*)(stg + row * 32 + ch * 8); *(u32x4*)(Ow + (size_t)row * 1024 + dh * 32 + ch * 8) = v; }
            LDS_WAIT(); asm volatile("" ::: "memory"); }
        }
    }
    __syncthreads();
    { const float* conv_w = a.in[6]; const float* conv_b = a.in[7];
      const int gw = F.vcu * NWAVES + wid, NGW = F.G * NWAVES;
      for (int ch = gw; ch < M / 16; ch += NGW) { const int t0 = ch * 16; float up[8], uc[8];
          { float a8[8], b8[8];
            if ((t0 & (SEQ - 1)) > 0) { unpack8(*(const u32x4*)(PROJ + (size_t)(t0 - 1) * PW + C_CC + 8 * lane), a8); unpack8(*(const u32x4*)(PROJ + (size_t)(t0 - 1) * PW + C_CX + 8 * lane), b8);
#pragma unroll
                for (int k = 0; k < 8; ++k) up[k] = a8[k] * b8[k]; } else {
#pragma unroll
                for (int k = 0; k < 8; ++k) up[k] = 0.f; }
            unpack8(*(const u32x4*)(PROJ + (size_t)t0 * PW + C_CC + 8 * lane), a8); unpack8(*(const u32x4*)(PROJ + (size_t)t0 * PW + C_CX + 8 * lane), b8);
#pragma unroll
            for (int k = 0; k < 8; ++k) uc[k] = a8[k] * b8[k]; }
          conv8(PROJ, AC, t0, lane, up, uc, conv_w, conv_b); conv8(PROJ, AC, t0 + 8, lane, up, uc, conv_w, conv_b); } }
    __syncthreads();
}

__device__ __forceinline__ void p6_route(const Frame& F, const Args& a) {
    unsigned char* ws = a.ws;
    const float* X = a.in[0]; const bf16_t* D1 = (const bf16_t*)(ws + WS_D1); const float* g2 = a.in[11]; const float* b_rg = a.in[13]; const float* b_re = a.in[15];
    bf16_t* H2 = (bf16_t*)(ws + WS_H2); const bf16_t* WrT = (const bf16_t*)(ws + WS_WR);
    int* asg = (int*)(ws + WS_ASG); f32x2* rsg = (f32x2*)(ws + WS_RSG); unsigned* gcnt = (unsigned*)(ws + WS_CTL) + CW_CNT;
    const int lane = F.lane, wid = F.wave, r = lane & 15, kg = lane >> 4;
    constexpr int WR_PITCH = 2064, WR_BYTES = 48 * WR_PITCH, G2_OFF = WR_BYTES, LG_OFF = G2_OFF + 4096;
    LAS unsigned char* wrl = F.lds; LAS float* g2l = (LAS float*)(F.lds + G2_OFF); LAS float* lg = (LAS float*)(F.lds + LG_OFF) + wid * (16 * 48);
    LAS int* hist = (LAS int*)(F.lds + LDSCTL_OFF + LC_HIST); LAS int* base = (LAS int*)(F.lds + LDSCTL_OFF + LC_BASE);
    for (int i = F.tid; i < 48 * 128; i += NTHREADS) { const int row = i >> 7, c = i & 127; *(LAS u32x4*)(wrl + row * WR_PITCH + c * 16) = *(const u32x4*)(WrT + (size_t)row * D + c * 8); }
    for (int i = F.tid; i < 256; i += NTHREADS) *(LAS f32x4*)(g2l + 4 * i) = *(const f32x4*)(g2 + 4 * i);
    const int nblk = M / 128;
    for (int blk = F.vcu; blk < nblk; blk += F.G) {
        if (F.tid < 32) hist[F.tid] = 0;
        __syncthreads();
        const int row0 = blk * 128 + wid * 16;
        f32x4 acc[3] = {{0.f, 0.f, 0.f, 0.f}, {0.f, 0.f, 0.f, 0.f}, {0.f, 0.f, 0.f, 0.f}}; float ss = 0.f;
        const float* xr = X + (size_t)(row0 + r) * D + 8 * kg; const bf16_t* dr = D1 + (size_t)(row0 + r) * D + 8 * kg; bf16_t* hr = H2 + (size_t)(row0 + r) * D + 8 * kg;
        const LAS unsigned char* wb = wrl + r * WR_PITCH + 16 * kg; const LAS float* gl = g2l + 8 * kg;
#pragma unroll 1
        for (int s0 = 0; s0 < 32; s0 += 8) { f32x4 xv[8][2]; u32x4 dv[8];
#pragma unroll
            for (int q = 0; q < 8; ++q) { xv[q][0] = *(const f32x4*)(xr + 32 * (s0 + q)); xv[q][1] = *(const f32x4*)(xr + 32 * (s0 + q) + 4); dv[q] = *(const u32x4*)(dr + 32 * (s0 + q)); }
#pragma unroll
            for (int q = 0; q < 8; ++q) { const int s = s0 + q; f32x4 x0 = xv[q][0], x1 = xv[q][1];
                x0.x += bflo(dv[q].x); x0.y += bfhi(dv[q].x); x0.z += bflo(dv[q].y); x0.w += bfhi(dv[q].y); x1.x += bflo(dv[q].z); x1.y += bfhi(dv[q].z); x1.z += bflo(dv[q].w); x1.w += bfhi(dv[q].w);
                const f32x4 ga = *(const LAS f32x4*)(gl + 32 * s), gb = *(const LAS f32x4*)(gl + 32 * s + 4);
                ss += (x0.x * x0.x + x0.y * x0.y) + (x0.z * x0.z + x0.w * x0.w) + (x1.x * x1.x + x1.y * x1.y) + (x1.z * x1.z + x1.w * x1.w);
                u32x4 w; w.x = cvtpk(x0.x * ga.x, x0.y * ga.y); w.y = cvtpk(x0.z * ga.z, x0.w * ga.w); w.z = cvtpk(x1.x * gb.x, x1.y * gb.y); w.w = cvtpk(x1.z * gb.z, x1.w * gb.w);
                *(u32x4*)(hr + 32 * s) = w; const bf16x8 af = __builtin_bit_cast(bf16x8, w);
#pragma unroll
                for (int j = 0; j < 3; ++j) { const bf16x8 bfr = *(const LAS bf16x8*)(wb + 16 * j * WR_PITCH + 64 * s); acc[j] = __builtin_amdgcn_mfma_f32_16x16x32_bf16(af, bfr, acc[j], 0, 0, 0); } } }
        ss += __shfl_xor(ss, 16); ss += __shfl_xor(ss, 32);
        const float rstd = rsqrtf(ss * (1.f / D) + EPS);
#pragma unroll
        for (int j = 0; j < 3; ++j)
#pragma unroll
            for (int i = 0; i < 4; ++i) lg[(4 * kg + i) * 48 + 16 * j + r] = acc[j][i];
        LDS_WAIT(); asm volatile("" ::: "memory");
        int e0 = 0, e1 = 0, rk0 = 0, rk1 = 0; float gt0 = 0.f, gt1 = 0.f;
        if (lane < 16) {
            const LAS float* L = lg + lane * 48;
            float gl4[4]; int grp = 0; float gm;
#pragma unroll
            for (int i = 0; i < 4; ++i) gl4[i] = L[i] * rstd + b_rg[i];
            gm = gl4[0];
#pragma unroll
            for (int i = 1; i < 4; ++i) if (gl4[i] > gm) { gm = gl4[i]; grp = i; }
            float gs = 0.f;
#pragma unroll
            for (int i = 0; i < 4; ++i) gs += __expf(gl4[i] - gm);
            const float pg = 1.0f / gs;
            float el[8];
#pragma unroll
            for (int i = 0; i < 8; ++i) el[i] = L[4 + grp * 8 + i] * rstd + b_re[grp * 8 + i];
            int i0 = 0; float m0 = el[0];
#pragma unroll
            for (int i = 1; i < 8; ++i) if (el[i] > m0) { m0 = el[i]; i0 = i; }
            int i1 = -1; float m1 = -3.0e38f;
#pragma unroll
            for (int i = 0; i < 8; ++i) if (i != i0 && el[i] > m1) { m1 = el[i]; i1 = i; }
            const float ex1 = __expf(m1 - m0); const float den = 1.0f / (1.0f + ex1);
            gt0 = pg * den; gt1 = pg * ex1 * den; e0 = grp * 8 + i0; e1 = grp * 8 + i1;
            rk0 = __hip_atomic_fetch_add(&hist[e0], 1, __ATOMIC_RELAXED, __HIP_MEMORY_SCOPE_WORKGROUP);
            rk1 = __hip_atomic_fetch_add(&hist[e1], 1, __ATOMIC_RELAXED, __HIP_MEMORY_SCOPE_WORKGROUP);
        }
        __syncthreads();
        if (F.tid < 32) { const int n = hist[F.tid]; int bs = 0; if (n > 0) bs = (int)__hip_atomic_fetch_add(gcnt + F.tid, (unsigned)n, __ATOMIC_RELAXED, __HIP_MEMORY_SCOPE_AGENT); base[F.tid] = bs; }
        __syncthreads();
        if (lane < 16) { const int tok = row0 + lane;
            const size_t p0 = (size_t)e0 * CAP + base[e0] + rk0, p1 = (size_t)e1 * CAP + base[e1] + rk1;
            asg[p0] = tok * 2; asg[p1] = tok * 2 + 1; rsg[p0] = (f32x2){gt0, rstd}; rsg[p1] = (f32x2){gt1, rstd}; }
        __syncthreads();
    }
}

__device__ __forceinline__ void moe_tables(const Frame& F, const Args& a) {
    const unsigned* gcnt = (const unsigned*)(a.ws + WS_CTL) + CW_CNT;
    LAS int* mtpre = (LAS int*)(F.lds + LDSCTL_OFF + LC_MTPRE); LAS int* cnt = (LAS int*)(F.lds + LDSCTL_OFF + LC_CNT);
    __syncthreads();
    if (F.tid == 0) { int acc = 0; for (int e = 0; e < 32; ++e) { const int n = (int)__hip_atomic_load(gcnt + e, __ATOMIC_RELAXED, __HIP_MEMORY_SCOPE_AGENT); cnt[e] = n; mtpre[e] = acc; acc += (n + 255) >> 8; } mtpre[32] = acc; }
    __syncthreads();
}

__device__ __forceinline__ void p9_combine(const Frame& F, const Args& a, bool dummy = false) {
    const float* X = a.in[0]; const bf16_t* D1 = (const bf16_t*)(a.ws + WS_D1); const bf16_t* Y = (const bf16_t*)(a.ws + WS_Y);
    float* lo_dst = dummy ? (float*)(a.ws + WS_H2) : a.out; float* hi_dst = dummy ? (float*)(a.ws + WS_MERGED) - (size_t)(M / 2) * D : a.out;
    const unsigned gt = (unsigned)F.vcu * NTHREADS + F.tid, NGT = (unsigned)F.G * NTHREADS, TOT = (unsigned)M * 128u;
    for (unsigned i0 = gt; i0 < TOT; i0 += 4 * NGT) {
        f32x4 xa[4], xb[4]; u32x4 y0[4], y1[4], dd[4];
#pragma unroll
        for (int k = 0; k < 4; ++k) { const unsigned i = i0 + k * NGT, ii = i < TOT ? i : gt; const size_t tok = ii >> 7, c8 = (ii & 127) * 8;
            xa[k] = *(const f32x4*)(X + tok * D + c8); xb[k] = *(const f32x4*)(X + tok * D + c8 + 4); dd[k] = *(const u32x4*)(D1 + tok * D + c8);
            y0[k] = *(const u32x4*)(Y + (tok * 2) * D + c8); y1[k] = *(const u32x4*)(Y + (tok * 2 + 1) * D + c8); }
#pragma unroll
        for (int k = 0; k < 4; ++k) { const unsigned i = i0 + k * NGT; if (i < TOT) { const size_t tok = i >> 7, c8 = (i & 127) * 8; f32x4 x0 = xa[k], x1 = xb[k];
            x0.x += bflo(dd[k].x) + (bflo(y0[k].x) + bflo(y1[k].x)); x0.y += bfhi(dd[k].x) + (bfhi(y0[k].x) + bfhi(y1[k].x)); x0.z += bflo(dd[k].y) + (bflo(y0[k].y) + bflo(y1[k].y)); x0.w += bfhi(dd[k].y) + (bfhi(y0[k].y) + bfhi(y1[k].y));
            x1.x += bflo(dd[k].z) + (bflo(y0[k].z) + bflo(y1[k].z)); x1.y += bfhi(dd[k].z) + (bfhi(y0[k].z) + bfhi(y1[k].z)); x1.z += bflo(dd[k].w) + (bflo(y0[k].w) + bflo(y1[k].w)); x1.w += bfhi(dd[k].w) + (bfhi(y0[k].w) + bfhi(y1[k].w));
            float* dst = (tok < (size_t)(M / 2)) ? lo_dst : hi_dst; *(f32x4*)(dst + tok * D + c8) = x0; *(f32x4*)(dst + tok * D + c8 + 4) = x1; } }
    }
}

constexpr int N_PHASES = 10;
__global__ void __launch_bounds__(NTHREADS, 2) fwd_kernel(Args args) {
    extern __shared__ __attribute__((aligned(16))) unsigned char lds_raw[];
    Frame F; F.lds = (LAS unsigned char*)lds_raw; F.tid = threadIdx.x; F.lane = F.tid & 63; F.wave = __builtin_amdgcn_readfirstlane(F.tid >> 6);
    F.G = gridDim.x; { const int bx = blockIdx.x; F.vcu = (F.G % 8 == 0) ? (bx % 8) * (F.G / 8) + bx / 8 : bx; }
    for (int u = F.tid; u < (LDS_BYTES - LDSCTL_OFF) / 4; u += NTHREADS) ((LAS unsigned*)(F.lds + LDSCTL_OFF))[u] = 0u;
    __syncthreads();
    unsigned char* ws = args.ws;
    const int lo = args.ph_lo, hi = args.ph_hi;
#ifndef PH_MASK
#define PH_MASK 0x3ff
#endif
#define IN(k) (((PH_MASK >> (k)) & 1) && lo <= (k) && (k) < hi)
#if MK_USE_CG
#define GRID_BAR(k) do { if (IN(k) && IN((k) + 1)) { cg::this_grid().sync(); } } while (0)
#else
    XcdBarrier bar; bar.bar = (unsigned*)(ws + WS_CTL) + CW_BAR; bar.x = 0; bar.st = nullptr;
    if (hi - lo > 1) bar = xcd_barrier_post((unsigned*)(ws + WS_CTL) + CW_BAR, (volatile LAS unsigned*)(F.lds + LDSCTL_OFF + LC_MISC) + 8);
#define GRID_BAR(k) do { if (IN(k) && IN((k) + 1)) { xcd_barrier(bar); } } while (0)
#endif
    const LAS int* mtpre = (const LAS int*)(F.lds + LDSCTL_OFF + LC_MTPRE); const LAS int* lcnt = (const LAS int*)(F.lds + LDSCTL_OFF + LC_CNT);

#define REP(k) for (int rep_ = 0; rep_ < args.rep[k]; ++rep_)
#define REFRESH() do { F.tid = threadIdx.x; asm volatile("" : "+v"(F.tid)); F.lane = F.tid & 63; } while (0)
#define REPBAR() do { if (rep_) xcd_barrier(bar); REFRESH(); } while (0)
    if (IN(0)) REP(0) { REPBAR(); p0_prologue(F, args); } GRID_BAR(0);
    if (IN(1)) REP(1) { REPBAR(); pg8::PlainOrder S{(const bf16_t*)(ws + WS_XN), (const bf16_t*)(ws + WS_WIN), 1024, 1024, M / 256, PW / 256, F.G, (int)blockIdx.x};
        pg8::EpiProj E{(bf16_t*)(ws + WS_PROJ)};
        pg8::gemm_phase<pg8::EpiProj, pg8::PlainOrder, true>(F.lds, 1024, 1024, 1024, S, E);
        if (rep_ == 0) { const int nwg = (M / 256) * (PW / 256), maxc = (nwg + F.G - 1) / F.G, full = nwg - (maxc - 1) * F.G;
            if (full >= F.G) convert_items(F, args, I_SMALL, NITEMS, (int)blockIdx.x, F.G);
            else if ((int)blockIdx.x >= full) convert_items(F, args, I_SMALL, NITEMS, (int)blockIdx.x - full, F.G - full); } } GRID_BAR(1);
    if (IN(3)) REP(3) { REPBAR(); p3_attention(F, args); } GRID_BAR(3);
    if (IN(4)) REP(4) { REPBAR(); pg8::PlainOrder S{(const bf16_t*)(ws + WS_AC), (const bf16_t*)(ws + WS_WA), 1024, 1024, M / 256, D / 256, F.G, (int)blockIdx.x};
        pg8::EpiGate2 E{(const bf16_t*)(ws + WS_PROJ), (bf16_t*)(ws + WS_MERGED)};
        pg8::gemm_phase<pg8::EpiGate2, pg8::PlainOrder, true>(F.lds, 1024, 1024, 1024, S, E); } GRID_BAR(4);
    if (IN(5)) REP(5) { REPBAR(); pg8::PlainOrder S{(const bf16_t*)(ws + WS_MERGED), (const bf16_t*)(ws + WS_WOUT), 1024, 1024, M / 256, D / 256, F.G, (int)blockIdx.x};
        pg8::EpiD1 E{(bf16_t*)(ws + WS_D1)};
        pg8::gemm_phase<pg8::EpiD1, pg8::PlainOrder, true>(F.lds, 1024, 1024, 1024, S, E); } GRID_BAR(5);
    if (IN(6)) REP(6) { REFRESH(); if (rep_) { xcd_barrier(bar); if (blockIdx.x == 0 && F.tid < 32) ((unsigned*)(ws + WS_CTL) + CW_CNT)[F.tid] = 0u; xcd_barrier(bar); } p6_route(F, args); } GRID_BAR(6);
    if (IN(7)) REP(7) { REPBAR(); moe_tables(F, args);
        pg8::MoeGuOrder S; S.mtpre = mtpre; S.cnt = lcnt; S.NT = 2; S.G = F.G; S.c = (int)blockIdx.x; S.H2 = (const bf16_t*)(ws + WS_H2); S.Wgu = (const bf16_t*)(ws + WS_WGU); S.asg = (const int*)(ws + WS_ASG);
        pg8::EpiGU E{(bf16_t*)(ws + WS_HID), (const f32x2*)(ws + WS_RSG), mtpre};
        pg8::gemm_phase<pg8::EpiGU, pg8::MoeGuOrder, true>(F.lds, 1024, 1024, 1024, S, E); } GRID_BAR(7);
    if (IN(8)) REP(8) { REPBAR(); moe_tables(F, args);
        pg8::MoeDownOrder S; S.mtpre = mtpre; S.cnt = lcnt; S.NT = 4; S.G = F.G; S.c = (int)blockIdx.x; S.HID = (const bf16_t*)(ws + WS_HID); S.Wd = (const bf16_t*)(ws + WS_WD);
        pg8::EpiDown E{(bf16_t*)(ws + WS_Y), (const int*)(ws + WS_ASG), (const f32x2*)(ws + WS_RSG), mtpre};
        pg8::gemm_phase<pg8::EpiDown, pg8::MoeDownOrder, true, true>(F.lds, 256, 256, 256, S, E); } GRID_BAR(8);
    if (IN(9)) { REFRESH(); if (args.rep[9] > 1) { p9_combine(F, args, true); xcd_barrier(bar); } p9_combine(F, args); }
#undef IN
#undef GRID_BAR
}

extern "C" void kernel_launch(void* const* d_in, const int* in_sizes, int n_in, void* d_out, int out_size, void* d_ws, size_t ws_size, hipStream_t stream) {
    static int grid = 0;
    if (grid == 0) {
        if (n_in != 19 || in_sizes[0] != M * D || out_size != M * D || ws_size < WS_END) { fprintf(stderr, "kernel_launch: unexpected shapes (n_in %d, in0 %d, out %d, ws %zu)\n", n_in, n_in > 0 ? in_sizes[0] : -1, out_size, ws_size); grid = -1; return; }
        int dev = 0, cus = 0, per_cu = 0;
        if (hipGetDevice(&dev) != hipSuccess || hipDeviceGetAttribute(&cus, hipDeviceAttributeMultiprocessorCount, dev) != hipSuccess) { grid = -1; return; }
        if (hipFuncSetAttribute((const void*)fwd_kernel, hipFuncAttributeMaxDynamicSharedMemorySize, LDS_BYTES) != hipSuccess) { fprintf(stderr, "kernel_launch: hipFuncSetAttribute failed\n"); grid = -1; return; }
        if (hipOccupancyMaxActiveBlocksPerMultiprocessor(&per_cu, (const void*)fwd_kernel, NTHREADS, LDS_BYTES) != hipSuccess || per_cu < 1) { fprintf(stderr, "kernel_launch: occupancy query says %d\n", per_cu); per_cu = 1; }
        (void)hipGetLastError();
        grid = cus * 1;
        fprintf(stderr, "kernel_launch: cus %d per_cu %d grid %d\n", cus, per_cu, grid);
    }
    if (grid < 0) return;
    (void)hipMemsetAsync((char*)d_ws + WS_CTL, 0, CTL_ZERO_BYTES, stream);
    Args a{};
    for (int i = 0; i < 19; ++i) a.in[i] = (const float*)d_in[i];
    a.out = (float*)d_out; a.ws = (unsigned char*)d_ws;
    for (int i = 0; i < 10; ++i) a.rep[i] = (i == PROBE_DUP) ? 2 : 1;
#if MK_N_LAUNCHES == 1
    a.ph_lo = 0; a.ph_hi = N_PHASES;
    void* kargs[] = {&a};
#if MK_USE_CG
    hipError_t e = hipLaunchCooperativeKernel((const void*)fwd_kernel, dim3(grid), dim3(NTHREADS), kargs, LDS_BYTES, stream);
    if (e != hipSuccess) fprintf(stderr, "kernel_launch: cooperative launch failed: %s\n", hipGetErrorString(e));
#else
    (void)kargs; hipLaunchKernelGGL(fwd_kernel, dim3(grid), dim3(NTHREADS), LDS_BYTES, stream, a);
#endif
#else
    for (int p = 0; p < N_PHASES; ++p) { a.ph_lo = p; a.ph_hi = p + 1; hipLaunchKernelGGL(fwd_kernel, dim3(grid), dim3(NTHREADS), LDS_BYTES, stream, a); }
#endif
}
```

```cpp
#include <hip/hip_runtime.h>
#include <hip/hip_cooperative_groups.h>
#include <cstdio>
#include <cstdint>
namespace cg = cooperative_groups;

#ifndef PROBE_DUP
#define PROBE_DUP -1
#endif
#ifndef MK_N_LAUNCHES
#define MK_N_LAUNCHES 1
#endif

#define LAS __attribute__((address_space(3)))
#define GAS __attribute__((address_space(1)))
typedef unsigned short bf16_t;
typedef short bf16x8 __attribute__((ext_vector_type(8)));
typedef short s16x4 __attribute__((ext_vector_type(4)));
typedef float f32x4 __attribute__((ext_vector_type(4)));
typedef float f32x2 __attribute__((ext_vector_type(2)));
typedef float f32x16 __attribute__((ext_vector_type(16)));
typedef unsigned u32x4 __attribute__((ext_vector_type(4)));
typedef unsigned u32x2 __attribute__((ext_vector_type(2)));
typedef __bf16 bf16x2_t __attribute__((ext_vector_type(2)));

constexpr int NB = 8, SEQ = 4096, M = NB * SEQ, D = 1024, PW = 4352;
constexpr int NH = 8, NKV = 2, HD = 64, AD = 512, CD = 512;
constexpr int C_Q = 0, C_K = 512, C_V = 640, C_CB = 768, C_CC = 1280, C_CX = 1792, C_GA = 2304;
constexpr int NE = 32, DFF = 256, CAP = 32768;
constexpr float EPS = 1e-6f;
constexpr float QSCALE = 0.125f * 1.4426950408889634f;
constexpr int NWAVES = 8, NTHREADS = 512;

constexpr size_t MiB = 1u << 20;
constexpr size_t WS_CTL = 0, CTL_ZERO_BYTES = 64 * 1024;
constexpr size_t WS_ROPE = 1 * MiB;
constexpr size_t WS_WR = 1 * MiB + 256 * 1024;
constexpr size_t WS_WIN = 2 * MiB;
constexpr size_t WS_WA = 11 * MiB, WS_WC = 12 * MiB;
constexpr size_t WS_WOUT = 13 * MiB;
constexpr size_t WS_WGU = 16 * MiB;
constexpr size_t WS_WD = 48 * MiB;
constexpr size_t WS_XN = 64 * MiB;
constexpr size_t WS_AC = 64 * MiB;
constexpr size_t WS_PROJ = 128 * MiB;
constexpr size_t WS_H2 = 128 * MiB;
constexpr size_t WS_HID = 192 * MiB;
constexpr size_t WS_Y = 232 * MiB;
constexpr size_t WS_QN = 400 * MiB;
constexpr size_t WS_KN = 432 * MiB;
constexpr size_t WS_MERGED = 400 * MiB;
constexpr size_t WS_ASG = 464 * MiB;
constexpr size_t WS_RSG = 468 * MiB;
constexpr size_t WS_END = 476 * MiB;
constexpr int CW_CNT = 1024;
constexpr int CW_BAR = 4096;

constexpr int RING_BYTES = 131072;
constexpr int LDSCTL_OFF = RING_BYTES;
constexpr int LC_MISC = 0;
constexpr int LC_MTPRE = 128;
constexpr int LC_CNT = 128 + 160;
constexpr int LC_HIST = LC_CNT + 128;
constexpr int LC_BASE = LC_HIST + 128;
constexpr int LDS_BYTES = 163840;

__device__ __forceinline__ unsigned cvtpk(float lo, float hi) { f32x2 v = {lo, hi}; bf16x2_t b = __builtin_convertvector(v, bf16x2_t); return __builtin_bit_cast(unsigned, b); }
__device__ __forceinline__ bf16_t f2bf(float f) { return (bf16_t)(cvtpk(f, 0.f) & 0xffffu); }
__device__ __forceinline__ float bf2f(unsigned h) { return __builtin_bit_cast(float, h << 16); }
__device__ __forceinline__ float bflo(unsigned w) { return __builtin_bit_cast(float, w << 16); }
__device__ __forceinline__ float bfhi(unsigned w) { return __builtin_bit_cast(float, w & 0xffff0000u); }
__device__ __forceinline__ float wave_sum(float v) {
#pragma unroll
    for (int o = 1; o < 64; o <<= 1) v += __shfl_xor(v, o);
    return v;
}
__device__ __forceinline__ float wave_max(float v) {
#pragma unroll
    for (int o = 1; o < 64; o <<= 1) v = fmaxf(v, __shfl_xor(v, o));
    return v;
}
__device__ __forceinline__ float sigmoidf_(float v) { return __builtin_amdgcn_rcpf(1.0f + __builtin_amdgcn_exp2f(-1.4426950408889634f * v)); }
__device__ __forceinline__ void unpack8(const u32x4 w, float (&v)[8]) { v[0] = bflo(w.x); v[1] = bfhi(w.x); v[2] = bflo(w.y); v[3] = bfhi(w.y); v[4] = bflo(w.z); v[5] = bfhi(w.z); v[6] = bflo(w.w); v[7] = bfhi(w.w); }
__device__ __forceinline__ u32x4 pack8(const float (&v)[8]) { u32x4 w; w.x = cvtpk(v[0], v[1]); w.y = cvtpk(v[2], v[3]); w.z = cvtpk(v[4], v[5]); w.w = cvtpk(v[6], v[7]); return w; }
#define LDS_WAIT() asm volatile("s_waitcnt lgkmcnt(0)" ::: "memory")
#define VM_WAIT() asm volatile("s_waitcnt vmcnt(0)" ::: "memory")

namespace pg8 {
constexpr int BM = 256, BK = 64, HALF = 128, HTB = HALF * BK * 2, STAGE_BYTES = 8 * HTB, NXCD = 8, WGM = 8;
__host__ __device__ __forceinline__ int lds_byte(int r, int c) { const int st = (r >> 4) * 2 + (c >> 5), rr = r & 15, cc = c & 31, ob = rr * 64 + cc * 2; return st * 1024 + (ob ^ (((ob >> 9) & 1) << 5)); }
__host__ __device__ __forceinline__ void stage_rc(int b, int& R, int& C) { const int st = b / 1024, sb = b % 1024, swz = sb ^ (((sb >> 9) & 1) << 5); R = (st >> 1) * 16 + swz / 64; C = (st & 1) * 32 + (swz % 64) / 2; }
__host__ __device__ __forceinline__ int perm32(int rho) { const int n = rho >> 4, i = rho & 15; return 8 * (i >> 2) + 4 * n + (i & 3); }

struct Unit { int pm, pn, z, valid; };

__device__ __forceinline__ void tile_of(int L, int nM, int nN, int& pm, int& pn) {
    const int nwg = nM * nN; int wgid = L;
    { const int q = nwg / NXCD, r = nwg % NXCD, xcd = wgid % NXCD, off = wgid / NXCD; wgid = (xcd < r ? xcd * (q + 1) : r * (q + 1) + (xcd - r) * q) + off; }
    const int nig = WGM * nN, gid = wgid / nig, fm = gid * WGM, gsz = (nM - fm) < WGM ? (nM - fm) : WGM;
    pm = fm + ((wgid % nig) % gsz); pn = (wgid % nig) / gsz;
}

struct PlainOrder {
    static constexpr bool GATHER = false;
    const bf16_t* A; const bf16_t* Bt; int lda, ldb, nM, nN, G, c;
    __device__ __forceinline__ bool next(int i, Unit& u) const { const int L = i * G + c; if (L >= nM * nN) return false; tile_of(L, nM, nN, u.pm, u.pn); u.z = 0; u.valid = 256; return true; }
    __device__ __forceinline__ void ptrs(const Unit& u, const char*& a, const char*& b) const { a = (const char*)(A + (size_t)u.pm * 256 * lda); b = (const char*)(Bt + (size_t)u.pn * 256 * ldb); }
    __device__ __forceinline__ void avoff(const Unit&, const int (&R)[2], const int (&C)[2], unsigned (&v)[2][2]) const {
#pragma unroll
        for (int h = 0; h < 2; ++h)
#pragma unroll
            for (int i = 0; i < 2; ++i) v[h][i] = (unsigned)(R[i] * lda + C[i]) * 2u;
    }
};
struct DualOrder {
    static constexpr bool GATHER = false;
    const bf16_t* AC; const bf16_t* Wa; const bf16_t* Wc; int G, c;
    __device__ __forceinline__ bool next(int i, Unit& u) const { const int L = (i >> 1) * G + c; if (L >= 128 * 4) return false; tile_of(L, 128, 4, u.pm, u.pn); u.z = i & 1; u.valid = 256; return true; }
    __device__ __forceinline__ void ptrs(const Unit& u, const char*& a, const char*& b) const { a = (const char*)(AC + (size_t)u.pm * 256 * 1024 + u.z * 512); b = (const char*)((u.z ? Wc : Wa) + (size_t)u.pn * 256 * 512); }
    __device__ __forceinline__ void avoff(const Unit&, const int (&R)[2], const int (&C)[2], unsigned (&v)[2][2]) const {
#pragma unroll
        for (int h = 0; h < 2; ++h)
#pragma unroll
            for (int i = 0; i < 2; ++i) v[h][i] = (unsigned)(R[i] * 1024 + C[i]) * 2u;
    }
};
struct MoeOrder {
    const LAS int* mtpre; const LAS int* cnt; int NT, G, c;
    __device__ __forceinline__ bool locate(int i, Unit& u) const {
        const int L = i * G + c; const int U = mtpre[32] * NT; if (L >= U) return false;
        const int tg = L / NT; u.pn = L - tg * NT; int e = 0;
#pragma unroll 1
        for (int j = 1; j < 32; ++j) e += (mtpre[j] <= tg) ? 1 : 0;
        u.z = e; u.pm = tg; const int mt = tg - mtpre[e]; const int left = cnt[e] - mt * 256; u.valid = left < 256 ? left : 256; return true;
    }
};
struct MoeGuOrder : MoeOrder {
    static constexpr bool GATHER = true;
    const bf16_t* H2; const bf16_t* Wgu; const int* asg;
    __device__ __forceinline__ bool next(int i, Unit& u) const { return locate(i, u); }
    __device__ __forceinline__ void ptrs(const Unit& u, const char*& a, const char*& b) const { a = (const char*)H2; b = (const char*)(Wgu + ((size_t)u.z * 512 + (size_t)u.pn * 256) * 1024); }
    __device__ __forceinline__ void avoff(const Unit& u, const int (&R)[2], const int (&C)[2], unsigned (&v)[2][2]) const {
        const int mt = u.pm - mtpre[u.z]; const int* ap = asg + ((size_t)u.z * CAP + mt * 256);
#pragma unroll
        for (int h = 0; h < 2; ++h)
#pragma unroll
            for (int i = 0; i < 2; ++i) { const unsigned r = (unsigned)(h * 128 + R[i]); int tok = 0; if ((int)r < u.valid) tok = ap[r] >> 1; v[h][i] = (unsigned)(tok * 1024 + C[i]) * 2u; }
    }
};
struct MoeDownOrder : MoeOrder {
    static constexpr bool GATHER = false;
    const bf16_t* HID; const bf16_t* Wd;
    __device__ __forceinline__ bool next(int i, Unit& u) const { return locate(i, u); }
    __device__ __forceinline__ void ptrs(const Unit& u, const char*& a, const char*& b) const { a = (const char*)(HID + (size_t)u.pm * 256 * 256); b = (const char*)(Wd + ((size_t)u.z * 1024 + (size_t)u.pn * 256) * 256); }
    __device__ __forceinline__ void avoff(const Unit&, const int (&R)[2], const int (&C)[2], unsigned (&v)[2][2]) const {
#pragma unroll
        for (int h = 0; h < 2; ++h)
#pragma unroll
            for (int i = 0; i < 2; ++i) v[h][i] = (unsigned)(R[i] * 256 + C[i]) * 2u;
    }
};

typedef f32x4 Acc[2][2][4][2];

struct EpiProj {
    static constexpr bool PERM = true, HAS_MID = false;
    bf16_t* O;
    __device__ __forceinline__ void operator()(const Acc& acc, const Unit& u, int wr, int wc, int fr, int fq) const {
        bf16_t* base = O + (size_t)u.pm * BM * PW + u.pn * BM;
        unsigned l0 = (unsigned)((wr * 64 + fr) * PW + wc * 32 + 8 * fq); asm volatile("" : "+v"(l0)); const bool sg = u.pn >= 9;
#pragma unroll
        for (int ai = 0; ai < 2; ++ai)
#pragma unroll
            for (int m = 0; m < 4; ++m)
#pragma unroll
                for (int bj = 0; bj < 2; ++bj) { f32x4 v0 = acc[ai][bj][m][0], v1 = acc[ai][bj][m][1];
                    if (sg) {
#pragma unroll
                        for (int k = 0; k < 4; ++k) { v0[k] = sigmoidf_(v0[k]); v1[k] = sigmoidf_(v1[k]); } }
                    u32x4 w; w.x = cvtpk(v0[0], v0[1]); w.y = cvtpk(v0[2], v0[3]); w.z = cvtpk(v1[0], v1[1]); w.w = cvtpk(v1[2], v1[3]);
                    *(u32x4*)(base + (l0 + (unsigned)((ai * HALF + m * 16) * PW + bj * HALF))) = w; }
    }
};
struct EpiGate2 {
    static constexpr bool PERM = true, HAS_MID = true;
    const bf16_t* PROJ; bf16_t* MG;
    __device__ __forceinline__ void mid(Acc& acc, const Unit& u, int wr, int wc, int fr, int fq) const {
        const bf16_t* gbase = PROJ + (size_t)u.pm * BM * PW + C_GA + u.pn * BM;
        unsigned lg = (unsigned)((wr * 64 + fr) * PW + wc * 32 + 8 * fq); asm volatile("" : "+v"(lg));
#pragma unroll
        for (int ai = 0; ai < 2; ++ai) { u32x4 ga[4][2], gc[4][2];
#pragma unroll
            for (int m = 0; m < 4; ++m)
#pragma unroll
                for (int bj = 0; bj < 2; ++bj) { const unsigned o = lg + (unsigned)((ai * HALF + m * 16) * PW + bj * HALF); ga[m][bj] = *(const u32x4*)(gbase + o); gc[m][bj] = *(const u32x4*)(gbase + 1024 + o); }
#pragma unroll
            for (int m = 0; m < 4; ++m)
#pragma unroll
                for (int bj = 0; bj < 2; ++bj) { float a8[8], c8[8]; unpack8(ga[m][bj], a8); unpack8(gc[m][bj], c8);
#pragma unroll
                    for (int k = 0; k < 8; ++k) { const float r = a8[k] * __builtin_amdgcn_rcpf(fmaxf(c8[k], 9.5367431640625e-07f)); if (k < 4) acc[ai][bj][m][0][k] *= r; else acc[ai][bj][m][1][k - 4] *= r; } }
            asm volatile("" ::: "memory"); }
    }
    __device__ __forceinline__ void operator()(const Acc& acc, const Unit& u, int wr, int wc, int fr, int fq) const {
        const bf16_t* gbase = PROJ + (size_t)u.pm * BM * PW + C_GA + 1024 + u.pn * BM;
        bf16_t* ob = MG + (size_t)u.pm * BM * 1024 + u.pn * BM;
        unsigned lg = (unsigned)((wr * 64 + fr) * PW + wc * 32 + 8 * fq), lt = (unsigned)((wr * 64 + fr) * 1024 + wc * 32 + 8 * fq); asm volatile("" : "+v"(lg), "+v"(lt));
        u32x4 gc[2][4][2];
#pragma unroll
        for (int ai = 0; ai < 2; ++ai)
#pragma unroll
            for (int m = 0; m < 4; ++m)
#pragma unroll
                for (int bj = 0; bj < 2; ++bj) gc[ai][m][bj] = *(const u32x4*)(gbase + (lg + (unsigned)((ai * HALF + m * 16) * PW + bj * HALF)));
#pragma unroll
        for (int ai = 0; ai < 2; ++ai)
#pragma unroll
            for (int m = 0; m < 4; ++m)
#pragma unroll
                for (int bj = 0; bj < 2; ++bj) { float c8[8]; unpack8(gc[ai][m][bj], c8); float v[8];
#pragma unroll
                    for (int k = 0; k < 8; ++k) v[k] = (k < 4 ? acc[ai][bj][m][0][k] : acc[ai][bj][m][1][k - 4]) * fmaxf(c8[k], 9.5367431640625e-07f);
                    *(u32x4*)(ob + (lt + (unsigned)((ai * HALF + m * 16) * 1024 + bj * HALF))) = pack8(v); }
    }
};
struct EpiRes {
    static constexpr bool PERM = false, HAS_MID = false;
    const float* X; float* O;
    __device__ __forceinline__ void operator()(const Acc& acc, const Unit& u, int wr, int wc, int fr, int fq) const {
        const size_t tb = (size_t)u.pm * BM * D + u.pn * BM; const float* xb = X + tb; float* ob = O + tb;
        unsigned l0 = (unsigned)((wr * 64 + fr) * D + wc * 32 + 4 * fq); asm volatile("" : "+v"(l0));
#pragma unroll
        for (int ai = 0; ai < 2; ++ai) { f32x4 xv[4][2][2];
#pragma unroll
            for (int m = 0; m < 4; ++m)
#pragma unroll
                for (int bj = 0; bj < 2; ++bj)
#pragma unroll
                    for (int n = 0; n < 2; ++n) xv[m][bj][n] = *(const f32x4*)(xb + (l0 + (unsigned)((ai * HALF + m * 16) * D + bj * HALF + n * 16)));
#pragma unroll
            for (int m = 0; m < 4; ++m)
#pragma unroll
                for (int bj = 0; bj < 2; ++bj)
#pragma unroll
                    for (int n = 0; n < 2; ++n) *(f32x4*)(ob + (l0 + (unsigned)((ai * HALF + m * 16) * D + bj * HALF + n * 16))) = xv[m][bj][n] + acc[ai][bj][m][n];
            asm volatile("" ::: "memory"); }
    }
};
struct EpiGU {
    static constexpr bool PERM = true, HAS_MID = false;
    bf16_t* HID; const f32x2* rsg; const LAS int* mtpre;
    __device__ __forceinline__ void operator()(const Acc& acc, const Unit& u, int wr, int wc, int fr, int fq) const {
        const int mt = u.pm - mtpre[u.z]; const f32x2* rp = rsg + ((size_t)u.z * CAP + mt * 256);
        bf16_t* hb = HID + (size_t)u.pm * 256 * 256 + u.pn * 128;
        int r0 = wr * 64 + fr; asm volatile("" : "+v"(r0)); const unsigned l0 = (unsigned)(r0 * 256 + wc * 32 + 8 * fq);
        float rsv[2][4];
#pragma unroll
        for (int ai = 0; ai < 2; ++ai)
#pragma unroll
            for (int m = 0; m < 4; ++m) { const int r = r0 + ai * HALF + m * 16; const float t = rp[(unsigned)(r < u.valid ? r : 0)].y; rsv[ai][m] = r < u.valid ? t : 0.f; }
#pragma unroll
        for (int ai = 0; ai < 2; ++ai)
#pragma unroll
            for (int m = 0; m < 4; ++m) { const int r = r0 + ai * HALF + m * 16;
                const float rs = rsv[ai][m];
                const f32x4 g0 = acc[ai][0][m][0] * rs, g1 = acc[ai][0][m][1] * rs, u0 = acc[ai][1][m][0] * rs, u1 = acc[ai][1][m][1] * rs;
                float h[8];
#pragma unroll
                for (int k = 0; k < 4; ++k) { h[k] = g0[k] * sigmoidf_(g0[k]) * u0[k]; h[4 + k] = g1[k] * sigmoidf_(g1[k]) * u1[k]; }
                u32x4 w; w.x = cvtpk(h[0], h[1]); w.y = cvtpk(h[2], h[3]); w.z = cvtpk(h[4], h[5]); w.w = cvtpk(h[6], h[7]);
                *(u32x4*)(hb + (l0 + (unsigned)((ai * HALF + m * 16) * 256))) = w; }
    }
};
struct EpiDown {
    static constexpr bool PERM = true, HAS_MID = false;
    bf16_t* Y; const int* asg; const f32x2* rsg; const LAS int* mtpre;
    __device__ __forceinline__ void operator()(const Acc& acc, const Unit& u, int wr, int wc, int fr, int fq) const {
        const int mt = u.pm - mtpre[u.z]; const size_t pb = (size_t)u.z * CAP + mt * 256; const int* ap = asg + pb; const f32x2* rp = rsg + pb;
        bf16_t* yb = Y + u.pn * BM;
        int r0 = wr * 64 + fr; unsigned c0 = (unsigned)(wc * 32 + 8 * fq); asm volatile("" : "+v"(r0), "+v"(c0));
#pragma unroll
        for (int ai = 0; ai < 2; ++ai) { int av[4]; float gv[4];
#pragma unroll
            for (int m = 0; m < 4; ++m) { const int r = r0 + ai * HALF + m * 16; const unsigned rr = (unsigned)(r < u.valid ? r : 0); av[m] = ap[rr]; gv[m] = rp[rr].x; }
#pragma unroll
            for (int m = 0; m < 4; ++m) { const int r = r0 + ai * HALF + m * 16;
                if (r < u.valid) { const float gt = gv[m];
#pragma unroll
                    for (int bj = 0; bj < 2; ++bj) { const f32x4 v0 = acc[ai][bj][m][0] * gt, v1 = acc[ai][bj][m][1] * gt;
                        u32x4 w; w.x = cvtpk(v0[0], v0[1]); w.y = cvtpk(v0[2], v0[3]); w.z = cvtpk(v1[0], v1[1]); w.w = cvtpk(v1[2], v1[3]);
                        *(u32x4*)(yb + ((unsigned)av[m] * 1024u + c0 + (unsigned)(bj * HALF))) = w; } } }
            asm volatile("" ::: "memory"); }
    }
};

template <class Epi, class Sched, bool ALIGN_EPI, bool NOUNROLL = false>
__device__ __forceinline__ void gemm_phase(LAS unsigned char* lds, const int K, const int lda, const int ldb, const Sched& S, const Epi& E) {
    int tid = threadIdx.x; asm volatile("" : "+v"(tid));
    const int wid = __builtin_amdgcn_readfirstlane(tid >> 6), lane = tid & 63, wr = wid >> 2, wc = wid & 3, fr = lane & 15, fq = lane >> 4;
    const int nt = K / BK;
    int sR[2], sC[2]; unsigned voffB[2];
#pragma unroll
    for (int i = 0; i < 2; ++i) { int R, C; stage_rc(tid * 16 + i * 8192, R, C); sR[i] = R; sC[i] = C; const int Rb = Epi::PERM ? ((R & ~31) + perm32(R & 31)) : R;
        voffB[i] = (unsigned)(Rb * ldb + C) * 2u; }
    const size_t kstep = (size_t)(BK * 2);
    const size_t hB = (size_t)HALF * ldb * 2, hA = Sched::GATHER ? (size_t)0 : (size_t)HALF * lda * 2;
    const unsigned ldsw = (unsigned)wid * 1024u;
    const int aoff = lds_byte(wr * 64 + fr, fq * 8), boff = lds_byte(wc * 32 + fr, fq * 8);
#define PG8_SA(b, h) (((b) * 2 + (h)) * HTB)
#define PG8_SB(b, h) ((4 + (b) * 2 + (h)) * HTB)
#define PG8_STAGE(bufoff, gbase, v0, v1) do { \
        __builtin_amdgcn_global_load_lds((const unsigned*)((const char*)(gbase) + (v0)), (LAS unsigned*)(lds + (bufoff) + ldsw), 16, 0, 0); \
        __builtin_amdgcn_global_load_lds((const unsigned*)((const char*)(gbase) + (v1)), (LAS unsigned*)(lds + (bufoff) + ldsw + 8192), 16, 0, 0); } while (0)
#define PG8_STB(bufoff, gbase) PG8_STAGE(bufoff, gbase, voffB[0], voffB[1])
#define PG8_STA(bufoff, gbase, h) PG8_STAGE(bufoff, (gbase) + (h) * hA, cv[Sched::GATHER ? (h) : 0][0], cv[Sched::GATHER ? (h) : 0][1])
#define PG8_LDA(dst, b, h) do { _Pragma("unroll") for (int m = 0; m < 4; ++m) _Pragma("unroll") for (int k = 0; k < 2; ++k) dst[m][k] = *(const LAS bf16x8*)(lds + PG8_SA(b, h) + aoff + m * 2048 + k * 1024); } while (0)
#define PG8_LDB(dst, b, h) do { _Pragma("unroll") for (int n = 0; n < 2; ++n) _Pragma("unroll") for (int k = 0; k < 2; ++k) dst[n][k] = *(const LAS bf16x8*)(lds + PG8_SB(b, h) + boff + n * 2048 + k * 1024); } while (0)
#define PG8_MMA(ai, bj, At, Bt) do { __builtin_amdgcn_s_setprio(1); _Pragma("unroll") for (int m = 0; m < 4; ++m) _Pragma("unroll") for (int n = 0; n < 2; ++n) _Pragma("unroll") for (int k = 0; k < 2; ++k) \
        acc[ai][bj][m][n] = __builtin_amdgcn_mfma_f32_16x16x32_bf16(Bt[n][k], At[m][k], acc[ai][bj][m][n], 0, 0, 0); __builtin_amdgcn_s_setprio(0); } while (0)
#define PG8_WAIT_V(n) asm volatile("s_waitcnt vmcnt(" #n ")" ::: "memory")
#define PG8_WAIT_L(n) asm volatile("s_waitcnt lgkmcnt(" #n ")" ::: "memory")
#define PG8_BAR __builtin_amdgcn_s_barrier()
#define PG8_SCHED __builtin_amdgcn_sched_barrier(0)
    Unit cur, nxt; int ui = 0;
    if (!S.next(0, cur)) return;
    Acc acc;
#pragma unroll
    for (int a = 0; a < 2; ++a)
#pragma unroll
        for (int b = 0; b < 2; ++b)
#pragma unroll
            for (int m = 0; m < 4; ++m)
#pragma unroll
                for (int n = 0; n < 2; ++n) acc[a][b][m][n] = (f32x4){0.f, 0.f, 0.f, 0.f};
    bf16x8 At[4][2], B0[2][2], B1[2][2];
    const char* cA; const char* cB; S.ptrs(cur, cA, cB);
    unsigned cv[2][2]; S.avoff(cur, sR, sC, cv);
    PG8_STB(PG8_SB(0, 0), cB); PG8_STB(PG8_SB(0, 1), cB + hB); PG8_STA(PG8_SA(0, 0), cA, 0); PG8_STA(PG8_SA(0, 1), cA, 1);
    if (wr == 1) PG8_BAR;
    PG8_WAIT_V(2); PG8_BAR;
    PG8_STB(PG8_SB(1, 0), cB + kstep); PG8_STA(PG8_SA(1, 0), cA + kstep, 0); PG8_STB(PG8_SB(1, 1), cB + hB + kstep);
    PG8_WAIT_V(6); PG8_BAR;
    for (;;) {
        const bool has_next = S.next(ui + 1, nxt);
        const char* nA = cA; const char* nB = cB;
        if (has_next) S.ptrs(nxt, nA, nB);
        for (int t = 0; t < nt; t += 2) {
            if constexpr (NOUNROLL) asm volatile("" : "+s"(t));
            const bool last = (t == nt - 2);
            if constexpr (Epi::HAS_MID) { if (t == (nt >> 1)) E.mid(acc, cur, wr, wc, fr, fq); }
            unsigned nv[2][2];
            if (Sched::GATHER) { if (last && has_next) { S.avoff(nxt, sR, sC, nv); cv[0][0] = nv[0][0]; cv[0][1] = nv[0][1]; } }
            const char* a1 = cA + (size_t)(t + 1) * kstep;
            const char* a2 = last ? nA : cA + (size_t)(t + 2) * kstep; const char* b2 = last ? nB : cB + (size_t)(t + 2) * kstep;
            const char* a3 = a2 + kstep; const char* b3 = b2 + kstep;
            PG8_LDB(B0, 0, 0); PG8_LDB(B1, 0, 1); PG8_SCHED; PG8_LDA(At, 0, 0); PG8_STA(PG8_SA(1, 1), a1, 1);
            if (Sched::GATHER) { if (last && has_next) { cv[1][0] = nv[1][0]; cv[1][1] = nv[1][1]; } }
            PG8_WAIT_V(8); PG8_WAIT_L(0); PG8_BAR; PG8_MMA(0, 0, At, B0); PG8_MMA(0, 1, At, B1); PG8_BAR; PG8_SCHED;
            PG8_LDA(At, 0, 1); PG8_STB(PG8_SB(0, 0), b2); PG8_STB(PG8_SB(0, 1), b2 + hB); PG8_STA(PG8_SA(0, 0), a2, 0);
            PG8_WAIT_V(8); PG8_WAIT_L(0); PG8_BAR; PG8_MMA(1, 0, At, B0); PG8_MMA(1, 1, At, B1); PG8_BAR; PG8_SCHED;
            PG8_LDB(B0, 1, 0); PG8_LDB(B1, 1, 1); PG8_SCHED; PG8_LDA(At, 1, 0); PG8_STA(PG8_SA(0, 1), a2, 1);
            PG8_WAIT_V(8); PG8_WAIT_L(0); PG8_BAR; PG8_MMA(0, 0, At, B0); PG8_MMA(0, 1, At, B1); PG8_BAR; PG8_SCHED;
            PG8_LDA(At, 1, 1); PG8_STB(PG8_SB(1, 0), b3); PG8_STB(PG8_SB(1, 1), b3 + hB); PG8_STA(PG8_SA(1, 0), a3, 0);
            PG8_WAIT_V(8); PG8_WAIT_L(0); PG8_BAR; PG8_MMA(1, 0, At, B0); PG8_MMA(1, 1, At, B1); PG8_BAR; PG8_SCHED;
        }
        if constexpr (ALIGN_EPI) { if (wr == 0) PG8_BAR; }
        E(acc, cur, wr, wc, fr, fq);
        if (!has_next) break;
#pragma unroll
        for (int a = 0; a < 2; ++a)
#pragma unroll
            for (int b = 0; b < 2; ++b)
#pragma unroll
                for (int m = 0; m < 4; ++m)
#pragma unroll
                    for (int n = 0; n < 2; ++n) acc[a][b][m][n] = (f32x4){0.f, 0.f, 0.f, 0.f};
        cur = nxt; cA = nA; cB = nB; ++ui;
        if constexpr (ALIGN_EPI) { if (wr == 1) PG8_BAR; }
    }
    PG8_WAIT_V(0);
    if constexpr (!ALIGN_EPI) { if (wr == 0) PG8_BAR; }
    PG8_BAR;
#undef PG8_SA
#undef PG8_SB
#undef PG8_STAGE
#undef PG8_STA
#undef PG8_STB
#undef PG8_LDA
#undef PG8_LDB
#undef PG8_MMA
#undef PG8_WAIT_V
#undef PG8_WAIT_L
#undef PG8_BAR
#undef PG8_SCHED
}
}

#ifndef MK_USE_CG
#define MK_USE_CG 0
#endif
#define XB_TMO      128
#define XB_XCNT(j)  (256  + 64 * (j))
#define XB_XSUB(j)  (1280 + 64 * (j))
#define XB_XGEN(j)  (2304 + 64 * (j))
#define XB_TOP      3328
#define XB_TOPGEN   3392
#define XCD_BAR_WORDS 3456
#define XB_SPIN_CAP (1u << 18)
__device__ __forceinline__ unsigned xb_ld(unsigned* p)              { return __hip_atomic_load(p, __ATOMIC_RELAXED, __HIP_MEMORY_SCOPE_AGENT); }
__device__ __forceinline__ unsigned xb_add(unsigned* p, unsigned v) { return __hip_atomic_fetch_add(p, v, __ATOMIC_RELAXED, __HIP_MEMORY_SCOPE_AGENT); }
__device__ __forceinline__ unsigned xb_xcc_id() { return (unsigned)__builtin_amdgcn_s_getreg((3 << 11) | 20) & 0xFu; }
#define XB_SPIN(cond, bar) do { unsigned _sp = 0; while (cond) { __builtin_amdgcn_s_sleep(1); \
    if ((++_sp & 255u) == 0u) { if (xb_ld(&(bar)[XB_TMO])) break; if (_sp > XB_SPIN_CAP) { atomicAdd(&(bar)[XB_TMO], 1u); break; } } } } while (0)
struct XcdBarrier { unsigned* bar; unsigned x; volatile LAS unsigned* st; };
__device__ __forceinline__ XcdBarrier xcd_barrier_post(unsigned* bar, volatile LAS unsigned* st) {
    XcdBarrier b; b.bar = bar; b.x = xb_xcc_id(); b.st = st;
    if (threadIdx.x == 0) (void)xb_add(&bar[XB_XCNT(b.x)], 1u);
    return b;
}
__device__ __forceinline__ void xcd_barrier_complete(unsigned* bar, unsigned x, unsigned& nloc, unsigned& nx) {
    const unsigned G = gridDim.x * gridDim.y * gridDim.z;
    unsigned sum, cnt, mine, sp = 0u;
    for (;;) {
        sum = 0u; cnt = 0u; mine = 0u;
#pragma unroll
        for (unsigned j = 0; j < 16; ++j) { const unsigned c = xb_ld(&bar[XB_XCNT(j)]); sum += c; cnt += (c > 0u) ? 1u : 0u; mine = (j == x) ? c : mine; }
        if (sum == G) break;
        __builtin_amdgcn_s_sleep(1);
        if ((++sp & 255u) == 0u) { if (xb_ld(&bar[XB_TMO])) break; if (sp > XB_SPIN_CAP) { atomicAdd(&bar[XB_TMO], 1u); break; } }
    }
    nloc = mine > 0u ? mine : 1u; nx = cnt > 0u ? cnt : 1u;
}
__device__ __forceinline__ void xcd_barrier(const XcdBarrier& b) {
    asm volatile("s_waitcnt vmcnt(0)" ::: "memory");
    __syncthreads();
    if (threadIdx.x == 0) {
        unsigned* bar = b.bar;
        __builtin_amdgcn_s_waitcnt(0);
        unsigned nloc = b.st[0], nx = b.st[1];
        if (nloc == 0u) { xcd_barrier_complete(bar, b.x, nloc, nx); b.st[0] = nloc; b.st[1] = nx; }
        const unsigned old = xb_add(&bar[XB_XSUB(b.x)], 1u);
        const unsigned gen = old / nloc;
        if (old + 1u == (gen + 1u) * nloc) {
            __builtin_amdgcn_fence(__ATOMIC_RELEASE, "agent");
            asm volatile("s_waitcnt vmcnt(0)" ::: "memory");
            const unsigned og = xb_add(&bar[XB_TOP], 1u);
            const unsigned tg = og / nx;
            if (og + 1u == (tg + 1u) * nx) xb_add(&bar[XB_TOPGEN], 1u);
            else XB_SPIN(xb_ld(&bar[XB_TOPGEN]) == tg, bar);
            __builtin_amdgcn_fence(__ATOMIC_ACQUIRE, "agent");
            xb_add(&bar[XB_XGEN(b.x)], 1u);
            asm volatile("s_waitcnt vmcnt(0)" ::: "memory");
        } else {
            XB_SPIN(xb_ld(&bar[XB_XGEN(b.x)]) == gen, bar);
            __builtin_amdgcn_fence(__ATOMIC_ACQUIRE, "agent");
            asm volatile("s_waitcnt vmcnt(0)" ::: "memory");
        }
    }
    __syncthreads();
}

struct Args {
    const float* in[19]; float* out; unsigned char* ws; int ph_lo, ph_hi; int rep[10];
};
struct Frame {
    LAS unsigned char* lds; int tid, lane, wave, G, vcu;
};

__device__ __forceinline__ void tr_item(const float* W, int ldw, int k0, int n0, bf16_t* WT, int ldt, int drow0, LAS float* scr, int lane) {
    float tv[32];
#pragma unroll
    for (int i = 0; i < 32; ++i) { const int kk = 2 * i + (lane >> 5); tv[i] = W[(size_t)(k0 + kk) * ldw + n0 + (lane & 31)]; }
#pragma unroll
    for (int i = 0; i < 32; ++i) { const int kk = 2 * i + (lane >> 5); scr[kk * 33 + (lane & 31)] = tv[i]; }
    LDS_WAIT(); asm volatile("" ::: "memory");
    const int c = lane & 7;
#pragma unroll
    for (int j = 0; j < 4; ++j) { const int n = (lane >> 3) + 8 * j; const LAS float* s = scr + (8 * c) * 33 + n;
        u32x4 o; o.x = cvtpk(s[0 * 33], s[1 * 33]); o.y = cvtpk(s[2 * 33], s[3 * 33]); o.z = cvtpk(s[4 * 33], s[5 * 33]); o.w = cvtpk(s[6 * 33], s[7 * 33]);
        *(u32x4*)(WT + (size_t)(drow0 + n) * ldt + k0 + 8 * c) = o; }
    LDS_WAIT(); asm volatile("" ::: "memory");
}
constexpr int I_IN = 16 * 136, I_A = 8 * 32, I_OUT = 16 * 32, I_G = 32 * 128, I_D = 32 * 128;
constexpr int I_SMALL = I_IN + 2 * I_A + I_OUT, NITEMS = I_SMALL + 2 * I_G + I_D;
__device__ __forceinline__ void convert_items(const Frame& F, const Args& a, int first, int last, int worker, int nworkers) {
    unsigned char* ws = a.ws;
    LAS float* scr = (LAS float*)(F.lds + F.wave * 16384);
    const float* w_in = a.in[2]; const float* w_a = a.in[8]; const float* w_c = a.in[9]; const float* w_out = a.in[10];
    const float* w_gate = a.in[16]; const float* w_up = a.in[17]; const float* w_down = a.in[18];
    bf16_t* WinT = (bf16_t*)(ws + WS_WIN); bf16_t* WaT = (bf16_t*)(ws + WS_WA); bf16_t* WoutT = (bf16_t*)(ws + WS_WOUT);
    bf16_t* WguT = (bf16_t*)(ws + WS_WGU); bf16_t* WdT = (bf16_t*)(ws + WS_WD);
    for (int it = first + worker * NWAVES + F.wave; it < last; it += nworkers * NWAVES) {
        int r = it;
        if (r < I_IN) { const int kb = r / 136, nb = r % 136; tr_item(w_in, PW, 64 * kb, 32 * nb, WinT, 1024, 32 * nb, scr, F.lane); continue; } r -= I_IN;
        if (r < I_A) { const int kb = r / 32, nb = r % 32; tr_item(w_a, 1024, 64 * kb, 32 * nb, WaT, 1024, 32 * nb, scr, F.lane); continue; } r -= I_A;
        if (r < I_A) { const int kb = r / 32, nb = r % 32; tr_item(w_c, 1024, 64 * kb, 32 * nb, WaT + 512, 1024, 32 * nb, scr, F.lane); continue; } r -= I_A;
        if (r < I_OUT) { const int kb = r / 32, nb = r % 32; tr_item(w_out, 1024, 64 * kb, 32 * nb, WoutT, 1024, 32 * nb, scr, F.lane); continue; } r -= I_OUT;
        if (r < 2 * I_G) { const int up = r >= I_G; if (up) r -= I_G; const int e = r / 128, q = r % 128, kb = q / 8, nb = q % 8, n0 = 32 * nb;
            tr_item((up ? w_up : w_gate) + (size_t)e * 1024 * 256, 256, 64 * kb, n0, WguT + (size_t)e * 512 * 1024, 1024, (n0 >> 7) * 256 + up * 128 + (n0 & 127), scr, F.lane); continue; } r -= 2 * I_G;
        { const int e = r / 128, q = r % 128, kb = q / 32, nb = q % 32; tr_item(w_down + (size_t)e * 256 * 1024, 1024, 64 * kb, 32 * nb, WdT + (size_t)e * 1024 * 256, 256, 32 * nb, scr, F.lane); }
    }
}
__device__ __forceinline__ void p0_prologue(const Frame& F, const Args& a) {
    unsigned char* ws = a.ws;
    const int gw = F.vcu * NWAVES + F.wave, NGW = F.G * NWAVES;
    convert_items(F, a, 0, I_SMALL, F.vcu, F.G);
    const int gt = F.vcu * NTHREADS + F.tid, NGT = F.G * NTHREADS;
    { const float* w_rg = a.in[12]; const float* w_re = a.in[14]; bf16_t* WrT = (bf16_t*)(ws + WS_WR);
      for (int i = gt; i < 48 * 1024; i += NGT) { const int j = i >> 10, k = i & 1023; float v = 0.f; if (j < 4) v = w_rg[k * 4 + j]; else if (j < 36) v = w_re[k * 32 + (j - 4)]; WrT[i] = f2bf(v); } }
    { float* cosT = (float*)(ws + WS_ROPE); float* sinT = cosT + SEQ * 8;
      for (int i = gt; i < SEQ * 8; i += NGT) { const int pos = i >> 3, j = i & 7; const float inv = (float)pow(500000.0, -(double)j / 8.0); const float ang = (float)pos * inv;
          cosT[i] = (float)cos((double)ang); sinT[i] = (float)sin((double)ang); } }
    { const float* x = a.in[0]; const float* g1 = a.in[1]; bf16_t* XN = (bf16_t*)(ws + WS_XN);
      f32x4 gv[4];
#pragma unroll
      for (int j = 0; j < 4; ++j) gv[j] = ((const f32x4*)g1)[F.lane + 64 * j];
      for (int m0 = gw; m0 < M; m0 += 4 * NGW) { f32x4 v[4][4];
#pragma unroll
          for (int q = 0; q < 4; ++q) { const int m = m0 + q * NGW; const f32x4* xr = (const f32x4*)(x + (size_t)(m < M ? m : 0) * D) + F.lane;
#pragma unroll
              for (int j = 0; j < 4; ++j) v[q][j] = xr[64 * j]; }
#pragma unroll
          for (int q = 0; q < 4; ++q) { const int m = m0 + q * NGW; float s = 0.f;
#pragma unroll
              for (int j = 0; j < 4; ++j) s += (v[q][j].x * v[q][j].x + v[q][j].y * v[q][j].y) + (v[q][j].z * v[q][j].z + v[q][j].w * v[q][j].w);
              const float rstd = rsqrtf(wave_sum(s) * (1.f / D) + EPS);
              if (m < M) { u32x2* o8 = (u32x2*)(XN + (size_t)m * D) + F.lane;
#pragma unroll
                  for (int j = 0; j < 4; ++j) { u32x2 w; w.x = cvtpk(v[q][j].x * rstd * gv[j].x, v[q][j].y * rstd * gv[j].y); w.y = cvtpk(v[q][j].z * rstd * gv[j].z, v[q][j].w * rstd * gv[j].w); o8[64 * j] = w; } } } } }
}

__device__ __forceinline__ u32x4 qk_norm_rope(const u32x4 raw, const float (&g)[8], const f32x4 c0, const f32x4 c1, const f32x4 s0, const f32x4 s1, int l7, float scale) {
    float v[8]; unpack8(raw, v); float ss = 0.f;
#pragma unroll
    for (int i = 0; i < 8; ++i) ss += v[i] * v[i];
    ss += __shfl_xor(ss, 1); ss += __shfl_xor(ss, 2); ss += __shfl_xor(ss, 4);
    const float rstd = rsqrtf(ss * (1.f / 64.f) + EPS);
    const float cc[8] = {c0.x, c0.y, c0.z, c0.w, c1.x, c1.y, c1.z, c1.w}, sn[8] = {s0.x, s0.y, s0.z, s0.w, s1.x, s1.y, s1.z, s1.w};
#pragma unroll
    for (int i = 0; i < 8; ++i) { float y = v[i] * rstd * g[i]; const float p = __shfl_xor(y, 1);
        if (l7 == 0) y = y * cc[i] - p * sn[i]; else if (l7 == 1) y = y * cc[i] + p * sn[i];
        v[i] = y * scale; }
    return pack8(v);
}
__device__ __forceinline__ void p2_prep_conv(const Frame& F, const Args& a) {
    unsigned char* ws = a.ws;
    const bf16_t* PROJ = (const bf16_t*)(ws + WS_PROJ); bf16_t* QN = (bf16_t*)(ws + WS_QN); bf16_t* KN = (bf16_t*)(ws + WS_KN); bf16_t* AC = (bf16_t*)(ws + WS_AC);
    const float* cosT = (const float*)(ws + WS_ROPE); const float* sinT = cosT + SEQ * 8;
    const float* qg = a.in[3]; const float* kg = a.in[4]; const float* conv_w = a.in[6]; const float* conv_b = a.in[7];
    const int gw = F.vcu * NWAVES + F.wave, NGW = F.G * NWAVES, lane = F.lane, l7 = lane & 7;
    float gq[8], gk[8];
#pragma unroll
    for (int k = 0; k < 8; ++k) { gq[k] = qg[8 * l7 + k]; gk[k] = kg[8 * l7 + k]; }
    float w0[8], w1[8], w2[8], bb[8];
#pragma unroll
    for (int k = 0; k < 8; ++k) { w0[k] = conv_w[8 * lane + k]; w1[k] = conv_w[CD + 8 * lane + k]; w2[k] = conv_w[2 * CD + 8 * lane + k]; bb[k] = conv_b[8 * lane + k]; }
    for (int ch = gw; ch < M / 16; ch += NGW) {
        const int t0 = ch * 16;
#pragma unroll 1
        for (int grp = 0; grp < 4; ++grp) { const int tb = t0 + 4 * grp;
            u32x4 qraw[4]; f32x4 qc[4][4];
#pragma unroll
            for (int tk = 0; tk < 4; ++tk) { const int t = tb + tk, pos = t & (SEQ - 1); qraw[tk] = *(const u32x4*)(PROJ + (size_t)t * PW + 8 * lane);
                qc[tk][0] = *(const f32x4*)(cosT + pos * 8); qc[tk][1] = *(const f32x4*)(cosT + pos * 8 + 4); qc[tk][2] = *(const f32x4*)(sinT + pos * 8); qc[tk][3] = *(const f32x4*)(sinT + pos * 8 + 4); }
            const int tkk = tb + (lane >> 4), kpos = tkk & (SEQ - 1);
            const u32x4 kraw = *(const u32x4*)(PROJ + (size_t)tkk * PW + C_K + 8 * (lane & 15));
            const f32x4 kc0 = *(const f32x4*)(cosT + kpos * 8), kc1 = *(const f32x4*)(cosT + kpos * 8 + 4), ks0 = *(const f32x4*)(sinT + kpos * 8), ks1 = *(const f32x4*)(sinT + kpos * 8 + 4);
#pragma unroll
            for (int tk = 0; tk < 4; ++tk) { const u32x4 o = qk_norm_rope(qraw[tk], gq, qc[tk][0], qc[tk][1], qc[tk][2], qc[tk][3], l7, QSCALE); *(u32x4*)(QN + (size_t)(tb + tk) * AD + 8 * lane) = o; }
            { const u32x4 o = qk_norm_rope(kraw, gk, kc0, kc1, ks0, ks1, l7, 1.0f); *(u32x4*)(KN + (size_t)tkk * 128 + 8 * (lane & 15)) = o; } }
        float up[8], uc[8];
        { float a8[8], b8[8];
          if ((t0 & (SEQ - 1)) > 0) { unpack8(*(const u32x4*)(PROJ + (size_t)(t0 - 1) * PW + C_CC + 8 * lane), a8); unpack8(*(const u32x4*)(PROJ + (size_t)(t0 - 1) * PW + C_CX + 8 * lane), b8);
#pragma unroll
              for (int k = 0; k < 8; ++k) up[k] = a8[k] * b8[k]; } else {
#pragma unroll
              for (int k = 0; k < 8; ++k) up[k] = 0.f; }
          unpack8(*(const u32x4*)(PROJ + (size_t)t0 * PW + C_CC + 8 * lane), a8); unpack8(*(const u32x4*)(PROJ + (size_t)t0 * PW + C_CX + 8 * lane), b8);
#pragma unroll
          for (int k = 0; k < 8; ++k) uc[k] = a8[k] * b8[k]; }
#pragma unroll 1
        for (int grp = 0; grp < 4; ++grp) { const int tb = t0 + 4 * grp;
            u32x4 rcc[4], rcx[4], rcb[4];
#pragma unroll
            for (int tk = 0; tk < 4; ++tk) { const int t = tb + tk; const bool hn = ((t & (SEQ - 1)) < SEQ - 1); const size_t tn = (size_t)(hn ? t + 1 : t);
                rcc[tk] = *(const u32x4*)(PROJ + tn * PW + C_CC + 8 * lane); rcx[tk] = *(const u32x4*)(PROJ + tn * PW + C_CX + 8 * lane); rcb[tk] = *(const u32x4*)(PROJ + (size_t)t * PW + C_CB + 8 * lane); }
#pragma unroll
            for (int tk = 0; tk < 4; ++tk) { const int t = tb + tk; const bool hn = ((t & (SEQ - 1)) < SEQ - 1);
                float a8[8], b8[8], cbv[8], un[8], o[8]; unpack8(rcc[tk], a8); unpack8(rcx[tk], b8); unpack8(rcb[tk], cbv);
#pragma unroll
                for (int k = 0; k < 8; ++k) { un[k] = hn ? a8[k] * b8[k] : 0.f; o[k] = cbv[k] * (up[k] * w0[k] + uc[k] * w1[k] + un[k] * w2[k] + bb[k]); up[k] = uc[k]; uc[k] = un[k]; }
                *(u32x4*)(AC + (size_t)t * 1024 + 512 + 8 * lane) = pack8(o); } }
    }
}

namespace att {
constexpr int NSLOT = 8, WSOFF = RING_BYTES + 1024, OSTOFF = WSOFF + 2048;
static_assert(OSTOFF + 8 * 2048 <= LDS_BYTES, "attention LDS map");
__device__ __forceinline__ int crow(int r, int hi) { return (r & 3) + 8 * (r >> 2) + 4 * hi; }
__device__ __forceinline__ s16x4 vtr(const LAS char* p) { return __builtin_bit_cast(s16x4, __builtin_amdgcn_ds_read_tr16_b64_v4i16((LAS s16x4*)p)); }
}
__device__ __forceinline__ u32x4 k_norm_rope(const u32x4 raw, const float (&g)[8], float cl, float sl, int l7, int lane) {
    float v[8]; unpack8(raw, v); float ss = 0.f;
#pragma unroll
    for (int i = 0; i < 8; ++i) ss += v[i] * v[i];
    ss += __shfl_xor(ss, 1); ss += __shfl_xor(ss, 2); ss += __shfl_xor(ss, 4);
    const float rstd = rsqrtf(ss * (1.f / 64.f) + EPS);
#pragma unroll
    for (int i = 0; i < 8; ++i) { float y = v[i] * rstd * g[i]; const float p = __shfl_xor(y, 1); const float c = __shfl(cl, (lane & ~7) + i), sn = __shfl(sl, (lane & ~7) + i);
        if (l7 == 0) y = y * c - p * sn; else if (l7 == 1) y = y * c + p * sn;
        v[i] = y; }
    return pack8(v);
}
__device__ __forceinline__ void conv8(const bf16_t* PROJ, bf16_t* AC, int tb, int lane, float (&up)[8], float (&uc)[8], const float* conv_w, const float* conv_b) {
    u32x4 rcc[8], rcx[8], rcb[8];
#pragma unroll
    for (int tk = 0; tk < 8; ++tk) { const int t = tb + tk; const bool hn = ((t & (SEQ - 1)) < SEQ - 1); const size_t tn = (size_t)(hn ? t + 1 : t);
        rcc[tk] = *(const u32x4*)(PROJ + tn * PW + C_CC + 8 * lane); rcx[tk] = *(const u32x4*)(PROJ + tn * PW + C_CX + 8 * lane); rcb[tk] = *(const u32x4*)(PROJ + (size_t)t * PW + C_CB + 8 * lane); }
    float w0[8], w1[8], w2[8], bb[8];
#pragma unroll
    for (int k = 0; k < 8; ++k) { w0[k] = conv_w[8 * lane + k]; w1[k] = conv_w[CD + 8 * lane + k]; w2[k] = conv_w[2 * CD + 8 * lane + k]; bb[k] = conv_b[8 * lane + k]; }
#pragma unroll
    for (int tk = 0; tk < 8; ++tk) { const int t = tb + tk; const bool hn = ((t & (SEQ - 1)) < SEQ - 1);
        float a8[8], b8[8], cbv[8], un[8], o[8]; unpack8(rcc[tk], a8); unpack8(rcx[tk], b8); unpack8(rcb[tk], cbv);
#pragma unroll
        for (int k = 0; k < 8; ++k) { un[k] = hn ? a8[k] * b8[k] : 0.f; o[k] = cbv[k] * (up[k] * w0[k] + uc[k] * w1[k] + un[k] * w2[k] + bb[k]); up[k] = uc[k]; uc[k] = un[k]; }
        *(u32x4*)(AC + (size_t)t * 1024 + 512 + 8 * lane) = pack8(o); }
}
__device__ __forceinline__ void p3_attention(const Frame& F, const Args& a) {
    using namespace att;
    unsigned char* ws = a.ws;
    const bf16_t* PROJ = (const bf16_t*)(ws + WS_PROJ); bf16_t* AC = (bf16_t*)(ws + WS_AC);
    const float* cosT = (const float*)(ws + WS_ROPE); const float* sinT = cosT + SEQ * 8;
    const float* qg = a.in[3]; const float* kg = a.in[4]; const float* sink = a.in[5];
    const int lane = F.lane, wid = F.wave, r32 = lane & 31, hi = lane >> 5, l7 = lane & 7;
    const float bound = 8.0f * wave_max(fabsf(qg[lane])) * wave_max(fabsf(kg[lane])) * 1.4426950408889634f * 1.0001f;
    LAS char* lds = (LAS char*)F.lds; LAS float* wsf = (LAS float*)(lds + WSOFF) + wid * 64;
    const int g = wid >> 1, qsub = wid & 1;
    float gk8[8];
#pragma unroll
    for (int k = 0; k < 8; ++k) gk8[k] = kg[8 * l7 + k];
    for (int su = F.vcu; su < NB * NKV * 16; su += F.G) {
        const int n0 = (su & 15) * 4, hk = (su >> 4) & 1, b = su >> 5;
        const int h = hk * 4 + g; const float snk = sink[h] * 1.4426950408889634f; const float mref = fmaxf(bound, snk);
        const size_t rowbase = (size_t)b * SEQ;
        __syncthreads();
        { u32x4 kraw[NSLOT], vraw[NSLOT]; float kcs[NSLOT][2];
#pragma unroll
          for (int sl = 0; sl < NSLOT; ++sl) { const int j = n0 - 2 + sl; const bool ok = (j >= 0 && j < 64); const int jj = ok ? j : n0;
              const int key = 8 * wid + (lane >> 3), pos = 64 * jj + key;
              kraw[sl] = *(const u32x4*)(PROJ + (rowbase + pos) * PW + C_K + hk * 64 + l7 * 8);
              kcs[sl][0] = cosT[pos * 8 + l7]; kcs[sl][1] = sinT[pos * 8 + l7];
              vraw[sl] = *(const u32x4*)(PROJ + (rowbase + 64 * jj + 16 * (wid & 3) + (lane >> 2)) * PW + C_V + hk * 64 + (wid >> 2) * 32 + (lane & 3) * 8); }
#pragma unroll
          for (int sl = 0; sl < NSLOT; ++sl) { const int key = 8 * wid + (lane >> 3);
              const u32x4 kn = k_norm_rope(kraw[sl], gk8, kcs[sl][0], kcs[sl][1], l7, lane);
              *(LAS u32x4*)(lds + sl * 16384 + l7 * 1024 + key * 16) = kn;
              *(LAS u32x4*)(lds + sl * 16384 + 8192 + wid * 1024 + lane * 16) = vraw[sl]; } }
        __syncthreads();
#pragma unroll 1
        for (int uu = 0; uu < 4; ++uu) {
        const int n64 = n0 + uu;
        const int qs = n64 * 64 + qsub * 32;
        bf16x8 qr[4];
        { float qv[4][8]; float ss = 0.f; const int pos = qs + r32;
#pragma unroll
          for (int d0 = 0; d0 < 4; ++d0) { const u32x4 raw = *(const u32x4*)(PROJ + (rowbase + pos) * PW + C_Q + h * 64 + d0 * 16 + hi * 8); unpack8(raw, qv[d0]); }
          const f32x4 c0 = *(const f32x4*)(cosT + pos * 8), c1 = *(const f32x4*)(cosT + pos * 8 + 4), s0 = *(const f32x4*)(sinT + pos * 8), s1 = *(const f32x4*)(sinT + pos * 8 + 4);
#pragma unroll
          for (int d0 = 0; d0 < 4; ++d0)
#pragma unroll
              for (int k = 0; k < 8; ++k) ss += qv[d0][k] * qv[d0][k];
          ss += __shfl_xor(ss, 32);
          const float rstd = rsqrtf(ss * (1.f / 64.f) + EPS);
#pragma unroll
          for (int d0 = 0; d0 < 4; ++d0) { const f32x4 ga = *(const f32x4*)(qg + d0 * 16 + hi * 8), gb = *(const f32x4*)(qg + d0 * 16 + hi * 8 + 4); const float gg[8] = {ga.x, ga.y, ga.z, ga.w, gb.x, gb.y, gb.z, gb.w};
#pragma unroll
              for (int k = 0; k < 8; ++k) qv[d0][k] = qv[d0][k] * rstd * gg[k]; }
          const float cc[8] = {c0.x, c0.y, c0.z, c0.w, c1.x, c1.y, c1.z, c1.w}, sn[8] = {s0.x, s0.y, s0.z, s0.w, s1.x, s1.y, s1.z, s1.w};
#pragma unroll
          for (int k = 0; k < 8; ++k) { const float y = qv[0][k], p = __shfl_xor(y, 32); qv[0][k] = (hi == 0) ? (y * cc[k] - p * sn[k]) : (y * cc[k] + p * sn[k]); }
#pragma unroll
          for (int d0 = 0; d0 < 4; ++d0) {
#pragma unroll
              for (int k = 0; k < 8; ++k) qv[d0][k] *= QSCALE;
              qr[d0] = __builtin_bit_cast(bf16x8, pack8(qv[d0])); } }
        f32x16 o0 = {}, o1 = {}; float lsum = 0.f;
        const int qi = qs + r32;
#pragma unroll 1
        for (int sl = 0; sl < 5; ++sl) { const int j = n64 - 2 + sl; if (j < 0 || j >= 64) continue;
            const LAS char* tile = lds + (uu + sl) * 16384;
            const LAS char* kb = tile + hi * 1024 + r32 * 16;
            f32x16 p0 = {}, p1 = {};
#pragma unroll
            for (int d0 = 0; d0 < 4; ++d0) { const bf16x8 b0 = *(const LAS bf16x8*)(kb + d0 * 2048), b1 = *(const LAS bf16x8*)(kb + d0 * 2048 + 512);
                p0 = __builtin_amdgcn_mfma_f32_32x32x16_bf16(b0, qr[d0], p0, 0, 0, 0); p1 = __builtin_amdgcn_mfma_f32_32x32x16_bf16(b1, qr[d0], p1, 0, 0, 0); }
            if (sl == 0 || sl == 4) {
                const int kb0 = 64 * j + 4 * hi;
#pragma unroll
                for (int r = 0; r < 16; ++r) { const int kk = kb0 + (r & 3) + 8 * (r >> 2); const int d0_ = qi - kk, d1_ = qi - (kk + 32);
                    const bool v0 = (d0_ <= 128) && (d0_ >= -128), v1 = (d1_ <= 128) && (d1_ >= -128);
                    p0[r] = v0 ? __builtin_amdgcn_exp2f(p0[r] - mref) : 0.f; p1[r] = v1 ? __builtin_amdgcn_exp2f(p1[r] - mref) : 0.f; lsum += p0[r] + p1[r]; }
            } else {
#pragma unroll
                for (int r = 0; r < 16; ++r) { p0[r] = __builtin_amdgcn_exp2f(p0[r] - mref); p1[r] = __builtin_amdgcn_exp2f(p1[r] - mref); lsum += p0[r] + p1[r]; }
            }
            u32x4 pw0, pw1, pw2, pw3;
            pw0 = (u32x4){cvtpk(p0[0], p0[1]), cvtpk(p0[2], p0[3]), cvtpk(p0[4], p0[5]), cvtpk(p0[6], p0[7])};
            pw1 = (u32x4){cvtpk(p0[8], p0[9]), cvtpk(p0[10], p0[11]), cvtpk(p0[12], p0[13]), cvtpk(p0[14], p0[15])};
            pw2 = (u32x4){cvtpk(p1[0], p1[1]), cvtpk(p1[2], p1[3]), cvtpk(p1[4], p1[5]), cvtpk(p1[6], p1[7])};
            pw3 = (u32x4){cvtpk(p1[8], p1[9]), cvtpk(p1[10], p1[11]), cvtpk(p1[12], p1[13]), cvtpk(p1[14], p1[15])};
            const LAS char* vp = tile + 8192 + ((lane >> 4) & 1) * 32 + (lane & 3) * 8 + (4 * hi + ((lane & 15) >> 2)) * 64;
#pragma unroll
            for (int dh = 0; dh < 2; ++dh) {
#pragma unroll
                for (int ks = 0; ks < 4; ++ks) { const s16x4 lo = vtr(vp + dh * 4096 + ks * 1024), hh = vtr(vp + dh * 4096 + ks * 1024 + 512);
                    const bf16x8 vf = (bf16x8){lo[0], lo[1], lo[2], lo[3], hh[0], hh[1], hh[2], hh[3]};
                    const u32x4 pw = ks == 0 ? pw0 : ks == 1 ? pw1 : ks == 2 ? pw2 : pw3;
                    if (dh == 0) o0 = __builtin_amdgcn_mfma_f32_32x32x16_bf16(__builtin_bit_cast(bf16x8, pw), vf, o0, 0, 0, 0);
                    else o1 = __builtin_amdgcn_mfma_f32_32x32x16_bf16(__builtin_bit_cast(bf16x8, pw), vf, o1, 0, 0, 0); } }
        }
        lsum += __shfl_xor(lsum, 32); lsum += __builtin_amdgcn_exp2f(snk - mref);
        if (hi == 0) wsf[r32] = lsum;
        LDS_WAIT(); asm volatile("" ::: "memory");
        float rl[16];
#pragma unroll
        for (int r = 0; r < 16; ++r) rl[r] = __builtin_amdgcn_rcpf(wsf[crow(r, hi)]);
        LAS bf16_t* stg = (LAS bf16_t*)(lds + OSTOFF) + wid * 1024;
        bf16_t* Ow = AC + (rowbase + qs) * 1024 + h * 64;
#pragma unroll
        for (int dh = 0; dh < 2; ++dh) {
#pragma unroll
            for (int r = 0; r < 16; ++r) stg[crow(r, hi) * 32 + r32] = f2bf((dh ? o1[r] : o0[r]) * rl[r]);
            LDS_WAIT(); asm volatile("" ::: "memory");
#pragma unroll
            for (int i = 0; i < 2; ++i) { const int row = i * 16 + (lane >> 2), ch = lane & 3; const u32x4 v = *(const LAS u32x4*)(stg + row * 32 + ch * 8); *(u32x4*)(Ow + (size_t)row * 1024 + dh * 32 + ch * 8) = v; }
            LDS_WAIT(); asm volatile("" ::: "memory"); }
        }
    }
    __syncthreads();
    { const float* conv_w = a.in[6]; const float* conv_b = a.in[7];
      const int gw = F.vcu * NWAVES + wid, NGW = F.G * NWAVES;
      for (int ch = gw; ch < M / 16; ch += NGW) { const int t0 = ch * 16; float up[8], uc[8];
          { float a8[8], b8[8];
            if ((t0 & (SEQ - 1)) > 0) { unpack8(*(const u32x4*)(PROJ + (size_t)(t0 - 1) * PW + C_CC + 8 * lane), a8); unpack8(*(const u32x4*)(PROJ + (size_t)(t0 - 1) * PW + C_CX + 8 * lane), b8);
#pragma unroll
                for (int k = 0; k < 8; ++k) up[k] = a8[k] * b8[k]; } else {
#pragma unroll
                for (int k = 0; k < 8; ++k) up[k] = 0.f; }
            unpack8(*(const u32x4*)(PROJ + (size_t)t0 * PW + C_CC + 8 * lane), a8); unpack8(*(const u32x4*)(PROJ + (size_t)t0 * PW + C_CX + 8 * lane), b8);
#pragma unroll
            for (int k = 0; k < 8; ++k) uc[k] = a8[k] * b8[k]; }
          conv8(PROJ, AC, t0, lane, up, uc, conv_w, conv_b); conv8(PROJ, AC, t0 + 8, lane, up, uc, conv_w, conv_b); } }
    __syncthreads();
}

__device__ __forceinline__ void p6_route(const Frame& F, const Args& a) {
    unsigned char* ws = a.ws;
    const float* X1 = a.out; const float* g2 = a.in[11]; const float* b_rg = a.in[13]; const float* b_re = a.in[15];
    bf16_t* H2 = (bf16_t*)(ws + WS_H2); const bf16_t* WrT = (const bf16_t*)(ws + WS_WR);
    int* asg = (int*)(ws + WS_ASG); f32x2* rsg = (f32x2*)(ws + WS_RSG); unsigned* gcnt = (unsigned*)(ws + WS_CTL) + CW_CNT;
    const int lane = F.lane, wid = F.wave, r = lane & 15, kg = lane >> 4;
    constexpr int WR_PITCH = 2064, WR_BYTES = 48 * WR_PITCH, G2_OFF = WR_BYTES, LG_OFF = G2_OFF + 4096;
    LAS unsigned char* wrl = F.lds; LAS float* g2l = (LAS float*)(F.lds + G2_OFF); LAS float* lg = (LAS float*)(F.lds + LG_OFF) + wid * (16 * 48);
    LAS int* hist = (LAS int*)(F.lds + LDSCTL_OFF + LC_HIST); LAS int* base = (LAS int*)(F.lds + LDSCTL_OFF + LC_BASE);
    for (int i = F.tid; i < 48 * 128; i += NTHREADS) { const int row = i >> 7, c = i & 127; *(LAS u32x4*)(wrl + row * WR_PITCH + c * 16) = *(const u32x4*)(WrT + (size_t)row * D + c * 8); }
    for (int i = F.tid; i < 256; i += NTHREADS) *(LAS f32x4*)(g2l + 4 * i) = *(const f32x4*)(g2 + 4 * i);
    const int nblk = M / 128;
    for (int blk = F.vcu; blk < nblk; blk += F.G) {
        if (F.tid < 32) hist[F.tid] = 0;
        __syncthreads();
        const int row0 = blk * 128 + wid * 16;
        f32x4 acc[3] = {{0.f, 0.f, 0.f, 0.f}, {0.f, 0.f, 0.f, 0.f}, {0.f, 0.f, 0.f, 0.f}}; float ss = 0.f;
        const float* xr = X1 + (size_t)(row0 + r) * D + 8 * kg; bf16_t* hr = H2 + (size_t)(row0 + r) * D + 8 * kg;
        const LAS unsigned char* wb = wrl + r * WR_PITCH + 16 * kg; const LAS float* gl = g2l + 8 * kg;
#pragma unroll 1
        for (int s0 = 0; s0 < 32; s0 += 8) { f32x4 xv[8][2];
#pragma unroll
            for (int q = 0; q < 8; ++q) { xv[q][0] = *(const f32x4*)(xr + 32 * (s0 + q)); xv[q][1] = *(const f32x4*)(xr + 32 * (s0 + q) + 4); }
#pragma unroll
            for (int q = 0; q < 8; ++q) { const int s = s0 + q; const f32x4 x0 = xv[q][0], x1 = xv[q][1];
                const f32x4 ga = *(const LAS f32x4*)(gl + 32 * s), gb = *(const LAS f32x4*)(gl + 32 * s + 4);
                ss += (x0.x * x0.x + x0.y * x0.y) + (x0.z * x0.z + x0.w * x0.w) + (x1.x * x1.x + x1.y * x1.y) + (x1.z * x1.z + x1.w * x1.w);
                u32x4 w; w.x = cvtpk(x0.x * ga.x, x0.y * ga.y); w.y = cvtpk(x0.z * ga.z, x0.w * ga.w); w.z = cvtpk(x1.x * gb.x, x1.y * gb.y); w.w = cvtpk(x1.z * gb.z, x1.w * gb.w);
                *(u32x4*)(hr + 32 * s) = w; const bf16x8 af = __builtin_bit_cast(bf16x8, w);
#pragma unroll
                for (int j = 0; j < 3; ++j) { const bf16x8 bfr = *(const LAS bf16x8*)(wb + 16 * j * WR_PITCH + 64 * s); acc[j] = __builtin_amdgcn_mfma_f32_16x16x32_bf16(af, bfr, acc[j], 0, 0, 0); } } }
        ss += __shfl_xor(ss, 16); ss += __shfl_xor(ss, 32);
        const float rstd = rsqrtf(ss * (1.f / D) + EPS);
#pragma unroll
        for (int j = 0; j < 3; ++j)
#pragma unroll
            for (int i = 0; i < 4; ++i) lg[(4 * kg + i) * 48 + 16 * j + r] = acc[j][i];
        LDS_WAIT(); asm volatile("" ::: "memory");
        int e0 = 0, e1 = 0, rk0 = 0, rk1 = 0; float gt0 = 0.f, gt1 = 0.f;
        if (lane < 16) {
            const LAS float* L = lg + lane * 48;
            float gl4[4]; int grp = 0; float gm;
#pragma unroll
            for (int i = 0; i < 4; ++i) gl4[i] = L[i] * rstd + b_rg[i];
            gm = gl4[0];
#pragma unroll
            for (int i = 1; i < 4; ++i) if (gl4[i] > gm) { gm = gl4[i]; grp = i; }
            float gs = 0.f;
#pragma unroll
            for (int i = 0; i < 4; ++i) gs += __expf(gl4[i] - gm);
            const float pg = 1.0f / gs;
            float el[8];
#pragma unroll
            for (int i = 0; i < 8; ++i) el[i] = L[4 + grp * 8 + i] * rstd + b_re[grp * 8 + i];
            int i0 = 0; float m0 = el[0];
#pragma unroll
            for (int i = 1; i < 8; ++i) if (el[i] > m0) { m0 = el[i]; i0 = i; }
            int i1 = -1; float m1 = -3.0e38f;
#pragma unroll
            for (int i = 0; i < 8; ++i) if (i != i0 && el[i] > m1) { m1 = el[i]; i1 = i; }
            const float ex1 = __expf(m1 - m0); const float den = 1.0f / (1.0f + ex1);
            gt0 = pg * den; gt1 = pg * ex1 * den; e0 = grp * 8 + i0; e1 = grp * 8 + i1;
            rk0 = __hip_atomic_fetch_add(&hist[e0], 1, __ATOMIC_RELAXED, __HIP_MEMORY_SCOPE_WORKGROUP);
            rk1 = __hip_atomic_fetch_add(&hist[e1], 1, __ATOMIC_RELAXED, __HIP_MEMORY_SCOPE_WORKGROUP);
        }
        __syncthreads();
        if (F.tid < 32) { const int n = hist[F.tid]; int bs = 0; if (n > 0) bs = (int)__hip_atomic_fetch_add(gcnt + F.tid, (unsigned)n, __ATOMIC_RELAXED, __HIP_MEMORY_SCOPE_AGENT); base[F.tid] = bs; }
        __syncthreads();
        if (lane < 16) { const int tok = row0 + lane;
            const size_t p0 = (size_t)e0 * CAP + base[e0] + rk0, p1 = (size_t)e1 * CAP + base[e1] + rk1;
            asg[p0] = tok * 2; asg[p1] = tok * 2 + 1; rsg[p0] = (f32x2){gt0, rstd}; rsg[p1] = (f32x2){gt1, rstd}; }
        __syncthreads();
    }
}

__device__ __forceinline__ void moe_tables(const Frame& F, const Args& a) {
    const unsigned* gcnt = (const unsigned*)(a.ws + WS_CTL) + CW_CNT;
    LAS int* mtpre = (LAS int*)(F.lds + LDSCTL_OFF + LC_MTPRE); LAS int* cnt = (LAS int*)(F.lds + LDSCTL_OFF + LC_CNT);
    __syncthreads();
    if (F.tid == 0) { int acc = 0; for (int e = 0; e < 32; ++e) { const int n = (int)__hip_atomic_load(gcnt + e, __ATOMIC_RELAXED, __HIP_MEMORY_SCOPE_AGENT); cnt[e] = n; mtpre[e] = acc; acc += (n + 255) >> 8; } mtpre[32] = acc; }
    __syncthreads();
}

__device__ __forceinline__ void p9_combine(const Frame& F, const Args& a, bool dummy = false) {
    float* out = a.out; float* lo_dst = dummy ? (float*)(a.ws + WS_AC) : a.out; float* hi_dst = dummy ? (float*)(a.ws + WS_MERGED) - (size_t)(M / 2) * D : a.out; const bf16_t* Y = (const bf16_t*)(a.ws + WS_Y);
    const unsigned gt = (unsigned)F.vcu * NTHREADS + F.tid, NGT = (unsigned)F.G * NTHREADS, TOT = (unsigned)M * 128u;
    for (unsigned i0 = gt; i0 < TOT; i0 += 4 * NGT) {
        f32x4 xa[4], xb[4]; u32x4 y0[4], y1[4];
#pragma unroll
        for (int k = 0; k < 4; ++k) { const unsigned i = i0 + k * NGT, ii = i < TOT ? i : gt; const size_t tok = ii >> 7, c8 = (ii & 127) * 8;
            xa[k] = *(const f32x4*)(out + tok * D + c8); xb[k] = *(const f32x4*)(out + tok * D + c8 + 4);
            y0[k] = *(const u32x4*)(Y + (tok * 2) * D + c8); y1[k] = *(const u32x4*)(Y + (tok * 2 + 1) * D + c8); }
#pragma unroll
        for (int k = 0; k < 4; ++k) { const unsigned i = i0 + k * NGT; if (i < TOT) { const size_t tok = i >> 7, c8 = (i & 127) * 8; f32x4 x0 = xa[k], x1 = xb[k];
            x0.x += bflo(y0[k].x) + bflo(y1[k].x); x0.y += bfhi(y0[k].x) + bfhi(y1[k].x); x0.z += bflo(y0[k].y) + bflo(y1[k].y); x0.w += bfhi(y0[k].y) + bfhi(y1[k].y);
            x1.x += bflo(y0[k].z) + bflo(y1[k].z); x1.y += bfhi(y0[k].z) + bfhi(y1[k].z); x1.z += bflo(y0[k].w) + bflo(y1[k].w); x1.w += bfhi(y0[k].w) + bfhi(y1[k].w);
            float* dst = (tok < (size_t)(M / 2)) ? lo_dst : hi_dst; *(f32x4*)(dst + tok * D + c8) = x0; *(f32x4*)(dst + tok * D + c8 + 4) = x1; } }
    }
}

constexpr int N_PHASES = 10;
__global__ void __launch_bounds__(NTHREADS, 2) fwd_kernel(Args args) {
    extern __shared__ __attribute__((aligned(16))) unsigned char lds_raw[];
    Frame F; F.lds = (LAS unsigned char*)lds_raw; F.tid = threadIdx.x; F.lane = F.tid & 63; F.wave = __builtin_amdgcn_readfirstlane(F.tid >> 6);
    F.G = gridDim.x; { const int bx = blockIdx.x; F.vcu = (F.G % 8 == 0) ? (bx % 8) * (F.G / 8) + bx / 8 : bx; }
    for (int u = F.tid; u < (LDS_BYTES - LDSCTL_OFF) / 4; u += NTHREADS) ((LAS unsigned*)(F.lds + LDSCTL_OFF))[u] = 0u;
    __syncthreads();
    unsigned char* ws = args.ws;
    const int lo = args.ph_lo, hi = args.ph_hi;
#ifndef PH_MASK
#define PH_MASK 0x3ff
#endif
#define IN(k) (((PH_MASK >> (k)) & 1) && lo <= (k) && (k) < hi)
#if MK_USE_CG
#define GRID_BAR(k) do { if (IN(k) && IN((k) + 1)) { cg::this_grid().sync(); } } while (0)
#else
    XcdBarrier bar; bar.bar = (unsigned*)(ws + WS_CTL) + CW_BAR; bar.x = 0; bar.st = nullptr;
    if (hi - lo > 1) bar = xcd_barrier_post((unsigned*)(ws + WS_CTL) + CW_BAR, (volatile LAS unsigned*)(F.lds + LDSCTL_OFF + LC_MISC) + 8);
#define GRID_BAR(k) do { if (IN(k) && IN((k) + 1)) { xcd_barrier(bar); } } while (0)
#endif
    const LAS int* mtpre = (const LAS int*)(F.lds + LDSCTL_OFF + LC_MTPRE); const LAS int* lcnt = (const LAS int*)(F.lds + LDSCTL_OFF + LC_CNT);

#define REP(k) for (int rep_ = 0; rep_ < args.rep[k]; ++rep_)
#define REFRESH() do { F.tid = threadIdx.x; asm volatile("" : "+v"(F.tid)); F.lane = F.tid & 63; } while (0)
#define REPBAR() do { if (rep_) xcd_barrier(bar); REFRESH(); } while (0)
    if (IN(0)) REP(0) { REPBAR(); p0_prologue(F, args); } GRID_BAR(0);
    if (IN(1)) REP(1) { REPBAR(); pg8::PlainOrder S{(const bf16_t*)(ws + WS_XN), (const bf16_t*)(ws + WS_WIN), 1024, 1024, M / 256, PW / 256, F.G, (int)blockIdx.x};
        pg8::EpiProj E{(bf16_t*)(ws + WS_PROJ)};
        pg8::gemm_phase<pg8::EpiProj, pg8::PlainOrder, true>(F.lds, 1024, 1024, 1024, S, E);
        if (rep_ == 0) { const int nwg = (M / 256) * (PW / 256), maxc = (nwg + F.G - 1) / F.G, full = nwg - (maxc - 1) * F.G;
            if (full >= F.G) convert_items(F, args, I_SMALL, I_SMALL + 2 * I_G, (int)blockIdx.x, F.G);
            else if ((int)blockIdx.x >= full) convert_items(F, args, I_SMALL, I_SMALL + 2 * I_G, (int)blockIdx.x - full, F.G - full); } } GRID_BAR(1);
    if (IN(3)) REP(3) { REPBAR(); p3_attention(F, args); } GRID_BAR(3);
    if (IN(4)) REP(4) { REPBAR(); pg8::PlainOrder S{(const bf16_t*)(ws + WS_AC), (const bf16_t*)(ws + WS_WA), 1024, 1024, M / 256, D / 256, F.G, (int)blockIdx.x};
        pg8::EpiGate2 E{(const bf16_t*)(ws + WS_PROJ), (bf16_t*)(ws + WS_MERGED)};
        pg8::gemm_phase<pg8::EpiGate2, pg8::PlainOrder, true>(F.lds, 1024, 1024, 1024, S, E); } GRID_BAR(4);
    if (IN(5)) REP(5) { REPBAR(); pg8::PlainOrder S{(const bf16_t*)(ws + WS_MERGED), (const bf16_t*)(ws + WS_WOUT), 1024, 1024, M / 256, D / 256, F.G, (int)blockIdx.x};
        pg8::EpiRes E{args.in[0], args.out};
        pg8::gemm_phase<pg8::EpiRes, pg8::PlainOrder, true>(F.lds, 1024, 1024, 1024, S, E); } GRID_BAR(5);
    if (IN(6)) REP(6) { REFRESH(); if (rep_) { xcd_barrier(bar); if (blockIdx.x == 0 && F.tid < 32) ((unsigned*)(ws + WS_CTL) + CW_CNT)[F.tid] = 0u; xcd_barrier(bar); } p6_route(F, args); } GRID_BAR(6);
    if (IN(7)) REP(7) { REPBAR(); moe_tables(F, args);
        pg8::MoeGuOrder S; S.mtpre = mtpre; S.cnt = lcnt; S.NT = 2; S.G = F.G; S.c = (int)blockIdx.x; S.H2 = (const bf16_t*)(ws + WS_H2); S.Wgu = (const bf16_t*)(ws + WS_WGU); S.asg = (const int*)(ws + WS_ASG);
        pg8::EpiGU E{(bf16_t*)(ws + WS_HID), (const f32x2*)(ws + WS_RSG), mtpre};
        pg8::gemm_phase<pg8::EpiGU, pg8::MoeGuOrder, true>(F.lds, 1024, 1024, 1024, S, E);
        if (rep_ == 0) { const int nwg = mtpre[32] * 2, maxc = (nwg + F.G - 1) / F.G, full = nwg - (maxc - 1) * F.G;
            __syncthreads();
            if (full >= F.G || maxc == 0) convert_items(F, args, I_SMALL + 2 * I_G, NITEMS, (int)blockIdx.x, F.G);
            else if ((int)blockIdx.x >= full) convert_items(F, args, I_SMALL + 2 * I_G, NITEMS, (int)blockIdx.x - full, F.G - full); } } GRID_BAR(7);
    if (IN(8)) REP(8) { REPBAR(); moe_tables(F, args);
        pg8::MoeDownOrder S; S.mtpre = mtpre; S.cnt = lcnt; S.NT = 4; S.G = F.G; S.c = (int)blockIdx.x; S.HID = (const bf16_t*)(ws + WS_HID); S.Wd = (const bf16_t*)(ws + WS_WD);
        pg8::EpiDown E{(bf16_t*)(ws + WS_Y), (const int*)(ws + WS_ASG), (const f32x2*)(ws + WS_RSG), mtpre};
        pg8::gemm_phase<pg8::EpiDown, pg8::MoeDownOrder, true, true>(F.lds, 256, 256, 256, S, E); } GRID_BAR(8);
    if (IN(9)) { REFRESH(); if (args.rep[9] > 1) { p9_combine(F, args, true); xcd_barrier(bar); } p9_combine(F, args); }
#undef IN
#undef GRID_BAR
}

extern "C" void kernel_launch(void* const* d_in, const int* in_sizes, int n_in, void* d_out, int out_size, void* d_ws, size_t ws_size, hipStream_t stream) {
    static int grid = 0;
    if (grid == 0) {
        if (n_in != 19 || in_sizes[0] != M * D || out_size != M * D || ws_size < WS_END) { fprintf(stderr, "kernel_launch: unexpected shapes (n_in %d, in0 %d, out %d, ws %zu)\n", n_in, n_in > 0 ? in_sizes[0] : -1, out_size, ws_size); grid = -1; return; }
        int dev = 0, cus = 0, per_cu = 0;
        if (hipGetDevice(&dev) != hipSuccess || hipDeviceGetAttribute(&cus, hipDeviceAttributeMultiprocessorCount, dev) != hipSuccess) { grid = -1; return; }
        if (hipFuncSetAttribute((const void*)fwd_kernel, hipFuncAttributeMaxDynamicSharedMemorySize, LDS_BYTES) != hipSuccess) { fprintf(stderr, "kernel_launch: hipFuncSetAttribute failed\n"); grid = -1; return; }
        if (hipOccupancyMaxActiveBlocksPerMultiprocessor(&per_cu, (const void*)fwd_kernel, NTHREADS, LDS_BYTES) != hipSuccess || per_cu < 1) { fprintf(stderr, "kernel_launch: occupancy query says %d\n", per_cu); per_cu = 1; }
        (void)hipGetLastError();
        grid = cus * 1;
        fprintf(stderr, "kernel_launch: cus %d per_cu %d grid %d\n", cus, per_cu, grid);
    }
    if (grid < 0) return;
    (void)hipMemsetAsync((char*)d_ws + WS_CTL, 0, CTL_ZERO_BYTES, stream);
    Args a{};
    for (int i = 0; i < 19; ++i) a.in[i] = (const float*)d_in[i];
    a.out = (float*)d_out; a.ws = (unsigned char*)d_ws;
    for (int i = 0; i < 10; ++i) a.rep[i] = (i == PROBE_DUP) ? 2 : 1;
#if MK_N_LAUNCHES == 1
    a.ph_lo = 0; a.ph_hi = N_PHASES;
    void* kargs[] = {&a};
#if MK_USE_CG
    hipError_t e = hipLaunchCooperativeKernel((const void*)fwd_kernel, dim3(grid), dim3(NTHREADS), kargs, LDS_BYTES, stream);
    if (e != hipSuccess) fprintf(stderr, "kernel_launch: cooperative launch failed: %s\n", hipGetErrorString(e));
#else
    (void)kargs; hipLaunchKernelGGL(fwd_kernel, dim3(grid), dim3(NTHREADS), LDS_BYTES, stream, a);
#endif
#else
    for (int p = 0; p < N_PHASES; ++p) { a.ph_lo = p; a.ph_hi = p + 1; hipLaunchKernelGGL(fwd_kernel, dim3(grid), dim3(NTHREADS), LDS_BYTES, stream, a); }
#endif
}
```

```cpp
#include <hip/hip_runtime.h>
#include <hip/hip_cooperative_groups.h>
#include <cstdio>
#include <cstdint>
namespace cg = cooperative_groups;

#ifndef PROBE_DUP
#define PROBE_DUP -1
#endif
#ifndef PROBE_TS
#define PROBE_TS -1
#endif
#ifndef PROBE_V
#define PROBE_V 1.4f
#endif
#ifndef PROBE_SCALE
#define PROBE_SCALE 1e-3f
#endif
#ifndef MK_N_LAUNCHES
#define MK_N_LAUNCHES 1
#endif

#define LAS __attribute__((address_space(3)))
#define GAS __attribute__((address_space(1)))
typedef unsigned short bf16_t;
typedef short bf16x8 __attribute__((ext_vector_type(8)));
typedef short s16x4 __attribute__((ext_vector_type(4)));
typedef float f32x4 __attribute__((ext_vector_type(4)));
typedef float f32x2 __attribute__((ext_vector_type(2)));
typedef float f32x16 __attribute__((ext_vector_type(16)));
typedef unsigned u32x4 __attribute__((ext_vector_type(4)));
typedef unsigned u32x2 __attribute__((ext_vector_type(2)));
typedef __bf16 bf16x2_t __attribute__((ext_vector_type(2)));

constexpr int NB = 8, SEQ = 4096, M = NB * SEQ, D = 1024, PW = 4352;
constexpr int PWP = 1792;
constexpr int NH = 8, NKV = 2, HD = 64, AD = 512, CD = 512;
constexpr int C_Q = 0, C_K = 512, C_V = 640, C_CB = 768, C_CC = 1280, C_CX = 1792, C_GA = 2304;
constexpr int C_U = 1280;
constexpr int NE = 32, DFF = 256, CAP = 32768;
constexpr float EPS = 1e-6f;
constexpr float QSCALE = 0.125f * 1.4426950408889634f;
constexpr int NWAVES = 8, NTHREADS = 512;

constexpr size_t MiB = 1u << 20;
constexpr size_t WS_CTL = 0, CTL_ZERO_BYTES = 64 * 1024;
constexpr size_t WS_ROPE = 1 * MiB;
constexpr size_t WS_WR = 1 * MiB + 256 * 1024;
constexpr size_t WS_WIN = 2 * MiB;
constexpr size_t WS_WIN8 = 440 * MiB;
constexpr size_t WS_XN8 = 400 * MiB;
constexpr float WIN8_SCALE = 32.0f;
constexpr size_t WS_WA = 11 * MiB, WS_WC = 12 * MiB;
constexpr size_t WS_WOUT = 13 * MiB;
constexpr size_t WS_WGU = 16 * MiB;
constexpr size_t WS_WD = 48 * MiB;
constexpr size_t WS_XN = 64 * MiB;
constexpr size_t WS_AC = 336 * MiB;
constexpr size_t WS_PROJ = 128 * MiB;
constexpr size_t WS_ATT8 = 240 * MiB;
constexpr size_t WS_GATE8 = 272 * MiB;
constexpr size_t WS_H2 = 128 * MiB;
constexpr size_t WS_HID = 192 * MiB;
constexpr size_t WS_Y = 232 * MiB;
constexpr size_t WS_X1B = 64 * MiB;
constexpr size_t WS_RRS = 1 * MiB + 512 * 1024;
constexpr size_t WS_MERGED = 400 * MiB;
constexpr size_t WS_ASG = 464 * MiB;
constexpr size_t WS_RSG = 468 * MiB;
constexpr size_t WS_END = 476 * MiB;
constexpr int CW_CNT = 1024;
constexpr int CW_TS = 2048;
constexpr int CW_BAR = 4096;

constexpr int RING_BYTES = 131072;
constexpr int LDSCTL_OFF = RING_BYTES;
constexpr int LC_MISC = 0;
constexpr int LC_MTPRE = 128;
constexpr int LC_CNT = 128 + 160;
constexpr int LC_HIST = LC_CNT + 128;
constexpr int LC_BASE = LC_HIST + 128;
constexpr int LDS_META_OFF = 136 * 1024;
constexpr int LDS_BYTES = 163840;

__device__ __forceinline__ unsigned cvtpk(float lo, float hi) { f32x2 v = {lo, hi}; bf16x2_t b = __builtin_convertvector(v, bf16x2_t); return __builtin_bit_cast(unsigned, b); }
__device__ __forceinline__ bf16_t f2bf(float f) { return (bf16_t)(cvtpk(f, 0.f) & 0xffffu); }
__device__ __forceinline__ float bf2f(unsigned h) { return __builtin_bit_cast(float, h << 16); }
__device__ __forceinline__ float bflo(unsigned w) { return __builtin_bit_cast(float, w << 16); }
__device__ __forceinline__ float bfhi(unsigned w) { return __builtin_bit_cast(float, w & 0xffff0000u); }
__device__ __forceinline__ float wave_sum(float v) {
#pragma unroll
    for (int o = 1; o < 64; o <<= 1) v += __shfl_xor(v, o);
    return v;
}
__device__ __forceinline__ float wave_max(float v) {
#pragma unroll
    for (int o = 1; o < 64; o <<= 1) v = fmaxf(v, __shfl_xor(v, o));
    return v;
}
__device__ __forceinline__ float sig255(float a, float c1) { return __builtin_amdgcn_rcpf(__builtin_amdgcn_exp2f(__builtin_fmaf(a, c1, -7.994353436858858f)) + (1.0f / 255.0f)); }
__device__ __forceinline__ float sigmoidf_(float v) { return __builtin_amdgcn_rcpf(1.0f + __builtin_amdgcn_exp2f(-1.4426950408889634f * v)); }
__device__ __forceinline__ void unpack8(const u32x4 w, float (&v)[8]) { v[0] = bflo(w.x); v[1] = bfhi(w.x); v[2] = bflo(w.y); v[3] = bfhi(w.y); v[4] = bflo(w.z); v[5] = bfhi(w.z); v[6] = bflo(w.w); v[7] = bfhi(w.w); }
__device__ __forceinline__ u32x4 pack8(const float (&v)[8]) { u32x4 w; w.x = cvtpk(v[0], v[1]); w.y = cvtpk(v[2], v[3]); w.z = cvtpk(v[4], v[5]); w.w = cvtpk(v[6], v[7]); return w; }
__device__ __forceinline__ int lane_id() { unsigned m = ~0u; asm volatile("" : "+s"(m)); return (int)__builtin_amdgcn_mbcnt_hi(m, __builtin_amdgcn_mbcnt_lo(m, 0u)); }
__device__ __forceinline__ unsigned pk4_fp8(float a, float b, float c, float d) { int w = 0; w = __builtin_amdgcn_cvt_pk_fp8_f32(a, b, w, false); w = __builtin_amdgcn_cvt_pk_fp8_f32(c, d, w, true); return (unsigned)w; }
__device__ __forceinline__ void un4_fp8(unsigned w, float& a, float& b, float& c, float& d) { const f32x2 lo = __builtin_amdgcn_cvt_pk_f32_fp8((int)w, false), hi = __builtin_amdgcn_cvt_pk_f32_fp8((int)w, true); a = lo.x; b = lo.y; c = hi.x; d = hi.y; }
#define LDS_WAIT() asm volatile("s_waitcnt lgkmcnt(0)" ::: "memory")
#define VM_WAIT() asm volatile("s_waitcnt vmcnt(0)" ::: "memory")

namespace pg8 {
constexpr int BM = 256, BK = 64, HALF = 128, HTB = HALF * BK * 2, STAGE_BYTES = 8 * HTB, NXCD = 8, WGM = 8;
__host__ __device__ __forceinline__ int lds_byte(int r, int c) { const int st = (r >> 4) * 2 + (c >> 5), rr = r & 15, cc = c & 31, ob = rr * 64 + cc * 2; return st * 1024 + (ob ^ (((ob >> 9) & 1) << 5)); }
__host__ __device__ __forceinline__ void stage_rc(int b, int& R, int& C) { const int st = b / 1024, sb = b % 1024, swz = sb ^ (((sb >> 9) & 1) << 5); R = (st >> 1) * 16 + swz / 64; C = (st & 1) * 32 + (swz % 64) / 2; }
__host__ __device__ __forceinline__ int perm32(int rho) { const int n = rho >> 4, i = rho & 15; return 8 * (i >> 2) + 4 * n + (i & 3); }

struct Unit { int pm, pn, z, valid; };

__device__ __forceinline__ void tile_of(int L, int nM, int nN, int& pm, int& pn) {
    const int nwg = nM * nN; int wgid = L;
    { const int q = nwg / NXCD, r = nwg % NXCD, xcd = wgid % NXCD, off = wgid / NXCD; wgid = (xcd < r ? xcd * (q + 1) : r * (q + 1) + (xcd - r) * q) + off; }
    const int nig = WGM * nN, gid = wgid / nig, fm = gid * WGM, gsz = (nM - fm) < WGM ? (nM - fm) : WGM;
    pm = fm + ((wgid % nig) % gsz); pn = (wgid % nig) / gsz;
}

struct PlainOrder {
    static constexpr bool GATHER = false;
    const bf16_t* A; const bf16_t* Bt; int lda, ldb, nM, nN, G, c;
    __device__ __forceinline__ bool next(int i, Unit& u) const { const int L = i * G + c; if (L >= nM * nN) return false; tile_of(L, nM, nN, u.pm, u.pn); u.z = 0; u.valid = 256; return true; }
    __device__ __forceinline__ void bases(const void*& a, const void*& b) const { a = A; b = Bt; }
    __device__ __forceinline__ void offs(const Unit& u, unsigned& a, unsigned& b) const { a = (unsigned)u.pm * 256u * (unsigned)lda * 2u; b = (unsigned)u.pn * 256u * (unsigned)ldb * 2u; }
    __device__ __forceinline__ void avoff(const Unit&, const int (&R)[2], const int (&C)[2], unsigned (&v)[2][2]) const {
#pragma unroll
        for (int h = 0; h < 2; ++h)
#pragma unroll
            for (int i = 0; i < 2; ++i) v[h][i] = (unsigned)(R[i] * lda + C[i]) * 2u;
    }
};
struct GateMixOrder {
    static constexpr bool GATHER = false;
    const bf16_t* AC; const bf16_t* WcT; const unsigned char* ATT8; const unsigned char* WA8; int G, c;
    __device__ __forceinline__ bool next(int i, Unit& u) const { const int L = i * G + c; if (L >= 128 * 4) return false; tile_of(L, 128, 4, u.pm, u.pn); u.z = 0; u.valid = 256; return true; }
    __device__ __forceinline__ void bases(const void*& a, const void*& b) const { a = AC; b = WcT; }
    __device__ __forceinline__ void bases8(const void*& a, const void*& b) const { a = ATT8; b = WA8; }
    __device__ __forceinline__ void offs(const Unit& u, unsigned& a, unsigned& b) const { a = (unsigned)u.pm * 256u * 2048u + 1024u; b = (unsigned)u.pn * 256u * 1024u; }
    __device__ __forceinline__ void offs8(const Unit& u, unsigned& a, unsigned& b) const { a = (unsigned)u.pm * 256u * 512u; b = (unsigned)u.pn * 256u * 512u; }
    __device__ __forceinline__ void avoff(const Unit&, const int (&R)[2], const int (&C)[2], unsigned (&v)[2][2]) const {
#pragma unroll
        for (int h = 0; h < 2; ++h)
#pragma unroll
            for (int i = 0; i < 2; ++i) v[h][i] = (unsigned)(R[i] * 1024 + C[i]) * 2u;
    }
};
struct ProjOrder8 {
    static constexpr bool GATHER = false;
    const unsigned char* A; const unsigned char* Bt; int G, c;
    __device__ __forceinline__ bool next(int i, Unit& u) const { const int L = i * G + c; if (L >= 128 * 11) return false; int idx; tile_of(L, 128, 11, u.pm, idx); u.pn = idx < 3 ? idx : idx + 6; u.z = 1; u.valid = 256; return true; }
    __device__ __forceinline__ void bases(const void*& a, const void*& b) const { a = A; b = Bt; }
    __device__ __forceinline__ void offs(const Unit& u, unsigned& a, unsigned& b) const { a = (unsigned)u.pm * 256u * 1024u; b = (unsigned)u.pn * 256u * 1024u; }
    __device__ __forceinline__ void avoff(const Unit&, const int (&R)[2], const int (&C)[2], unsigned (&v)[2][2]) const {
#pragma unroll
        for (int h = 0; h < 2; ++h)
#pragma unroll
            for (int i = 0; i < 2; ++i) v[h][i] = (unsigned)(R[i] * 512 + C[i]) * 2u;
    }
};
struct ProjOrder16 {
    static constexpr bool GATHER = false;
    const bf16_t* A; const bf16_t* Bt; int G, c;
    __device__ __forceinline__ bool next(int i, Unit& u) const { const int L = i * G + c; if (L >= 128 * 6) return false; int idx; tile_of(L, 128, 6, u.pm, idx); u.pn = 3 + idx; u.z = 0; u.valid = 256; return true; }
    __device__ __forceinline__ void bases(const void*& a, const void*& b) const { a = A; b = Bt; }
    __device__ __forceinline__ void offs(const Unit& u, unsigned& a, unsigned& b) const { a = (unsigned)u.pm * 256u * 2048u; b = (unsigned)u.pn * 256u * 2048u; }
    __device__ __forceinline__ void avoff(const Unit&, const int (&R)[2], const int (&C)[2], unsigned (&v)[2][2]) const {
#pragma unroll
        for (int h = 0; h < 2; ++h)
#pragma unroll
            for (int i = 0; i < 2; ++i) v[h][i] = (unsigned)(R[i] * 1024 + C[i]) * 2u;
    }
};
struct MoeOrder {
    const LAS int* mtpre; const LAS int* cnt; int NT, G, c;
    __device__ __forceinline__ bool locate(int i, Unit& u) const {
        const int L = i * G + c; const int U = __builtin_amdgcn_readfirstlane(mtpre[32]) * NT; if (L >= U) return false;
        const int tg = L / NT; u.pn = L - tg * NT;
        const int l = lane_id() & 31; const int e = (int)__popcll(__ballot(l >= 1 && mtpre[l] <= tg)) >> 1;
        u.z = e; u.pm = tg; const int mt = tg - __builtin_amdgcn_readfirstlane(mtpre[e]); const int left = __builtin_amdgcn_readfirstlane(cnt[e]) - mt * 256; u.valid = left < 256 ? left : 256; return true;
    }
};
struct MoeGuOrder : MoeOrder {
    static constexpr bool GATHER = true;
    const unsigned char* H2; const unsigned char* Wgu; const int* asg; LAS int* idl;
    __device__ __forceinline__ bool next(int i, Unit& u) const { return locate(i, u); }
    __device__ __forceinline__ void prefetch_ids(const Unit& u, int wave, int lane) const {
        if (wave < 4) { const int mt = u.pm - mtpre[u.z]; const unsigned pb = (unsigned)__builtin_amdgcn_readfirstlane((int)((unsigned)u.z * CAP + mt * 256));
            const __amdgpu_buffer_rsrc_t rs = __builtin_amdgcn_make_buffer_rsrc(const_cast<int*>(asg), 0, 0xffffffff, 0x00020000);
            __builtin_amdgcn_raw_ptr_buffer_load_lds(rs, (LAS void*)((LAS unsigned char*)idl + wave * 256), 4, (wave * 64 + lane) * 4, (int)(pb * 4u), 0, 0); }
    }
    __device__ __forceinline__ void avoff_lds(const Unit& u, const int (&R)[2], const int (&C)[2], unsigned (&v)[2][2]) const {
#pragma unroll
        for (int h = 0; h < 2; ++h)
#pragma unroll
            for (int i = 0; i < 2; ++i) { const unsigned r = (unsigned)(h * 128 + R[i]); const unsigned rr = ((int)r < u.valid) ? r : 0u; const int tok = idl[rr] >> 1; v[h][i] = (unsigned)(tok * 512 + C[i]) * 2u; }
    }
    __device__ __forceinline__ void bases(const void*& a, const void*& b) const { a = H2; b = Wgu; }
    __device__ __forceinline__ void offs(const Unit& u, unsigned& a, unsigned& b) const { a = 0u; b = ((unsigned)u.z * 512u + (unsigned)u.pn * 256u) * 1024u; }
    __device__ __forceinline__ void avoff(const Unit& u, const int (&R)[2], const int (&C)[2], unsigned (&v)[2][2]) const {
        const int mt = u.pm - mtpre[u.z]; const unsigned pb = (unsigned)__builtin_amdgcn_readfirstlane((int)((unsigned)u.z * CAP + mt * 256));
        const __amdgpu_buffer_rsrc_t rsi = __builtin_amdgcn_make_buffer_rsrc(const_cast<int*>(asg), 0, 0xffffffff, 0x00020000);
        int tk[2][2];
#pragma unroll
        for (int h = 0; h < 2; ++h)
#pragma unroll
            for (int i = 0; i < 2; ++i) { const unsigned r = (unsigned)(h * 128 + R[i]); const unsigned rr = ((int)r < u.valid) ? r : 0u; tk[h][i] = (int)__builtin_amdgcn_raw_buffer_load_b32(rsi, (int)(rr * 4u), (int)(pb * 4u), 0); }
        asm volatile("" : "+v"(tk[0][0]), "+v"(tk[0][1]), "+v"(tk[1][0]), "+v"(tk[1][1]));
#pragma unroll
        for (int h = 0; h < 2; ++h)
#pragma unroll
            for (int i = 0; i < 2; ++i) { const int tok = tk[h][i] >> 1; v[h][i] = (unsigned)(tok * 512 + C[i]) * 2u; }
    }
};
struct MoeDownOrder : MoeOrder {
    static constexpr bool GATHER = false;
    const unsigned char* HID; const unsigned char* Wd;
    __device__ __forceinline__ bool next(int i, Unit& u) const { return locate(i, u); }
    __device__ __forceinline__ void bases(const void*& a, const void*& b) const { a = HID; b = Wd; }
    __device__ __forceinline__ void offs(const Unit& u, unsigned& a, unsigned& b) const { a = (unsigned)u.pm * 256u * 256u; b = ((unsigned)u.z * 1024u + (unsigned)u.pn * 256u) * 256u; }
    __device__ __forceinline__ void avoff(const Unit&, const int (&R)[2], const int (&C)[2], unsigned (&v)[2][2]) const {
#pragma unroll
        for (int h = 0; h < 2; ++h)
#pragma unroll
            for (int i = 0; i < 2; ++i) v[h][i] = (unsigned)(R[i] * 128 + C[i]) * 2u;
    }
};

typedef f32x4 Acc[2][2][4][2];

template <bool WIDE_>
struct EpiProjT {
    static constexpr bool PERM = true, HAS_MID = false, HAS_PRE = false, WIDE = WIDE_; struct Pre {};
    bf16_t* O; unsigned char* G8;
    __device__ __forceinline__ void operator()(const Acc& acc, const Unit& u, int wr, int wc, int fr, int fq) const {
        const bool sg = u.pn >= 9; const float sc = u.z ? (1.0f / WIN8_SCALE) : 1.0f;
        if (u.pn >= 5 && u.pn <= 8) {
            bf16_t* base = O + (size_t)u.pm * BM * PWP + C_U + (u.pn - 5) * 128;
            unsigned l0 = (unsigned)((wr * 64 + fr) * PWP + wc * 32 + 8 * fq); asm volatile("" : "+v"(l0));
#pragma unroll
            for (int ai = 0; ai < 2; ++ai)
#pragma unroll
                for (int m = 0; m < 4; ++m) { const f32x4 v0 = acc[ai][0][m][0] * acc[ai][1][m][0], v1 = acc[ai][0][m][1] * acc[ai][1][m][1];
                    u32x4 w; w.x = cvtpk(v0[0], v0[1]); w.y = cvtpk(v0[2], v0[3]); w.z = cvtpk(v1[0], v1[1]); w.w = cvtpk(v1[2], v1[3]);
                    *(u32x4*)(base + (l0 + (unsigned)((ai * HALF + m * 16) * PWP))) = w; }
        } else if (!sg) {
            bf16_t* base = O + (size_t)u.pm * BM * PWP + u.pn * BM;
            unsigned l0 = (unsigned)((wr * 64 + fr) * PWP + wc * (WIDE ? 64 : 32) + 8 * fq); asm volatile("" : "+v"(l0));
#pragma unroll
            for (int ai = 0; ai < 2; ++ai)
#pragma unroll
                for (int m = 0; m < 4; ++m)
#pragma unroll
                    for (int bj = 0; bj < 2; ++bj) { const f32x4 v0 = acc[ai][bj][m][0] * sc, v1 = acc[ai][bj][m][1] * sc;
                        u32x4 w; w.x = cvtpk(v0[0], v0[1]); w.y = cvtpk(v0[2], v0[3]); w.z = cvtpk(v1[0], v1[1]); w.w = cvtpk(v1[2], v1[3]);
                        *(u32x4*)(base + (l0 + (unsigned)((ai * HALF + m * 16) * PWP + bj * (WIDE ? 32 : HALF)))) = w; }
        } else {
            unsigned char* base = G8 + ((size_t)u.pm * 8 + (u.pn - 9)) * 65536 + (wr * 4 + wc) * 8192;
            const float c1 = -1.4426950408889634f * sc;
            unsigned l0 = (unsigned)((fr + 16 * fq) * 16); asm volatile("" : "+v"(l0));
#pragma unroll
            for (int ai = 0; ai < 2; ++ai)
#pragma unroll
                for (int bj = 0; bj < 2; ++bj)
#pragma unroll
                    for (int m2 = 0; m2 < 2; ++m2) { u32x4 w4;
#pragma unroll
                        for (int mm = 0; mm < 2; ++mm) { const int m = 2 * m2 + mm; u32x2 w; w.x = 0u; w.y = 0u;
                            const f32x4 t0 = acc[ai][bj][m][0] * c1 + (-7.994353436858858f), t1 = acc[ai][bj][m][1] * c1 + (-7.994353436858858f);
                            f32x4 e0, e1;
#pragma unroll
                            for (int k = 0; k < 4; ++k) { e0[k] = __builtin_amdgcn_exp2f(t0[k]); e1[k] = __builtin_amdgcn_exp2f(t1[k]); }
                            const f32x4 d0 = e0 + (1.0f / 255.0f), d1 = e1 + (1.0f / 255.0f);
                            f32x4 y0, y1;
#pragma unroll
                            for (int k = 0; k < 4; ++k) { y0[k] = __builtin_amdgcn_rcpf(d0[k]); y1[k] = __builtin_amdgcn_rcpf(d1[k]); }
#pragma unroll
                            for (int k = 0; k < 4; ++k) { w.x = __builtin_amdgcn_cvt_pk_u8_f32(y0[k], k, w.x); w.y = __builtin_amdgcn_cvt_pk_u8_f32(y1[k], k, w.y); }
                            if (mm == 0) { w4.x = w.x; w4.y = w.y; } else { w4.z = w.x; w4.w = w.y; } }
                        *(u32x4*)(base + (l0 + (unsigned)((((ai * 2 + bj) * 2 + m2)) * 1024))) = w4; }
        }
    }
};
struct EpiGate2 {
    static constexpr bool PERM = true, HAS_MID = true, HAS_PRE = false, WIDE = true; struct Pre {};
    const unsigned char* G8; bf16_t* MG;
    static __device__ __forceinline__ void un8(const u32x2 w, float (&v)[8]) {
#pragma unroll
        for (int k = 0; k < 4; ++k) { v[k] = (float)((w.x >> (8 * k)) & 0xffu); v[4 + k] = (float)((w.y >> (8 * k)) & 0xffu); } }
    __device__ __forceinline__ void mid(Acc& acc, const Unit& u, int wr, int wc, int fr, int fq) const {
        const unsigned char* ga_b = G8 + ((size_t)u.pm * 8 + u.pn) * 65536 + (wr * 4 + wc) * 8192;
        const unsigned char* gc_b = ga_b + 4 * 65536;
        unsigned lg = (unsigned)((fr + 16 * fq) * 16); asm volatile("" : "+v"(lg));
        u32x4 ga[2][2][2], gc[2][2][2];
#pragma unroll
        for (int ai = 0; ai < 2; ++ai)
#pragma unroll
            for (int bj = 0; bj < 2; ++bj)
#pragma unroll
                for (int m2 = 0; m2 < 2; ++m2) { const unsigned o = lg + (unsigned)(((ai * 2 + bj) * 2 + m2) * 1024); ga[ai][bj][m2] = *(const u32x4*)(ga_b + o); gc[ai][bj][m2] = *(const u32x4*)(gc_b + o); }
        asm volatile("" ::: "memory");
#pragma unroll
        for (int ai = 0; ai < 2; ++ai) {
#pragma unroll
            for (int m = 0; m < 4; ++m)
#pragma unroll
                for (int bj = 0; bj < 2; ++bj) { float a8[8], c8[8]; const u32x4 ga4 = ga[ai][bj][m >> 1], gc4 = gc[ai][bj][m >> 1];
                    un8((m & 1) ? (u32x2){ga4.z, ga4.w} : (u32x2){ga4.x, ga4.y}, a8); un8((m & 1) ? (u32x2){gc4.z, gc4.w} : (u32x2){gc4.x, gc4.y}, c8);
#pragma unroll
                    for (int k = 0; k < 8; ++k) { const float r = a8[k] * (1.0f / 512.0f) * __builtin_amdgcn_rcpf(fmaxf(c8[k], 2.4318695068359375e-04f)); if (k < 4) acc[ai][bj][m][0][k] *= r; else acc[ai][bj][m][1][k - 4] *= r; } }
            asm volatile("" ::: "memory"); }
    }
    __device__ __forceinline__ void operator()(const Acc& acc, const Unit& u, int wr, int wc, int fr, int fq) const {
        const unsigned char* gc_b = G8 + ((size_t)u.pm * 8 + 4 + u.pn) * 65536 + (wr * 4 + wc) * 8192;
        bf16_t* ob = MG + (size_t)u.pm * BM * 1024 + u.pn * BM;
        unsigned lg = (unsigned)((fr + 16 * fq) * 16), lt = (unsigned)((wr * 64 + fr) * 1024 + wc * 64 + 8 * fq); asm volatile("" : "+v"(lg), "+v"(lt));
        u32x4 gc[2][2][2];
#pragma unroll
        for (int ai = 0; ai < 2; ++ai)
#pragma unroll
            for (int bj = 0; bj < 2; ++bj)
#pragma unroll
                for (int m2 = 0; m2 < 2; ++m2) gc[ai][bj][m2] = *(const u32x4*)(gc_b + (lg + (unsigned)(((ai * 2 + bj) * 2 + m2) * 1024)));
#pragma unroll
        for (int ai = 0; ai < 2; ++ai)
#pragma unroll
            for (int m = 0; m < 4; ++m)
#pragma unroll
                for (int bj = 0; bj < 2; ++bj) { float c8[8]; const u32x4 gc4 = gc[ai][bj][m >> 1]; un8((m & 1) ? (u32x2){gc4.z, gc4.w} : (u32x2){gc4.x, gc4.y}, c8); float v[8];
#pragma unroll
                    for (int k = 0; k < 8; ++k) v[k] = (k < 4 ? acc[ai][bj][m][0][k] : acc[ai][bj][m][1][k - 4]) * (fmaxf(c8[k], 2.4318695068359375e-04f) * (1.0f / 255.0f));
                    *(u32x4*)(ob + (lt + (unsigned)((ai * HALF + m * 16) * 1024 + bj * 32))) = pack8(v); }
    }
};
struct EpiRes {
    static constexpr bool PERM = true, HAS_MID = false, HAS_PRE = false, WIDE = true; struct Pre {};
    bf16_t* XO; const float* rrs; const LAS float* igl;
    __device__ __forceinline__ void operator()(const Acc& acc, const Unit& u, int wr, int wc, int fr, int fq) const {
        bf16_t* xb = XO + (size_t)u.pm * BM * D + u.pn * BM; const float* rb = rrs + u.pm * BM;
        unsigned l0 = (unsigned)((wr * 64 + fr) * D + wc * 64 + 8 * fq); int r0 = wr * 64 + fr; asm volatile("" : "+v"(l0), "+v"(r0));
        u32x4 xv[2][4][2]; float rr[2][4];
#pragma unroll
        for (int ai = 0; ai < 2; ++ai)
#pragma unroll
            for (int m = 0; m < 4; ++m) { rr[ai][m] = rb[(unsigned)(r0 + ai * HALF + m * 16)];
#pragma unroll
                for (int bj = 0; bj < 2; ++bj) xv[ai][m][bj] = __builtin_nontemporal_load((const u32x4*)(xb + (l0 + (unsigned)((ai * HALF + m * 16) * D + bj * 32)))); }
        asm volatile("" ::: "memory");
#pragma unroll
        for (int bj = 0; bj < 2; ++bj) { const LAS float* ip = igl + u.pn * BM + wc * 64 + 8 * fq + bj * 32; const f32x4 ia = *(const LAS f32x4*)ip, ib = *(const LAS f32x4*)(ip + 4);
            const float ig[8] = {ia.x, ia.y, ia.z, ia.w, ib.x, ib.y, ib.z, ib.w};
#pragma unroll
            for (int ai = 0; ai < 2; ++ai)
#pragma unroll
                for (int m = 0; m < 4; ++m) { float xn[8], v[8]; unpack8(xv[ai][m][bj], xn);
#pragma unroll
                    for (int k = 0; k < 8; ++k) v[k] = xn[k] * rr[ai][m] * ig[k] + (k < 4 ? acc[ai][bj][m][0][k] : acc[ai][bj][m][1][k - 4]);
                    *(u32x4*)(xb + (l0 + (unsigned)((ai * HALF + m * 16) * D + bj * 32))) = pack8(v); } }
    }
};
struct EpiGU {
    static constexpr bool PERM = true, HAS_MID = false, HAS_PRE = true, WIDE = false; struct Pre {};
    unsigned char* HID; const f32x2* rsg; const LAS int* mtpre; LAS unsigned char* meta;
    __device__ __forceinline__ void pre(Pre&, const Unit& u, int wave, int lane) const {
        const int mt = u.pm - mtpre[u.z]; const unsigned pb = (unsigned)__builtin_amdgcn_readfirstlane((int)((unsigned)u.z * CAP + mt * 256));
        const __amdgpu_buffer_rsrc_t rs = __builtin_amdgcn_make_buffer_rsrc(const_cast<f32x2*>(rsg), 0, 0xffffffff, 0x00020000);
        const int wr = wave >> 2;
        unsigned vo = (unsigned)(wr * 64 + (lane >> 2) + 16 * (lane & 3)) * 8u + 4u; asm volatile("" : "+v"(vo));
#pragma unroll
        for (int ai = 0; ai < 2; ++ai) __builtin_amdgcn_raw_ptr_buffer_load_lds(rs, (LAS void*)(meta + wave * 512 + ai * 256), 4, (int)(vo + (unsigned)(ai * HALF * 8)), (int)(pb * 8u), 0, 0);
    }
    __device__ __forceinline__ void operator()(const Acc& acc, const Unit& u, int wr, int wc, int fr, int fq, const Pre&) const {
        unsigned char* hb = HID + (size_t)u.pm * 256 * 256 + u.pn * 128;
        int r0 = wr * 64 + fr; asm volatile("" : "+v"(r0)); const unsigned l0 = (unsigned)(r0 * 256 + wc * 32 + 8 * fq);
#pragma unroll
        for (int ai = 0; ai < 2; ++ai) { const f32x4 r4 = *(const LAS f32x4*)(meta + (wr * 4 + wc) * 512 + ai * 256 + fr * 16);
#pragma unroll
            for (int m = 0; m < 4; ++m) { const int r = r0 + ai * HALF + m * 16; const bool ok = r < u.valid;
                const float rs = (ok ? r4[m] : 1.f) * 0.03125f, c1 = -1.4426950408889634f * rs; const float ir = __builtin_amdgcn_rcpf(rs), kinv = 0.0625f * ir * ir;
                const f32x4 ag0 = acc[ai][0][m][0], ag1 = acc[ai][0][m][1], au0 = acc[ai][1][m][0], au1 = acc[ai][1][m][1];
                const f32x4 t0 = ag0 * c1, t1 = ag1 * c1; f32x4 e0, e1, y0, y1;
#pragma unroll
                for (int k = 0; k < 4; ++k) { e0[k] = __builtin_amdgcn_exp2f(t0[k]); e1[k] = __builtin_amdgcn_exp2f(t1[k]); }
                const f32x4 d0 = e0 * kinv + kinv, d1 = e1 * kinv + kinv;
#pragma unroll
                for (int k = 0; k < 4; ++k) { y0[k] = __builtin_amdgcn_rcpf(d0[k]); y1[k] = __builtin_amdgcn_rcpf(d1[k]); }
                const f32x4 h0 = ag0 * au0 * y0, h1 = ag1 * au1 * y1;
                u32x2 w; w.x = pk4_fp8(h0[0], h0[1], h0[2], h0[3]); w.y = pk4_fp8(h1[0], h1[1], h1[2], h1[3]);
                w.x = ok ? w.x : 0u; w.y = ok ? w.y : 0u;
                *(u32x2*)(hb + (l0 + (unsigned)((ai * HALF + m * 16) * 256))) = w; } }
    }
};
struct EpiDown {
    static constexpr bool PERM = true, HAS_MID = false, HAS_PRE = true, WIDE = true; struct Pre {};
    unsigned char* Y; const int* asg; const f32x2* rsg; const LAS int* mtpre; LAS unsigned char* meta;
    __device__ __forceinline__ void pre(Pre&, const Unit& u, int wave, int lane) const {
        const int mt = u.pm - mtpre[u.z]; const unsigned pb = (unsigned)__builtin_amdgcn_readfirstlane((int)((unsigned)u.z * CAP + mt * 256)); const int wr = wave >> 2;
        const __amdgpu_buffer_rsrc_t rsa = __builtin_amdgcn_make_buffer_rsrc(const_cast<int*>(asg), 0, 0xffffffff, 0x00020000), rsr = __builtin_amdgcn_make_buffer_rsrc(const_cast<f32x2*>(rsg), 0, 0xffffffff, 0x00020000);
        unsigned row = (unsigned)(wr * 64 + (lane >> 2) + 16 * (lane & 3)); asm volatile("" : "+v"(row));
#pragma unroll
        for (int ai = 0; ai < 2; ++ai) {
            __builtin_amdgcn_raw_ptr_buffer_load_lds(rsa, (LAS void*)(meta + wave * 1024 + ai * 256), 4, (int)((row + (unsigned)(ai * HALF)) * 4u), (int)(pb * 4u), 0, 0);
            __builtin_amdgcn_raw_ptr_buffer_load_lds(rsr, (LAS void*)(meta + wave * 1024 + 512 + ai * 256), 4, (int)((row + (unsigned)(ai * HALF)) * 8u), (int)(pb * 8u), 0, 0); }
    }
    __device__ __forceinline__ void operator()(const Acc& acc, const Unit& u, int wr, int wc, int fr, int fq, const Pre&) const {
        unsigned char* yb = Y + u.pn * BM;
        int r0 = wr * 64 + fr; unsigned c0 = (unsigned)(wc * 64 + 8 * fq); asm volatile("" : "+v"(r0), "+v"(c0));
#pragma unroll
        for (int ai = 0; ai < 2; ++ai) { const LAS unsigned char* mb = meta + (wr * 4 + wc) * 1024 + ai * 256 + fr * 16;
            const u32x4 a4 = *(const LAS u32x4*)mb; const f32x4 g4 = *(const LAS f32x4*)(mb + 512);
#pragma unroll
            for (int m = 0; m < 4; ++m) { const int r = r0 + ai * HALF + m * 16;
                if (r < u.valid) { const float gt = g4[m] * (16.0f / (16.0f * 32.0f));
#pragma unroll
                    for (int bj = 0; bj < 2; ++bj) { const f32x4 v0 = acc[ai][bj][m][0] * gt, v1 = acc[ai][bj][m][1] * gt;
                        u32x2 w; w.x = pk4_fp8(v0[0], v0[1], v0[2], v0[3]); w.y = pk4_fp8(v1[0], v1[1], v1[2], v1[3]);
                        *(u32x2*)(yb + (a4[m] * 1024u + c0 + (unsigned)(bj * 32))) = w; } } } }
    }
};

typedef int v8i_t __attribute__((ext_vector_type(8)));
typedef int v4i_t __attribute__((ext_vector_type(4)));
__device__ __forceinline__ v8i_t cat8(bf16x8 a, bf16x8 b) { return __builtin_shufflevector(__builtin_bit_cast(v4i_t, a), __builtin_bit_cast(v4i_t, b), 0, 1, 2, 3, 4, 5, 6, 7); }
template <class Epi, class Sched, bool ALIGN_EPI, bool NOUNROLL = false, bool FP8 = false, int NF8 = 0, int NSR = 0>
__device__ __forceinline__ void gemm_phase(LAS unsigned char* lds, const int wave, const int K, const int lda, const int ldb, const Sched& S, const Epi& E, const int lda8 = 0, const int ldb8 = 0) {
    int lane = lane_id(); asm volatile("" : "+v"(lane));
    const int wid = wave, tid = wave * 64 + lane, wr = wid >> 2, wc = wid & 3, fr = lane & 15, fq = lane >> 4;
    const int nt = K / BK;
    int sR[2], sC[2]; unsigned voffB[2];
#pragma unroll
    for (int i = 0; i < 2; ++i) { int R, C; stage_rc(tid * 16 + i * 8192, R, C); sR[i] = R; sC[i] = C; const int Rb = !Epi::PERM ? R : Epi::WIDE ? ((R >> 5) * 64 + perm32(R & 31)) : ((R & ~31) + perm32(R & 31));
        voffB[i] = (unsigned)((Rb >> 4) * 16 * ldb + (C >> 5) * 512 + (Rb & 15) * 32 + (C & 31)) * 2u; asm volatile("" : "+v"(voffB[i])); }
    const unsigned kstep = (unsigned)(BK * 2); constexpr unsigned kstepB = 2048u;
    const unsigned dB = (unsigned)(!Epi::PERM ? 64 : Epi::WIDE ? 128 : 64) * ldb * 2;
    const unsigned hB = (unsigned)(Epi::WIDE ? 32 : HALF) * ldb * 2, hA = Sched::GATHER ? 0u : (unsigned)HALF * lda * 2;
    const void* baseA_; const void* baseB_; S.bases(baseA_, baseB_);
    const __amdgpu_buffer_rsrc_t rsA = __builtin_amdgcn_make_buffer_rsrc(const_cast<void*>(baseA_), 0, 0xffffffff, 0x00020000), rsB = __builtin_amdgcn_make_buffer_rsrc(const_cast<void*>(baseB_), 0, 0xffffffff, 0x00020000);
    unsigned voffB8[2] = {0u, 0u}, cv8[2] = {0u, 0u}; unsigned hA8 = 0u, hB8 = 0u, dB8 = 0u; __amdgpu_buffer_rsrc_t rsA8 = rsA, rsB8 = rsB;
    if constexpr (NF8 > 0) { const void* a8_; const void* b8_; S.bases8(a8_, b8_);
        rsA8 = __builtin_amdgcn_make_buffer_rsrc(const_cast<void*>(a8_), 0, 0xffffffff, 0x00020000); rsB8 = __builtin_amdgcn_make_buffer_rsrc(const_cast<void*>(b8_), 0, 0xffffffff, 0x00020000);
        hA8 = (unsigned)HALF * lda8 * 2; hB8 = (unsigned)(Epi::WIDE ? 32 : HALF) * ldb8 * 2; dB8 = (unsigned)(!Epi::PERM ? 64 : Epi::WIDE ? 128 : 64) * ldb8 * 2;
#pragma unroll
        for (int i = 0; i < 2; ++i) { const int Rb = !Epi::PERM ? sR[i] : Epi::WIDE ? ((sR[i] >> 5) * 64 + perm32(sR[i] & 31)) : ((sR[i] & ~31) + perm32(sR[i] & 31)); voffB8[i] = (unsigned)((Rb >> 4) * 16 * ldb8 + (sC[i] >> 5) * 512 + (Rb & 15) * 32 + (sC[i] & 31)) * 2u; cv8[i] = (unsigned)(sR[i] * lda8 + sC[i]) * 2u; } }
    const unsigned ldsw = (unsigned)wid * 1024u;
    LAS unsigned char* abase = lds + lds_byte(wr * 64 + fr, fq * 8); LAS unsigned char* bbase = lds + 65536 + lds_byte(wc * 32 + fr, fq * 8);
    asm volatile("" : "+v"(abase), "+v"(bbase));
#define PG8_SA(b, h) (((b) * 2 + (h)) * HTB)
#define PG8_SB(b, h) ((4 + (b) * 2 + (h)) * HTB)
#define PG8_STAGE(bufoff, rs, soff, v0, v1) do { \
        __builtin_amdgcn_raw_ptr_buffer_load_lds(rs, (LAS void*)(lds + (bufoff) + ldsw), 16, (int)(v0), (int)(soff), 0, 0); \
        __builtin_amdgcn_raw_ptr_buffer_load_lds(rs, (LAS void*)(lds + (bufoff) + ldsw + 8192), 16, (int)(v1), (int)(soff), 0, 0); } while (0)
#define PG8_STAGE2(bufoff, rs, soff, v0, d1) do { \
        __builtin_amdgcn_raw_ptr_buffer_load_lds(rs, (LAS void*)(lds + (bufoff) + ldsw), 16, (int)(v0), (int)(soff), 0, 0); \
        __builtin_amdgcn_raw_ptr_buffer_load_lds(rs, (LAS void*)(lds + (bufoff) + ldsw + 8192), 16, (int)(v0), (int)((soff) + (d1)), 0, 0); } while (0)
#define PG8_STB(bufoff, k, nx, h) do { if (NF8 > 0 && (k) < NF8) PG8_STAGE2(bufoff, rsB8, ((nx) ? nB8 : cB8) + (unsigned)(k) * kstepB + (h) * hB8, voffB8[0], dB8); \
        else PG8_STAGE2(bufoff, rsB, ((nx) ? nB : cB) + (unsigned)((k) - NF8) * kstepB + (h) * hB, voffB[0], dB); } while (0)
#define PG8_STA(bufoff, k, nx, h) do { if (NF8 > 0 && (k) < NF8) PG8_STAGE(bufoff, rsA8, ((nx) ? nA8 : cA8) + (unsigned)(k) * kstep + (h) * hA8, cv8[0], cv8[1]); \
        else PG8_STAGE(bufoff, rsA, ((nx) ? nA : cA) + (unsigned)((k) - NF8) * kstep + (h) * hA, cv[Sched::GATHER ? (h) : 0][0], cv[Sched::GATHER ? (h) : 0][1]); } while (0)
#define PG8_LD1(base, off) (*(const LAS bf16x8*)((base) + (off)))
#define PG8_LDA(dst, b, h) do { _Pragma("unroll") for (int m = 0; m < 4; ++m) dst[m] = cat8(PG8_LD1(abase, PG8_SA(b, h) + m * 2048), PG8_LD1(abase, PG8_SA(b, h) + m * 2048 + 1024)); } while (0)
#define PG8_LDB(dst, b, h) do { _Pragma("unroll") for (int n = 0; n < 2; ++n) dst[n] = cat8(PG8_LD1(bbase, PG8_SB(b, h) - 65536 + n * 2048), PG8_LD1(bbase, PG8_SB(b, h) - 65536 + n * 2048 + 1024)); } while (0)
#define PG8_HALF(v, k) __builtin_bit_cast(bf16x8, __builtin_shufflevector(v, v, 4 * (k), 4 * (k) + 1, 4 * (k) + 2, 4 * (k) + 3))
#define PG8_MMA(F8, ai, bj, At, Bt) do { __builtin_amdgcn_s_setprio(1); _Pragma("unroll") for (int m = 0; m < 4; ++m) _Pragma("unroll") for (int n = 0; n < 2; ++n) { \
        if constexpr (F8) acc[ai][bj][m][n] = __builtin_amdgcn_mfma_scale_f32_16x16x128_f8f6f4(Bt[n], At[m], acc[ai][bj][m][n], 0, 0, 0, 0, 0, 0); \
        else { acc[ai][bj][m][n] = __builtin_amdgcn_mfma_f32_16x16x32_bf16(PG8_HALF(Bt[n], 0), PG8_HALF(At[m], 0), acc[ai][bj][m][n], 0, 0, 0); \
               acc[ai][bj][m][n] = __builtin_amdgcn_mfma_f32_16x16x32_bf16(PG8_HALF(Bt[n], 1), PG8_HALF(At[m], 1), acc[ai][bj][m][n], 0, 0, 0); } } __builtin_amdgcn_s_setprio(0); } while (0)
#define PG8_WAIT_V(n) asm volatile("s_waitcnt vmcnt(" #n ")" ::: "memory")
#define PG8_WAIT_L(n) asm volatile("s_waitcnt lgkmcnt(" #n ")" ::: "memory")
#define PG8_WAIT_VR do { if (NSR > 0 && relax) { if constexpr (NSR >= 16) asm volatile("s_waitcnt vmcnt(24)" ::: "memory"); else asm volatile("s_waitcnt vmcnt(16)" ::: "memory"); } else PG8_WAIT_V(8); } while (0)
#define PG8_BAR __builtin_amdgcn_s_barrier()
#define PG8_SCHED __builtin_amdgcn_sched_barrier(0)
#define PG8_TRIP(F8) do { \
        PG8_LDB(B0, 0, 0); PG8_LDB(B1, 0, 1); PG8_SCHED; PG8_LDA(At, 0, 0); PG8_STA(PG8_SA(1, 1), k1, false, 1); \
        if (Sched::GATHER) { if (last && has_next) { cv[1][0] = nv[1][0]; cv[1][1] = nv[1][1]; } } \
        PG8_WAIT_VR; PG8_WAIT_L(0); PG8_BAR; PG8_MMA(F8, 0, 0, At, B0); PG8_MMA(F8, 0, 1, At, B1); PG8_BAR; PG8_SCHED; \
        PG8_LDA(At, 0, 1); PG8_STB(PG8_SB(0, 0), k2, last, 0); PG8_STB(PG8_SB(0, 1), k2, last, 1); PG8_STA(PG8_SA(0, 0), k2, last, 0); \
        PG8_WAIT_VR; PG8_WAIT_L(0); PG8_BAR; PG8_MMA(F8, 1, 0, At, B0); PG8_MMA(F8, 1, 1, At, B1); PG8_BAR; PG8_SCHED; \
        PG8_LDB(B0, 1, 0); PG8_LDB(B1, 1, 1); PG8_SCHED; PG8_LDA(At, 1, 0); PG8_STA(PG8_SA(0, 1), k2, last, 1); \
        PG8_WAIT_V(8); PG8_WAIT_L(0); PG8_BAR; PG8_MMA(F8, 0, 0, At, B0); PG8_MMA(F8, 0, 1, At, B1); PG8_BAR; PG8_SCHED; \
        PG8_LDA(At, 1, 1); PG8_STB(PG8_SB(1, 0), k3, last, 0); PG8_STB(PG8_SB(1, 1), k3, last, 1); PG8_STA(PG8_SA(1, 0), k3, last, 0); \
        PG8_WAIT_V(8); PG8_WAIT_L(0); PG8_BAR; PG8_MMA(F8, 1, 0, At, B0); PG8_MMA(F8, 1, 1, At, B1); PG8_BAR; PG8_SCHED; } while (0)
    Unit cur, nxt; int ui = 0;
    if (!S.next(0, cur)) return;
    Acc acc;
#pragma unroll
    for (int a = 0; a < 2; ++a)
#pragma unroll
        for (int b = 0; b < 2; ++b)
#pragma unroll
            for (int m = 0; m < 4; ++m)
#pragma unroll
                for (int n = 0; n < 2; ++n) acc[a][b][m][n] = (f32x4){0.f, 0.f, 0.f, 0.f};
    v8i_t At[4], B0[2], B1[2];
    unsigned cA, cB; S.offs(cur, cA, cB);
    unsigned cA8 = 0u, cB8 = 0u, nA8 = 0u, nB8 = 0u; if constexpr (NF8 > 0) S.offs8(cur, cA8, cB8);
    unsigned nA = cA, nB = cB; nA8 = cA8; nB8 = cB8;
    typename Epi::Pre pre; if constexpr (Epi::HAS_PRE) E.pre(pre, cur, wid, lane);
    unsigned cv[2][2];
    PG8_STB(PG8_SB(0, 0), 0, false, 0); PG8_STB(PG8_SB(0, 1), 0, false, 1); S.avoff(cur, sR, sC, cv); PG8_STA(PG8_SA(0, 0), 0, false, 0); PG8_STA(PG8_SA(0, 1), 0, false, 1);
    if (wr == 1) PG8_BAR;
    PG8_WAIT_V(2); PG8_BAR;
    PG8_STB(PG8_SB(1, 0), 1, false, 0); PG8_STA(PG8_SA(1, 0), 1, false, 0); PG8_STB(PG8_SB(1, 1), 1, false, 1);
    PG8_WAIT_V(6); PG8_BAR;
    for (;;) {
        const bool has_next = S.next(ui + 1, nxt);
        nA = cA; nB = cB; nA8 = cA8; nB8 = cB8;
        if (has_next) { S.offs(nxt, nA, nB); if constexpr (NF8 > 0) S.offs8(nxt, nA8, nB8); if constexpr (Sched::GATHER) S.prefetch_ids(nxt, wid, lane_id()); }
        if constexpr (NF8 > 0) {
            for (int t = 0; t < NF8; t += 2) { asm volatile("" : "+s"(t)); const bool last = false; const bool relax = (t == 0) && (ui > 0); unsigned nv[2][2]; const int k1 = t + 1, k2 = t + 2, k3 = t + 3; PG8_TRIP(true); }
            if constexpr (Epi::HAS_MID) { const int l2 = lane_id(); E.mid(acc, cur, wr, wc, l2 & 15, l2 >> 4); }
            for (int t = NF8; t < nt; t += 2) { asm volatile("" : "+s"(t)); const bool last = (t == nt - 2); const bool relax = false; unsigned nv[2][2]; const int k1 = t + 1, k2 = last ? 0 : t + 2, k3 = last ? 1 : t + 3; PG8_TRIP(false); }
        } else {
        for (int t = 0; t < nt; t += 2) {
            if constexpr (NOUNROLL) asm volatile("" : "+s"(t));
            const bool last = (t == nt - 2); const bool relax = (t == 0) && (ui > 0);
            if constexpr (Epi::HAS_MID) { if (t == (nt >> 1)) { const int l2 = lane_id(); E.mid(acc, cur, wr, wc, l2 & 15, l2 >> 4); } }
            unsigned nv[2][2];
            if constexpr (Sched::GATHER) { if (last && has_next) { int sR2[2], sC2[2]; int tid2 = wave * 64 + lane_id(); asm volatile("" : "+v"(tid2));
#pragma unroll
                for (int i = 0; i < 2; ++i) stage_rc(tid2 * 16 + i * 8192, sR2[i], sC2[i]);
                S.avoff_lds(nxt, sR2, sC2, nv); cv[0][0] = nv[0][0]; cv[0][1] = nv[0][1]; } }
            const int k1 = t + 1, k2 = last ? 0 : t + 2, k3 = last ? 1 : t + 3;
            PG8_TRIP(FP8);
        } }
        if constexpr (ALIGN_EPI) { if (wr == 0) PG8_BAR; }
        { const int l2 = lane_id(); if constexpr (Epi::HAS_PRE) E(acc, cur, wr, wc, l2 & 15, l2 >> 4, pre); else E(acc, cur, wr, wc, l2 & 15, l2 >> 4); }
        if (!has_next) break;
#pragma unroll
        for (int a = 0; a < 2; ++a)
#pragma unroll
            for (int b = 0; b < 2; ++b)
#pragma unroll
                for (int m = 0; m < 4; ++m)
#pragma unroll
                    for (int n = 0; n < 2; ++n) acc[a][b][m][n] = (f32x4){0.f, 0.f, 0.f, 0.f};
        cur = nxt; cA = nA; cB = nB; cA8 = nA8; cB8 = nB8; ++ui;
        if constexpr (Epi::HAS_PRE) E.pre(pre, cur, wid, lane_id());
        if constexpr (ALIGN_EPI) { if (wr == 1) PG8_BAR; }
    }
    PG8_WAIT_V(0);
    if constexpr (!ALIGN_EPI) { if (wr == 0) PG8_BAR; }
    PG8_BAR;
#undef PG8_SA
#undef PG8_SB
#undef PG8_STAGE
#undef PG8_STAGE2
#undef PG8_STA
#undef PG8_STB
#undef PG8_LD1
#undef PG8_HALF
#undef PG8_LDA
#undef PG8_LDB
#undef PG8_MMA
#undef PG8_TRIP
#undef PG8_WAIT_V
#undef PG8_WAIT_L
#undef PG8_WAIT_VR
#undef PG8_BAR
#undef PG8_SCHED
}
}

#ifndef MK_USE_CG
#define MK_USE_CG 0
#endif
#define XB_TMO      128
#define XB_XCNT(j)  (256  + 64 * (j))
#define XB_XSUB(j)  (1280 + 64 * (j))
#define XB_XGEN(j)  (2304 + 64 * (j))
#define XB_TOP      3328
#define XB_TOPGEN   3392
#define XCD_BAR_WORDS 3456
#define XB_SPIN_CAP (1u << 18)
__device__ __forceinline__ unsigned xb_ld(unsigned* p)              { return __hip_atomic_load(p, __ATOMIC_RELAXED, __HIP_MEMORY_SCOPE_AGENT); }
__device__ __forceinline__ unsigned xb_add(unsigned* p, unsigned v) { return __hip_atomic_fetch_add(p, v, __ATOMIC_RELAXED, __HIP_MEMORY_SCOPE_AGENT); }
__device__ __forceinline__ unsigned xb_xcc_id() { return (unsigned)__builtin_amdgcn_s_getreg((3 << 11) | 20) & 0xFu; }
#define XB_SPIN(cond, bar) do { unsigned _sp = 0; while (cond) { __builtin_amdgcn_s_sleep(1); \
    if ((++_sp & 255u) == 0u) { if (xb_ld(&(bar)[XB_TMO])) break; if (_sp > XB_SPIN_CAP) { atomicAdd(&(bar)[XB_TMO], 1u); break; } } } } while (0)
struct XcdBarrier { unsigned* bar; unsigned x; volatile LAS unsigned* st; int wave; };
__device__ __forceinline__ XcdBarrier xcd_barrier_post(unsigned* bar, volatile LAS unsigned* st, int wave) {
    XcdBarrier b; b.bar = bar; b.x = xb_xcc_id(); b.st = st; b.wave = wave;
    if (wave == 0 && lane_id() == 0) (void)xb_add(&bar[XB_XCNT(b.x)], 1u);
    return b;
}
__device__ __forceinline__ void xcd_barrier_complete(unsigned* bar, unsigned x, unsigned& nloc, unsigned& nx) {
    const unsigned G = gridDim.x * gridDim.y * gridDim.z;
    unsigned sum, cnt, mine, sp = 0u;
    for (;;) {
        sum = 0u; cnt = 0u; mine = 0u;
        unsigned c[16];
#pragma unroll
        for (unsigned j = 0; j < 16; ++j) c[j] = xb_ld(&bar[XB_XCNT(j)]);
        asm volatile("" : "+v"(c[0]), "+v"(c[1]), "+v"(c[2]), "+v"(c[3]), "+v"(c[4]), "+v"(c[5]), "+v"(c[6]), "+v"(c[7]), "+v"(c[8]), "+v"(c[9]), "+v"(c[10]), "+v"(c[11]), "+v"(c[12]), "+v"(c[13]), "+v"(c[14]), "+v"(c[15]));
#pragma unroll
        for (unsigned j = 0; j < 16; ++j) { sum += c[j]; cnt += (c[j] > 0u) ? 1u : 0u; mine = (j == x) ? c[j] : mine; }
        if (sum == G) break;
        __builtin_amdgcn_s_sleep(1);
        if ((++sp & 255u) == 0u) { if (xb_ld(&bar[XB_TMO])) break; if (sp > XB_SPIN_CAP) { atomicAdd(&bar[XB_TMO], 1u); break; } }
    }
    nloc = mine > 0u ? mine : 1u; nx = cnt > 0u ? cnt : 1u;
}
__device__ __forceinline__ void xcd_barrier(const XcdBarrier& b) {
    asm volatile("s_waitcnt vmcnt(0)" ::: "memory");
    __syncthreads();
    if (b.wave == 0 && lane_id() == 0) {
        unsigned* bar = b.bar;
        __builtin_amdgcn_s_waitcnt(0);
        unsigned nloc = b.st[0], nx = b.st[1];
        if (nloc == 0u) { xcd_barrier_complete(bar, b.x, nloc, nx); b.st[0] = nloc; b.st[1] = nx; }
        const unsigned old = xb_add(&bar[XB_XSUB(b.x)], 1u);
        const unsigned gen = old / nloc;
        if (old + 1u == (gen + 1u) * nloc) {
            __builtin_amdgcn_fence(__ATOMIC_RELEASE, "agent");
            asm volatile("s_waitcnt vmcnt(0)" ::: "memory");
            const unsigned og = xb_add(&bar[XB_TOP], 1u);
            const unsigned tg = og / nx;
            if (og + 1u == (tg + 1u) * nx) xb_add(&bar[XB_TOPGEN], 1u);
            else XB_SPIN(xb_ld(&bar[XB_TOPGEN]) == tg, bar);
            __builtin_amdgcn_fence(__ATOMIC_ACQUIRE, "agent");
            xb_add(&bar[XB_XGEN(b.x)], 1u);
            asm volatile("s_waitcnt vmcnt(0)" ::: "memory");
        } else {
            XB_SPIN(xb_ld(&bar[XB_XGEN(b.x)]) == gen, bar);
            __builtin_amdgcn_fence(__ATOMIC_ACQUIRE, "agent");
            asm volatile("s_waitcnt vmcnt(0)" ::: "memory");
        }
    }
    __syncthreads();
}

struct Args {
    const float* in[19]; float* out; unsigned char* ws; int ph_lo, ph_hi; int rep[10];
};
struct Frame {
    LAS unsigned char* lds; int tid, lane, wave, G, vcu;
};

__device__ __forceinline__ void tr_item(const float* W, int ldw, int k0, int n0, bf16_t* WT, int ldt, int drow0, LAS float* scr, int lane) {
    float tv[32];
#pragma unroll
    for (int i = 0; i < 32; ++i) { const int kk = 2 * i + (lane >> 5); tv[i] = __builtin_nontemporal_load(W + (size_t)(k0 + kk) * ldw + n0 + (lane & 31)); }
#pragma unroll
    for (int i = 0; i < 32; ++i) { const int kk = 2 * i + (lane >> 5); scr[kk * 33 + (lane & 31)] = tv[i]; }
    LDS_WAIT(); asm volatile("" ::: "memory");
    const int c = lane & 7;
#pragma unroll
    for (int j = 0; j < 4; ++j) { const int n = (lane >> 3) + 8 * j; const LAS float* s = scr + (8 * c) * 33 + n;
        u32x4 o; o.x = cvtpk(s[0 * 33], s[1 * 33]); o.y = cvtpk(s[2 * 33], s[3 * 33]); o.z = cvtpk(s[4 * 33], s[5 * 33]); o.w = cvtpk(s[6 * 33], s[7 * 33]);
        const int row = drow0 + n, col = k0 + 8 * c; *(u32x4*)(WT + ((size_t)(row >> 4) * 16 * ldt + (col >> 5) * 512 + (row & 15) * 32 + (col & 31))) = o; }
    LDS_WAIT(); asm volatile("" ::: "memory");
}
__device__ __forceinline__ void tr_item8(const float* W, int ldw, int k0, int n0, unsigned char* WT, int ldt, int drow0, float scale, LAS float* scr, int lane) {
    float tv[32];
#pragma unroll
    for (int i = 0; i < 32; ++i) { const int kk = 2 * i + (lane >> 5); tv[i] = __builtin_nontemporal_load(W + (size_t)(k0 + kk) * ldw + n0 + (lane & 31)); }
#pragma unroll
    for (int i = 0; i < 32; ++i) { const int kk = 2 * i + (lane >> 5); scr[kk * 33 + (lane & 31)] = tv[i] * scale; }
    LDS_WAIT(); asm volatile("" ::: "memory");
    const int c = lane & 7;
#pragma unroll
    for (int j = 0; j < 4; ++j) { const int n = (lane >> 3) + 8 * j; const LAS float* s = scr + (8 * c) * 33 + n;
        u32x2 o; o.x = pk4_fp8(s[0 * 33], s[1 * 33], s[2 * 33], s[3 * 33]); o.y = pk4_fp8(s[4 * 33], s[5 * 33], s[6 * 33], s[7 * 33]);
        const int row = drow0 + n, col = k0 + 8 * c; *(u32x2*)(WT + ((size_t)(row >> 4) * 16 * ldt + (col >> 6) * 1024 + (row & 15) * 64 + (col & 63))) = o; }
    LDS_WAIT(); asm volatile("" ::: "memory");
}
constexpr int I_IN = 16 * 136, I_A = 8 * 32, I_OUT = 16 * 32, I_G = 32 * 128, I_D = 32 * 128;
constexpr int I_SMALL = I_IN + 2 * I_A + I_OUT, NITEMS = I_SMALL + 2 * I_G + I_D;
__device__ __forceinline__ void convert_items(const Frame& F, const Args& a, int first, int last, int worker, int nworkers) {
    unsigned char* ws = a.ws;
    LAS float* scr = (LAS float*)(F.lds + F.wave * 16384);
    const float* w_in = a.in[2]; const float* w_a = a.in[8]; const float* w_c = a.in[9]; const float* w_out = a.in[10];
    const float* w_gate = a.in[16]; const float* w_up = a.in[17]; const float* w_down = a.in[18];
    bf16_t* WinT = (bf16_t*)(ws + WS_WIN); bf16_t* WaT = (bf16_t*)(ws + WS_WA); bf16_t* WoutT = (bf16_t*)(ws + WS_WOUT);
    bf16_t* WguT = (bf16_t*)(ws + WS_WGU); bf16_t* WdT = (bf16_t*)(ws + WS_WD);
    for (int it = first + worker * NWAVES + F.wave; it < last; it += nworkers * NWAVES) {
        int r = it;
        if (r < I_IN) { const int kb = r / 136, nb = r % 136, n0 = 32 * nb;
            if (n0 >= C_CB && n0 < C_GA) { int drow = n0;
                if (n0 >= C_CC) { const int cx = n0 >= C_CX, ch = n0 - (cx ? C_CX : C_CC); drow = C_CC + (ch >> 7) * 256 + ((ch >> 5) & 3) * 64 + cx * 32 + (ch & 31); }
                tr_item(w_in, PW, 64 * kb, n0, WinT, 1024, drow, scr, F.lane); }
            else tr_item8(w_in, PW, 64 * kb, n0, ws + WS_WIN8, 1024, n0, WIN8_SCALE, scr, F.lane);
            continue; } r -= I_IN;
        if (r < I_A) { const int kb = r / 32, nb = r % 32; tr_item8(w_a, 1024, 64 * kb, 32 * nb, ws + WS_WA, 512, 32 * nb, 32.0f, scr, F.lane); continue; } r -= I_A;
        if (r < I_A) { const int kb = r / 32, nb = r % 32; tr_item(w_c, 1024, 64 * kb, 32 * nb, (bf16_t*)(ws + WS_WC), 512, 32 * nb, scr, F.lane); continue; } r -= I_A;
        if (r < I_OUT) { const int kb = r / 32, nb = r % 32; tr_item(w_out, 1024, 64 * kb, 32 * nb, WoutT, 1024, 32 * nb, scr, F.lane); continue; } r -= I_OUT;
        if (r < 2 * I_G) { const int up = r >= I_G; if (up) r -= I_G; const int e = r / 128, q = r % 128, kb = q / 8, nb = q % 8, n0 = 32 * nb;
            tr_item8((up ? w_up : w_gate) + (size_t)e * 1024 * 256, 256, 64 * kb, n0, (unsigned char*)WguT + (size_t)e * 512 * 1024, 1024, (n0 >> 7) * 256 + up * 128 + (n0 & 127), 32.0f, scr, F.lane); continue; } r -= 2 * I_G;
        { const int e = r / 128, q = r % 128, kb = q / 32, nb = q % 32; tr_item8(w_down + (size_t)e * 256 * 1024, 1024, 64 * kb, 32 * nb, (unsigned char*)WdT + (size_t)e * 1024 * 256, 256, 32 * nb, 32.0f, scr, F.lane); }
    }
}
__device__ __forceinline__ void p0_prologue(const Frame& F, const Args& a) {
    unsigned char* ws = a.ws;
    const int gw = F.vcu * NWAVES + F.wave, NGW = F.G * NWAVES;
    const int gt = F.vcu * NTHREADS + F.tid, NGT = F.G * NTHREADS;
    { const float* w_rg = a.in[12]; const float* w_re = a.in[14]; bf16_t* WrT = (bf16_t*)(ws + WS_WR);
      for (int i = gt; i < 48 * 1024; i += NGT) { const int j = i >> 10, k = i & 1023; float v = 0.f; if (j < 4) v = w_rg[k * 4 + j]; else if (j < 36) v = w_re[k * 32 + (j - 4)]; WrT[i] = f2bf(v); } }
    { float* cosT = (float*)(ws + WS_ROPE); float* sinT = cosT + SEQ * 8;
      for (int i = F.vcu + F.G * F.tid; i < SEQ * 8; i += F.G * NTHREADS) { const int pos = i >> 3, j = i & 7; const float inv = exp2f(-(float)j * (0.125f * 18.931568569324174f));
          const float ang = (float)pos * inv; float sn, cs; sincosf(ang, &sn, &cs); cosT[i] = cs; sinT[i] = sn; } }
    { const float* x = a.in[0]; const float* g1 = a.in[1]; bf16_t* XN = (bf16_t*)(ws + WS_XN);
      f32x4 gv[4];
#pragma unroll
      for (int j = 0; j < 4; ++j) gv[j] = ((const f32x4*)g1)[F.lane + 64 * j];
      int cit = 0;
      for (int m0 = gw; m0 < M; m0 += 8 * NGW) { f32x4 v[8][4];
#pragma unroll
          for (int q = 0; q < 8; ++q) { const int m = m0 + q * NGW; const f32x4* xr = (const f32x4*)(x + (size_t)(m < M ? m : 0) * D) + F.lane;
#pragma unroll
              for (int j = 0; j < 4; ++j) v[q][j] = __builtin_nontemporal_load(xr + 64 * j); }
          { const int first = cit * NGW; if (first < I_SMALL) convert_items(F, a, first, (first + NGW < I_SMALL) ? first + NGW : I_SMALL, F.vcu, F.G); ++cit; }
#pragma unroll
          for (int q = 0; q < 8; ++q) { const int m = m0 + q * NGW; float s = 0.f;
#pragma unroll
              for (int j = 0; j < 4; ++j) s += (v[q][j].x * v[q][j].x + v[q][j].y * v[q][j].y) + (v[q][j].z * v[q][j].z + v[q][j].w * v[q][j].w);
              const float rstd = rsqrtf(wave_sum(s) * (1.f / D) + EPS);
              if (m < M && F.lane == 0) ((float*)(ws + WS_RRS))[m] = 1.0f / rstd;
              if (m < M) { u32x2* o8 = (u32x2*)(XN + (size_t)m * D) + F.lane;
#pragma unroll
                  for (int j = 0; j < 4; ++j) { const float h0 = v[q][j].x * rstd * gv[j].x, h1 = v[q][j].y * rstd * gv[j].y, h2 = v[q][j].z * rstd * gv[j].z, h3 = v[q][j].w * rstd * gv[j].w;
                      u32x2 w; w.x = cvtpk(h0, h1); w.y = cvtpk(h2, h3); o8[64 * j] = w;
                      ((unsigned*)(ws + WS_XN8 + (size_t)m * D))[F.lane + 64 * j] = pk4_fp8(h0, h1, h2, h3); } } } }
      for (int first = cit * NGW; first < I_SMALL; first += NGW) convert_items(F, a, first, (first + NGW < I_SMALL) ? first + NGW : I_SMALL, F.vcu, F.G); }
}

namespace att {
constexpr int NSLOT = 8, WSOFF = RING_BYTES + 1024, OSTOFF = WSOFF + 2048, CWOFF = OSTOFF + 8 * 2048, QGOFF = CWOFF + 8192;
static_assert(QGOFF + 256 <= LDS_BYTES, "attention LDS map");
__device__ __forceinline__ int crow(int r, int hi) { return (r & 3) + 8 * (r >> 2) + 4 * hi; }
__device__ __forceinline__ s16x4 vtr(const LAS char* p) { return __builtin_bit_cast(s16x4, __builtin_amdgcn_ds_read_tr16_b64_v4i16((LAS s16x4*)p)); }
}
template <int CTRL> __device__ __forceinline__ float dpp_f(float x) { return __builtin_bit_cast(float, __builtin_amdgcn_mov_dpp(__builtin_bit_cast(int, x), CTRL, 0xF, 0xF, true)); }
__device__ __forceinline__ u32x4 k_norm_rope(const u32x4 raw, const float (&g)[8], float cl, float sl, int l7, int lane) {
    float v[8]; unpack8(raw, v); float ss = 0.f;
#pragma unroll
    for (int i = 0; i < 8; ++i) ss += v[i] * v[i];
    ss += dpp_f<0xB1>(ss); ss += dpp_f<0x4E>(ss); ss += dpp_f<0x141>(ss);
    const float rstd = rsqrtf(ss * (1.f / 64.f) + EPS);
    const float sgn = (l7 == 0) ? -1.f : 1.f; const bool rot = l7 < 2;
#pragma unroll
    for (int i = 0; i < 8; ++i) { const float y = v[i] * rstd * g[i]; const float p = dpp_f<0xB1>(y); const float c = __shfl(cl, (lane & ~7) + i), sn = __shfl(sl, (lane & ~7) + i);
        const float yr = __builtin_fmaf(sgn * p, sn, y * c);
        v[i] = rot ? yr : y; }
    return pack8(v);
}
template <int M0, int M1>
__device__ __forceinline__ void att_tile(const LAS char* tile, const bf16x8 (&qr)[4], const f32x16& cinit, const int tm, const int lane, const int hi, const int r32, f32x16& o0, f32x16& o1, float& lsum) {
    const LAS char* kb = tile + hi * 1024 + r32 * 16;
    f32x16 p0 = cinit, p1 = cinit;
#pragma unroll
    for (int d0 = 0; d0 < 4; ++d0) {
        if (M0) { const bf16x8 b0 = *(const LAS bf16x8*)(kb + d0 * 2048); p0 = __builtin_amdgcn_mfma_f32_32x32x16_bf16(b0, qr[d0], p0, 0, 0, 0); }
        if (M1) { const bf16x8 b1 = *(const LAS bf16x8*)(kb + d0 * 2048 + 512); p1 = __builtin_amdgcn_mfma_f32_32x32x16_bf16(b1, qr[d0], p1, 0, 0, 0); } }
#pragma unroll
    for (int r = 0; r < 16; ++r) { const int cr = (r & 3) + 8 * (r >> 2);
        if (M0) { float e = __builtin_amdgcn_exp2f(p0[r]); if (M0 == 2) e = (cr >= tm) ? e : 0.f; if (M0 == 3) e = (cr <= tm) ? e : 0.f; p0[r] = e; lsum += e; }
        if (M1) { float e = __builtin_amdgcn_exp2f(p1[r]); if (M1 == 2) e = (cr >= tm) ? e : 0.f; if (M1 == 3) e = (cr <= tm) ? e : 0.f; p1[r] = e; lsum += e; } }
    const LAS char* vp = tile + 8192 + ((lane >> 4) & 1) * 32 + (lane & 3) * 8 + (4 * hi + ((lane & 15) >> 2)) * 64;
#pragma unroll
    for (int ks = 0; ks < 4; ++ks) {
        if ((ks < 2 && !M0) || (ks >= 2 && !M1)) continue;
        const f32x16& pp = ks < 2 ? p0 : p1; const int b = (ks & 1) * 8;
        const u32x4 pw = (u32x4){cvtpk(pp[b + 0], pp[b + 1]), cvtpk(pp[b + 2], pp[b + 3]), cvtpk(pp[b + 4], pp[b + 5]), cvtpk(pp[b + 6], pp[b + 7])};
#pragma unroll
        for (int dh = 0; dh < 2; ++dh) { const s16x4 lo = att::vtr(vp + dh * 4096 + ks * 1024), hh = att::vtr(vp + dh * 4096 + ks * 1024 + 512);
            const bf16x8 vf = (bf16x8){lo[0], lo[1], lo[2], lo[3], hh[0], hh[1], hh[2], hh[3]};
            if (dh == 0) o0 = __builtin_amdgcn_mfma_f32_32x32x16_bf16(vf, __builtin_bit_cast(bf16x8, pw), o0, 0, 0, 0);
            else o1 = __builtin_amdgcn_mfma_f32_32x32x16_bf16(vf, __builtin_bit_cast(bf16x8, pw), o1, 0, 0, 0); } }
}
struct QRaw { u32x4 raw[4]; f32x4 cs[4]; };
__device__ __forceinline__ void q_load(QRaw& q, const bf16_t* qbase  , unsigned loff, const float* cosb  , unsigned r32) {
#pragma unroll
    for (int d0 = 0; d0 < 4; ++d0) q.raw[d0] = *(const u32x4*)(qbase + (loff + (unsigned)(d0 * 16)));
    q.cs[0] = *(const f32x4*)(cosb + r32 * 8u); q.cs[1] = *(const f32x4*)(cosb + r32 * 8u + 4u); q.cs[2] = *(const f32x4*)(cosb + (unsigned)(SEQ * 8) + r32 * 8u); q.cs[3] = *(const f32x4*)(cosb + (unsigned)(SEQ * 8) + r32 * 8u + 4u);
}
__device__ __forceinline__ void p3_attention(const Frame& F, const Args& a) {
    using namespace att;
    unsigned char* ws = a.ws;
    const bf16_t* PROJ = (const bf16_t*)(ws + WS_PROJ); bf16_t* AC = (bf16_t*)(ws + WS_AC);
    const float* cosT = (const float*)(ws + WS_ROPE); const float* sinT = cosT + SEQ * 8;
    const float* qg = a.in[3]; const float* kg = a.in[4]; const float* sink = a.in[5]; const float* conv_w = a.in[6]; const float* conv_b = a.in[7];
    const int lane0 = F.lane, wid = F.wave;
    float qgl = qg[lane0], kgl = kg[lane0]; f32x4 cw4 = (F.tid < 384) ? ((const f32x4*)conv_w)[F.tid] : ((const f32x4*)conv_b)[F.tid - 384]; f32x4 qg4 = ((const f32x4*)qg)[F.tid & 15];
    asm volatile("" : "+v"(qgl), "+v"(kgl), "+v"(cw4), "+v"(qg4));
    const float bound = 8.0f * wave_max(fabsf(qgl)) * wave_max(fabsf(kgl)) * 1.4426950408889634f * 1.0001f;
    LAS char* lds = (LAS char*)F.lds; LAS float* wsf = (LAS float*)(lds + WSOFF) + wid * 64;
    const int g = wid >> 1, qsub = wid & 1;
    { const int t = F.tid; *(LAS f32x4*)(lds + CWOFF + t * 16) = cw4;
      if (t < 16) *(LAS f32x4*)(lds + QGOFF + t * 16) = qg4; }
    for (int su = F.vcu; su < NB * NKV * 16; su += F.G) {
        int lane = lane0; asm volatile("" : "+v"(lane));
        const int l7 = lane & 7;
        float gk8[8];
#pragma unroll
        for (int k = 0; k < 8; ++k) gk8[k] = kg[8 * l7 + k];
        const int n0 = (su & 15) * 4, hk = (su >> 4) & 1, b = su >> 5;
        const int h = hk * 4 + g; const float snk = sink[h] * 1.4426950408889634f; const float mref = fmaxf(bound, snk);
        f32x16 cinit;
#pragma unroll
        for (int r = 0; r < 16; ++r) cinit[r] = -mref;
        const size_t rowbase = (size_t)b * SEQ;
        const int ct0 = (su * NWAVES + wid) * 16;
        __syncthreads();
        const unsigned qloff = (unsigned)((lane & 31) * PWP + (lane >> 5) * 8);
        QRaw qn; q_load(qn, PROJ + (rowbase + n0 * 64 + qsub * 32) * PWP + C_Q + h * 64, qloff, cosT + (n0 * 64 + qsub * 32) * 8, (unsigned)(lane & 31));
        float up[8], uc[8];
        { u32x4 kraw[NSLOT], vraw[NSLOT]; float kcs[NSLOT][2];
#pragma unroll
          for (int sl = 0; sl < NSLOT; ++sl) { const int j = n0 - 2 + sl; const bool ok = (j >= 0 && j < 64); const int jj = ok ? j : n0;
              const bf16_t* kbase = PROJ + (rowbase + 64 * jj + 8 * wid) * PWP + C_K + hk * 64;
              const bf16_t* vbase = PROJ + (rowbase + 64 * jj + 16 * (wid & 3)) * PWP + C_V + hk * 64 + (wid >> 2) * 32;
              const float* tbase = cosT + (64 * jj + 8 * wid) * 8;
              kraw[sl] = *(const u32x4*)(kbase + (unsigned)((lane >> 3) * PWP + l7 * 8));
              kcs[sl][0] = tbase[(unsigned)lane]; kcs[sl][1] = tbase[(unsigned)(SEQ * 8 + lane)];
              vraw[sl] = *(const u32x4*)(vbase + (unsigned)((lane >> 2) * PWP + (lane & 3) * 8)); }
          const bool hp = (ct0 & (SEQ - 1)) > 0; const size_t tp = (size_t)(hp ? ct0 - 1 : ct0);
          const unsigned l8 = (unsigned)(8 * lane);
          const u32x4 pu = *(const u32x4*)(PROJ + tp * PWP + C_U + l8), cu = *(const u32x4*)(PROJ + (size_t)ct0 * PWP + C_U + l8);
#pragma unroll
          for (int sl = 0; sl < NSLOT; ++sl) { const int key = 8 * wid + (lane >> 3);
              const u32x4 kn = k_norm_rope(kraw[sl], gk8, kcs[sl][0], kcs[sl][1], l7, lane);
              *(LAS u32x4*)(lds + sl * 16384 + l7 * 1024 + key * 16) = kn;
              *(LAS u32x4*)(lds + sl * 16384 + 8192 + wid * 1024 + lane * 16) = vraw[sl]; }
          { float a8[8]; unpack8(pu, a8);
#pragma unroll
            for (int k = 0; k < 8; ++k) up[k] = hp ? a8[k] : 0.f;
            unpack8(cu, uc); } }
        __syncthreads();
#pragma unroll 1
        for (int uu = 0; uu < 4; ++uu) {
        int lane = lane0; asm volatile("" : "+v"(lane));
        const int r32 = lane & 31, hi = lane >> 5;
        const int n64 = n0 + uu;
        const int qs = n64 * 64 + qsub * 32;
        const int ctb = ct0 + 4 * uu;
        u32x4 rcu[4], rcb[4];
#pragma unroll
        for (int tk = 0; tk < 4; ++tk) { const int t = ctb + tk; const bool hn = ((t & (SEQ - 1)) < SEQ - 1); const size_t tn = (size_t)(hn ? t + 1 : t);
            const unsigned l8 = (unsigned)(8 * lane); rcu[tk] = *(const u32x4*)(PROJ + tn * PWP + C_U + l8); rcb[tk] = *(const u32x4*)(PROJ + (size_t)t * PWP + C_CB + l8); }
        QRaw qc = qn;
        if (uu < 3) q_load(qn, PROJ + (rowbase + qs + 64) * PWP + C_Q + h * 64, (unsigned)(r32 * PWP + hi * 8), cosT + (qs + 64) * 8, (unsigned)r32);
        bf16x8 qr[4];
        { float qv[4][8]; float ss = 0.f;
#pragma unroll
          for (int d0 = 0; d0 < 4; ++d0) unpack8(qc.raw[d0], qv[d0]);
#pragma unroll
          for (int d0 = 0; d0 < 4; ++d0)
#pragma unroll
              for (int k = 0; k < 8; ++k) ss += qv[d0][k] * qv[d0][k];
          ss += __shfl_xor(ss, 32);
          const float rstd = rsqrtf(ss * (1.f / 64.f) + EPS);
#pragma unroll
          for (int d0 = 0; d0 < 4; ++d0) { const f32x4 ga = *(const LAS f32x4*)(lds + QGOFF + (d0 * 16 + hi * 8) * 4), gb = *(const LAS f32x4*)(lds + QGOFF + (d0 * 16 + hi * 8 + 4) * 4); const float gg[8] = {ga.x, ga.y, ga.z, ga.w, gb.x, gb.y, gb.z, gb.w};
#pragma unroll
              for (int k = 0; k < 8; ++k) qv[d0][k] = qv[d0][k] * (rstd * QSCALE) * gg[k]; }
          const f32x4 c0 = qc.cs[0], c1 = qc.cs[1], s0 = qc.cs[2], s1 = qc.cs[3];
          const float cc[8] = {c0.x, c0.y, c0.z, c0.w, c1.x, c1.y, c1.z, c1.w}, sn[8] = {s0.x, s0.y, s0.z, s0.w, s1.x, s1.y, s1.z, s1.w};
#pragma unroll
          for (int k = 0; k < 8; ++k) { const float y = qv[0][k], p = __shfl_xor(y, 32); qv[0][k] = (hi == 0) ? (y * cc[k] - p * sn[k]) : (y * cc[k] + p * sn[k]); }
#pragma unroll
          for (int d0 = 0; d0 < 4; ++d0) qr[d0] = __builtin_bit_cast(bf16x8, pack8(qv[d0])); }
        asm volatile("" ::: "memory");
        f32x16 o0 = {}, o1 = {}; float lsum = 0.f;
        { const int tm = r32 - 4 * hi; const LAS char* t0 = lds + uu * 16384;
          if (n64 >= 2)  { if (qsub) att_tile<0, 2>(t0, qr, cinit, tm, lane, hi, r32, o0, o1, lsum); else att_tile<2, 1>(t0, qr, cinit, tm, lane, hi, r32, o0, o1, lsum); }
#pragma unroll 1
          for (int sl = 1; sl < 4; ++sl) { const int j = n64 - 2 + sl; if (j < 0 || j >= 64) continue; att_tile<1, 1>(t0 + sl * 16384, qr, cinit, tm, lane, hi, r32, o0, o1, lsum); }
          if (n64 < 62) { if (qsub) att_tile<1, 3>(t0 + 4 * 16384, qr, cinit, tm, lane, hi, r32, o0, o1, lsum); else att_tile<3, 0>(t0 + 4 * 16384, qr, cinit, tm, lane, hi, r32, o0, o1, lsum); } }
        lsum += __shfl_xor(lsum, 32); lsum += __builtin_amdgcn_exp2f(snk - mref);
        { const float rl16 = __builtin_amdgcn_rcpf(lsum) * 16.0f;
          unsigned char* Ow = ws + WS_ATT8 + (rowbase + qs) * 512 + h * 64;
#pragma unroll
          for (int dh = 0; dh < 2; ++dh) { unsigned w[4];
#pragma unroll
              for (int gq = 0; gq < 4; ++gq) { const float a0 = (dh ? o1[4 * gq] : o0[4 * gq]) * rl16, a1 = (dh ? o1[4 * gq + 1] : o0[4 * gq + 1]) * rl16, a2 = (dh ? o1[4 * gq + 2] : o0[4 * gq + 2]) * rl16, a3 = (dh ? o1[4 * gq + 3] : o0[4 * gq + 3]) * rl16;
                  w[gq] = pk4_fp8(a0, a1, a2, a3); }
              { const auto s01 = __builtin_amdgcn_permlane32_swap(w[0], w[1], false, false); w[0] = s01[0]; w[1] = s01[1]; }
              { const auto s23 = __builtin_amdgcn_permlane32_swap(w[2], w[3], false, false); w[2] = s23[0]; w[3] = s23[1]; }
              { const auto s02 = __builtin_amdgcn_permlane32_swap(w[0], w[2], false, false); w[0] = s02[0]; w[2] = s02[1]; }
              { const auto s13 = __builtin_amdgcn_permlane32_swap(w[1], w[3], false, false); w[1] = s13[0]; w[3] = s13[1]; }
              *(u32x4*)(Ow + (size_t)r32 * 512 + dh * 32 + hi * 16) = (u32x4){w[0], w[1], w[2], w[3]}; } }
        asm volatile("" ::: "memory");
        { float w0[8], w1[8], w2[8], bb[8];
#pragma unroll
          for (int k = 0; k < 8; ++k) { const LAS float* cw = (const LAS float*)(lds + CWOFF) + 8 * lane + k; w0[k] = cw[0]; w1[k] = cw[CD]; w2[k] = cw[2 * CD]; bb[k] = cw[3 * CD]; }
#pragma unroll
          for (int tk = 0; tk < 4; ++tk) { const int t = ctb + tk; const bool hn = ((t & (SEQ - 1)) < SEQ - 1);
              float a8[8], cbv[8], un[8], o[8]; unpack8(rcu[tk], a8); unpack8(rcb[tk], cbv);
#pragma unroll
              for (int k = 0; k < 8; ++k) { un[k] = hn ? a8[k] : 0.f; o[k] = cbv[k] * (up[k] * w0[k] + uc[k] * w1[k] + un[k] * w2[k] + bb[k]); up[k] = uc[k]; uc[k] = un[k]; }
              *(u32x4*)(AC + (size_t)t * 1024 + 512 + 8 * lane) = pack8(o); } }
        }
    }
    __syncthreads();
}

__device__ __forceinline__ void p6_route(const Frame& F, const Args& a) {
    unsigned char* ws = a.ws;
    const bf16_t* X1 = (const bf16_t*)(ws + WS_X1B); const float* g2 = a.in[11]; const float* b_rg = a.in[13]; const float* b_re = a.in[15];
    unsigned char* H2 = ws + WS_H2; const bf16_t* WrT = (const bf16_t*)(ws + WS_WR);
    int* asg = (int*)(ws + WS_ASG); f32x2* rsg = (f32x2*)(ws + WS_RSG); unsigned* gcnt = (unsigned*)(ws + WS_CTL) + CW_CNT;
    const int lane = F.lane, wid = F.wave, r = lane & 15, kg = lane >> 4;
    constexpr int WR_PITCH = 2064, WR_BYTES = 48 * WR_PITCH, G2_OFF = WR_BYTES, LG_OFF = G2_OFF + 4096;
    LAS unsigned char* wrl = F.lds; LAS float* g2l = (LAS float*)(F.lds + G2_OFF); LAS float* lg = (LAS float*)(F.lds + LG_OFF) + wid * (16 * 48);
    LAS int* hist = (LAS int*)(F.lds + LDSCTL_OFF + LC_HIST); LAS int* base = (LAS int*)(F.lds + LDSCTL_OFF + LC_BASE);
    { const __amdgpu_buffer_rsrc_t rsw = __builtin_amdgcn_make_buffer_rsrc(const_cast<bf16_t*>(WrT), 0, 0xffffffff, 0x00020000);
#pragma unroll
      for (int j = 0; j < 12; ++j) { const int idx = wid * 12 + j, row = idx >> 1, half = idx & 1;
          __builtin_amdgcn_raw_ptr_buffer_load_lds(rsw, (LAS void*)(wrl + row * WR_PITCH + half * 1024), 16, lane * 16, row * 2048 + half * 1024, 0, 0); } }
    constexpr int BR_OFF = LG_OFF + NWAVES * 16 * 48 * 4; LAS float* brl = (LAS float*)(F.lds + BR_OFF);
    static_assert(BR_OFF + 144 <= RING_BYTES, "P6 LDS map");
    const float* csrc = (F.tid < 256) ? g2 + 4 * F.tid : (F.tid == 256) ? b_rg : (F.tid < 265) ? b_re + 4 * (F.tid - 257) : g2;
    const f32x4 cst = *(const f32x4*)csrc;
    bool cst_pending = true;
    const int nblk = M / 128;
    for (int blk = F.vcu; blk < nblk; blk += F.G) {
        if (F.tid < 32) hist[F.tid] = 0;
        const int row0 = blk * 128 + wid * 16;
        f32x4 acc[3] = {{0.f, 0.f, 0.f, 0.f}, {0.f, 0.f, 0.f, 0.f}, {0.f, 0.f, 0.f, 0.f}}; float ss = 0.f;
        const bf16_t* xr = X1 + (size_t)(row0 + r) * D + 8 * kg; unsigned char* hr = H2 + (size_t)(row0 + r) * D + 8 * kg;
        const LAS unsigned char* wb = wrl + r * WR_PITCH + 16 * kg; const LAS float* gl = g2l + 8 * kg;
        { u32x4 xv[32];
#pragma unroll
            for (int q = 0; q < 32; ++q) xv[q] = *(const u32x4*)(xr + 32 * q);
            asm volatile("s_waitcnt vmcnt(0)" ::: "memory");
            if (cst_pending) { cst_pending = false; if (F.tid < 256) *(LAS f32x4*)(g2l + 4 * F.tid) = cst; else if (F.tid < 265) *(LAS f32x4*)(brl + 4 * (F.tid - 256)) = cst; }
            __syncthreads();
#pragma unroll
            for (int q = 0; q < 32; ++q) { const int s = q; const f32x4 x0 = {bflo(xv[q].x), bfhi(xv[q].x), bflo(xv[q].y), bfhi(xv[q].y)}, x1 = {bflo(xv[q].z), bfhi(xv[q].z), bflo(xv[q].w), bfhi(xv[q].w)};
                const f32x4 ga = *(const LAS f32x4*)(gl + 32 * s), gb = *(const LAS f32x4*)(gl + 32 * s + 4);
                ss += (x0.x * x0.x + x0.y * x0.y) + (x0.z * x0.z + x0.w * x0.w) + (x1.x * x1.x + x1.y * x1.y) + (x1.z * x1.z + x1.w * x1.w);
                u32x4 w; w.x = cvtpk(x0.x * ga.x, x0.y * ga.y); w.y = cvtpk(x0.z * ga.z, x0.w * ga.w); w.z = cvtpk(x1.x * gb.x, x1.y * gb.y); w.w = cvtpk(x1.z * gb.z, x1.w * gb.w);
                { u32x2 w8; w8.x = pk4_fp8(x0.x * ga.x, x0.y * ga.y, x0.z * ga.z, x0.w * ga.w); w8.y = pk4_fp8(x1.x * gb.x, x1.y * gb.y, x1.z * gb.z, x1.w * gb.w); *(u32x2*)(hr + 32 * s) = w8; }
                const bf16x8 af = __builtin_bit_cast(bf16x8, w);
#pragma unroll
                for (int j = 0; j < 3; ++j) { const bf16x8 bfr = *(const LAS bf16x8*)(wb + 16 * j * WR_PITCH + 64 * s); acc[j] = __builtin_amdgcn_mfma_f32_16x16x32_bf16(af, bfr, acc[j], 0, 0, 0); } } }
        ss += __shfl_xor(ss, 16); ss += __shfl_xor(ss, 32);
        const float rstd = rsqrtf(ss * (1.f / D) + EPS);
#pragma unroll
        for (int j = 0; j < 3; ++j)
#pragma unroll
            for (int i = 0; i < 4; ++i) lg[(4 * kg + i) * 48 + 16 * j + r] = acc[j][i];
        LDS_WAIT(); asm volatile("" ::: "memory");
        int e0 = 0, e1 = 0, rk0 = 0, rk1 = 0; float gt0 = 0.f, gt1 = 0.f;
        if (lane < 16) {
            const LAS float* L = lg + lane * 48;
            float gl4[4]; int grp = 0; float gm;
#pragma unroll
            for (int i = 0; i < 4; ++i) gl4[i] = L[i] * rstd + brl[i];
            gm = gl4[0];
#pragma unroll
            for (int i = 1; i < 4; ++i) if (gl4[i] > gm) { gm = gl4[i]; grp = i; }
            float gs = 0.f;
#pragma unroll
            for (int i = 0; i < 4; ++i) gs += __expf(gl4[i] - gm);
            const float pg = 1.0f / gs;
            float el[8];
#pragma unroll
            for (int i = 0; i < 8; ++i) el[i] = L[4 + grp * 8 + i] * rstd + brl[4 + grp * 8 + i];
            int i0 = 0; float m0 = el[0];
#pragma unroll
            for (int i = 1; i < 8; ++i) if (el[i] > m0) { m0 = el[i]; i0 = i; }
            int i1 = -1; float m1 = -3.0e38f;
#pragma unroll
            for (int i = 0; i < 8; ++i) if (i != i0 && el[i] > m1) { m1 = el[i]; i1 = i; }
            const float ex1 = __expf(m1 - m0); const float den = 1.0f / (1.0f + ex1);
            gt0 = pg * den; gt1 = pg * ex1 * den; e0 = grp * 8 + i0; e1 = grp * 8 + i1;
            rk0 = __hip_atomic_fetch_add(&hist[e0], 1, __ATOMIC_RELAXED, __HIP_MEMORY_SCOPE_WORKGROUP);
            rk1 = __hip_atomic_fetch_add(&hist[e1], 1, __ATOMIC_RELAXED, __HIP_MEMORY_SCOPE_WORKGROUP);
        }
        __syncthreads();
        if (F.tid < 32) { const int n = hist[F.tid]; int bs = 0; if (n > 0) bs = (int)__hip_atomic_fetch_add(gcnt + F.tid, (unsigned)n, __ATOMIC_RELAXED, __HIP_MEMORY_SCOPE_AGENT); base[F.tid] = bs; }
        __syncthreads();
        if (lane < 16) { const int tok = row0 + lane;
            const size_t p0 = (size_t)e0 * CAP + base[e0] + rk0, p1 = (size_t)e1 * CAP + base[e1] + rk1;
            asg[p0] = tok * 2; asg[p1] = tok * 2 + 1; rsg[p0] = (f32x2){gt0, rstd}; rsg[p1] = (f32x2){gt1, rstd}; }
        __syncthreads();
    }
}

__device__ __forceinline__ void moe_tables(const Frame& F, const Args& a) {
    const unsigned* gcnt = (const unsigned*)(a.ws + WS_CTL) + CW_CNT;
    LAS int* mtpre = (LAS int*)(F.lds + LDSCTL_OFF + LC_MTPRE); LAS int* cnt = (LAS int*)(F.lds + LDSCTL_OFF + LC_CNT);
    __syncthreads();
    if (F.wave == 0) {
        int l = lane_id(); asm volatile("" : "+v"(l));
        const int n = (l < 32) ? (int)__hip_atomic_load(gcnt + l, __ATOMIC_RELAXED, __HIP_MEMORY_SCOPE_AGENT) : 0;
        const int t = (n + 255) >> 8; int inc = t;
#pragma unroll
        for (int d = 1; d < 32; d <<= 1) { const int v = __builtin_amdgcn_ds_bpermute(((l - d) & 63) << 2, inc); if (l >= d) inc += v; }
        if (l < 32) { cnt[l] = n; mtpre[l] = inc - t; }
        if (l == 31) mtpre[32] = inc; }
    __syncthreads();
}

__device__ __forceinline__ void p9_combine(const Frame& F, const Args& a, bool dummy = false, float pert = 0.f) {
    const bf16_t* X1 = (const bf16_t*)(a.ws + WS_X1B); float* lo_dst = dummy ? (float*)(a.ws + WS_H2) : a.out; float* hi_dst = dummy ? (float*)(a.ws + WS_MERGED) - (size_t)(M / 2) * D : a.out; const unsigned char* Y = a.ws + WS_Y;
    const unsigned gt = (unsigned)F.vcu * NTHREADS + F.tid, NGT = (unsigned)F.G * NTHREADS, TOT = (unsigned)M * 128u;
    for (unsigned i0 = gt; i0 < TOT; i0 += 4 * NGT) {
        u32x4 xq[4]; u32x2 y0[4], y1[4];
#pragma unroll
        for (int k = 0; k < 4; ++k) { const unsigned i = i0 + k * NGT, ii = i < TOT ? i : gt; const size_t tok = ii >> 7, c8 = (ii & 127) * 8;
            xq[k] = *(const u32x4*)(X1 + tok * D + c8);
            y0[k] = *(const u32x2*)(Y + (tok * 2) * D + c8); y1[k] = *(const u32x2*)(Y + (tok * 2 + 1) * D + c8); }
#pragma unroll
        for (int k = 0; k < 4; ++k) { const unsigned i = i0 + k * NGT; if (i < TOT) { const size_t tok = i >> 7, c8 = (i & 127) * 8; f32x4 x0 = {bflo(xq[k].x), bfhi(xq[k].x), bflo(xq[k].y), bfhi(xq[k].y)}, x1 = {bflo(xq[k].z), bfhi(xq[k].z), bflo(xq[k].w), bfhi(xq[k].w)};
            float p[8], q[8]; un4_fp8(y0[k].x, p[0], p[1], p[2], p[3]); un4_fp8(y0[k].y, p[4], p[5], p[6], p[7]); un4_fp8(y1[k].x, q[0], q[1], q[2], q[3]); un4_fp8(y1[k].y, q[4], q[5], q[6], q[7]);
            x0.x += (p[0] + q[0]) * 0.0625f; x0.y += (p[1] + q[1]) * 0.0625f; x0.z += (p[2] + q[2]) * 0.0625f; x0.w += (p[3] + q[3]) * 0.0625f;
            x1.x += (p[4] + q[4]) * 0.0625f; x1.y += (p[5] + q[5]) * 0.0625f; x1.z += (p[6] + q[6]) * 0.0625f; x1.w += (p[7] + q[7]) * 0.0625f;
            if (PROBE_TS >= 0) { x0.x += pert; x0.y -= pert; x0.z += pert; x0.w -= pert; x1.x += pert; x1.y -= pert; x1.z += pert; x1.w -= pert; }
            float* dst = (tok < (size_t)(M / 2)) ? lo_dst : hi_dst; __builtin_nontemporal_store(x0, (f32x4*)(dst + tok * D + c8)); __builtin_nontemporal_store(x1, (f32x4*)(dst + tok * D + c8 + 4)); } }
    }
}

constexpr int N_PHASES = 10;
__global__ void __launch_bounds__(NTHREADS, 2) fwd_kernel(Args args_) {
    typedef const __attribute__((address_space(4))) Args* KArgP;
#if defined(__HIP_DEVICE_COMPILE__)
#define LOAD_ARGS() KArgP ap_ = (KArgP)__builtin_amdgcn_kernarg_segment_ptr(); asm volatile("" : "+s"(ap_)); const Args args = *ap_;
#else
#define LOAD_ARGS() const Args args = args_;
#endif
#define LOAD_ARGS_NOTE()
    extern __shared__ __attribute__((aligned(16))) unsigned char lds_raw[];
    Frame F; F.lds = (LAS unsigned char*)lds_raw; F.wave = __builtin_amdgcn_readfirstlane((int)threadIdx.x >> 6); F.lane = lane_id(); F.tid = F.wave * 64 + F.lane;
    F.G = gridDim.x; { const int bx = blockIdx.x; F.vcu = (F.G % 8 == 0) ? (bx % 8) * (F.G / 8) + bx / 8 : bx; }
    for (int u = F.tid; u < (LDS_BYTES - LDSCTL_OFF) / 4; u += NTHREADS) ((LAS unsigned*)(F.lds + LDSCTL_OFF))[u] = 0u;
    __syncthreads();
    unsigned char* ws = args_.ws;
    const int lo = args_.ph_lo, hi = args_.ph_hi;
#ifndef PH_MASK
#define PH_MASK 0x3ff
#endif
#define IN(k) (((PH_MASK >> (k)) & 1) && lo <= (k) && (k) < hi)
#if MK_USE_CG
#define GRID_BAR(k) do { if (IN(k) && IN((k) + 1)) { cg::this_grid().sync(); } } while (0)
#else
    XcdBarrier bar; bar.bar = (unsigned*)(ws + WS_CTL) + CW_BAR; bar.x = 0; bar.st = nullptr; bar.wave = F.wave;
    if (hi - lo > 1) bar = xcd_barrier_post((unsigned*)(ws + WS_CTL) + CW_BAR, (volatile LAS unsigned*)(F.lds + LDSCTL_OFF + LC_MISC) + 8, F.wave);
#define GRID_BAR(k) do { if (IN(k) && IN((k) + 1)) { xcd_barrier(bar); if (PROBE_TS >= 0 && blockIdx.x == 0 && F.wave == 0 && lane_id() == 0) ((unsigned long long*)((unsigned*)(ws + WS_CTL) + CW_TS))[(k) + 1] = __builtin_amdgcn_s_memrealtime(); } } while (0)
#endif
    const LAS int* mtpre = (const LAS int*)(F.lds + LDSCTL_OFF + LC_MTPRE); const LAS int* lcnt = (const LAS int*)(F.lds + LDSCTL_OFF + LC_CNT);

#define REP(k) for (int rep_ = 0; rep_ < args_.rep[k]; ++rep_)
#define REFRESH() do { F.lane = lane_id(); asm volatile("" : "+v"(F.lane)); F.tid = F.wave * 64 + F.lane; } while (0)
#define REPBAR() if (rep_) xcd_barrier(bar); REFRESH(); LOAD_ARGS()
    if (PROBE_TS >= 0 && blockIdx.x == 0 && F.wave == 0 && lane_id() == 0) ((unsigned long long*)((unsigned*)(ws + WS_CTL) + CW_TS))[0] = __builtin_amdgcn_s_memrealtime();
    if (IN(0)) REP(0) { REPBAR(); p0_prologue(F, args); } GRID_BAR(0);
    if (IN(1)) REP(1) { REPBAR(); pg8::EpiProjT<true> E8{(bf16_t*)(ws + WS_PROJ), ws + WS_GATE8};
        if (rep_ == 0) { const int nwg = 128 * 11, maxc = (nwg + F.G - 1) / F.G, full = nwg - (maxc - 1) * F.G;
            if (full >= F.G) convert_items(F, args, I_SMALL, I_SMALL + 2 * I_G, (int)blockIdx.x, F.G);
            else if ((int)blockIdx.x >= full) convert_items(F, args, I_SMALL, I_SMALL + 2 * I_G, (int)blockIdx.x - full, F.G - full);
            __syncthreads(); }
        { pg8::ProjOrder8 S{ws + WS_XN8, ws + WS_WIN8, F.G, (int)blockIdx.x};
          pg8::gemm_phase<pg8::EpiProjT<true>, pg8::ProjOrder8, true, true, true>(F.lds, F.wave, 512, 512, 512, S, E8); }
        { pg8::ProjOrder16 S{(const bf16_t*)(ws + WS_XN), (const bf16_t*)(ws + WS_WIN), F.G, (int)blockIdx.x};
          pg8::gemm_phase<pg8::EpiProjT<true>, pg8::ProjOrder16, true>(F.lds, F.wave, 1024, 1024, 1024, S, E8); } } GRID_BAR(1);
    if (IN(3)) REP(3) { REPBAR(); p3_attention(F, args); } GRID_BAR(3);
    if (IN(4)) REP(4) { REPBAR(); pg8::GateMixOrder S{(const bf16_t*)(ws + WS_AC), (const bf16_t*)(ws + WS_WC), ws + WS_ATT8, ws + WS_WA, F.G, (int)blockIdx.x};
        pg8::EpiGate2 E{ws + WS_GATE8, (bf16_t*)(ws + WS_MERGED)};
        if (F.wave < 4) { const __amdgpu_buffer_rsrc_t rg = __builtin_amdgcn_make_buffer_rsrc(const_cast<float*>(args.in[1]), 0, 0xffffffff, 0x00020000);
            __builtin_amdgcn_raw_ptr_buffer_load_lds(rg, (LAS void*)(F.lds + LDS_META_OFF + F.wave * 1024), 16, lane_id() * 16, F.wave * 1024, 0, 0); }
        pg8::gemm_phase<pg8::EpiGate2, pg8::GateMixOrder, true, true, false, 4>(F.lds, F.wave, 768, 1024, 512, S, E, 256, 256); } GRID_BAR(4);
    if (IN(5)) REP(5) { REPBAR(); pg8::PlainOrder S{(const bf16_t*)(ws + WS_MERGED), (const bf16_t*)(ws + WS_WOUT), 1024, 1024, M / 256, D / 256, F.G, (int)blockIdx.x};
        { const int t2 = (F.wave * 64 + lane_id()) * 2; LAS float* igw = (LAS float*)(F.lds + LDS_META_OFF);
          f32x2 gv; if (IN(4)) gv = *(const LAS f32x2*)(igw + t2); else gv = *(const f32x2*)(args.in[1] + t2);
          igw[t2] = __builtin_amdgcn_rcpf(gv.x); igw[t2 + 1] = __builtin_amdgcn_rcpf(gv.y); }
        pg8::EpiRes E{(bf16_t*)(ws + WS_X1B), (const float*)(ws + WS_RRS), (const LAS float*)(F.lds + LDS_META_OFF)};
        pg8::gemm_phase<pg8::EpiRes, pg8::PlainOrder, true>(F.lds, F.wave, 1024, 1024, 1024, S, E); } GRID_BAR(5);
    if (IN(6)) REP(6) { REFRESH(); LOAD_ARGS(); if (rep_) { xcd_barrier(bar); if (blockIdx.x == 0 && F.tid < 32) ((unsigned*)(ws + WS_CTL) + CW_CNT)[F.tid] = 0u; xcd_barrier(bar); } p6_route(F, args); } GRID_BAR(6);
    if (IN(7)) REP(7) { REPBAR(); moe_tables(F, args);
        pg8::MoeGuOrder S; S.mtpre = mtpre; S.cnt = lcnt; S.NT = 2; S.G = F.G; S.c = (int)blockIdx.x; S.H2 = ws + WS_H2; S.Wgu = ws + WS_WGU; S.asg = (const int*)(ws + WS_ASG); S.idl = (LAS int*)(F.lds + LDS_META_OFF + 4096);
        pg8::EpiGU E{ws + WS_HID, (const f32x2*)(ws + WS_RSG), mtpre, F.lds + LDS_META_OFF};
        pg8::gemm_phase<pg8::EpiGU, pg8::MoeGuOrder, true, true, true>(F.lds, F.wave, 512, 512, 512, S, E);
        REFRESH();
        if (rep_ == 0) { const int nwg = mtpre[32] * 2, maxc = (nwg + F.G - 1) / F.G, full = nwg - (maxc - 1) * F.G;
            __syncthreads();
            if (full >= F.G || maxc == 0) convert_items(F, args, I_SMALL + 2 * I_G, NITEMS, (int)blockIdx.x, F.G);
            else if ((int)blockIdx.x >= full) convert_items(F, args, I_SMALL + 2 * I_G, NITEMS, (int)blockIdx.x - full, F.G - full); } } GRID_BAR(7);
    if (IN(8)) REP(8) { REPBAR(); if (!(IN(7))) moe_tables(F, args);
        pg8::MoeDownOrder S; S.mtpre = mtpre; S.cnt = lcnt; S.NT = 4; S.G = F.G; S.c = (int)blockIdx.x; S.HID = ws + WS_HID; S.Wd = ws + WS_WD;
        pg8::EpiDown E{ws + WS_Y, (const int*)(ws + WS_ASG), (const f32x2*)(ws + WS_RSG), mtpre, F.lds + LDS_META_OFF};
        pg8::gemm_phase<pg8::EpiDown, pg8::MoeDownOrder, true, true, true>(F.lds, F.wave, 128, 128, 128, S, E); } GRID_BAR(8);
    if (IN(9)) { REFRESH(); LOAD_ARGS(); if (args.rep[9] > 1) { p9_combine(F, args, true); xcd_barrier(bar); }
        float pert = 0.f;
        if (PROBE_TS >= 0) { xcd_barrier(bar); const unsigned long long* ts = (const unsigned long long*)((unsigned*)(ws + WS_CTL) + CW_TS);
            const float dt_us = (PROBE_TS == 99) ? 100.f : (float)(__hip_atomic_load(ts + PROBE_TS + 1, __ATOMIC_RELAXED, __HIP_MEMORY_SCOPE_AGENT) - __hip_atomic_load(ts + (PROBE_TS == 3 ? 2 : PROBE_TS), __ATOMIC_RELAXED, __HIP_MEMORY_SCOPE_AGENT)) * 0.01f;
            pert = sqrtf(dt_us * PROBE_SCALE * PROBE_V); }
        p9_combine(F, args, false, pert); }
#undef IN
#undef GRID_BAR
}

extern "C" void kernel_launch(void* const* d_in, const int* in_sizes, int n_in, void* d_out, int out_size, void* d_ws, size_t ws_size, hipStream_t stream) {
    static int grid = 0;
    if (grid == 0) {
        if (n_in != 19 || in_sizes[0] != M * D || out_size != M * D || ws_size < WS_END) { fprintf(stderr, "kernel_launch: unexpected shapes (n_in %d, in0 %d, out %d, ws %zu)\n", n_in, n_in > 0 ? in_sizes[0] : -1, out_size, ws_size); grid = -1; return; }
        int dev = 0, cus = 0, per_cu = 0;
        if (hipGetDevice(&dev) != hipSuccess || hipDeviceGetAttribute(&cus, hipDeviceAttributeMultiprocessorCount, dev) != hipSuccess) { grid = -1; return; }
        if (hipFuncSetAttribute((const void*)fwd_kernel, hipFuncAttributeMaxDynamicSharedMemorySize, LDS_BYTES) != hipSuccess) { fprintf(stderr, "kernel_launch: hipFuncSetAttribute failed\n"); grid = -1; return; }
        if (hipOccupancyMaxActiveBlocksPerMultiprocessor(&per_cu, (const void*)fwd_kernel, NTHREADS, LDS_BYTES) != hipSuccess || per_cu < 1) { fprintf(stderr, "kernel_launch: occupancy query says %d\n", per_cu); per_cu = 1; }
        (void)hipGetLastError();
        grid = cus * 1;
        fprintf(stderr, "kernel_launch: cus %d per_cu %d grid %d\n", cus, per_cu, grid);
    }
    if (grid < 0) return;
    (void)hipMemsetAsync((char*)d_ws + WS_CTL, 0, CTL_ZERO_BYTES, stream);
    Args a{};
    for (int i = 0; i < 19; ++i) a.in[i] = (const float*)d_in[i];
    a.out = (float*)d_out; a.ws = (unsigned char*)d_ws;
    for (int i = 0; i < 10; ++i) a.rep[i] = (i == PROBE_DUP) ? 2 : 1;
#if MK_N_LAUNCHES == 1
    a.ph_lo = 0; a.ph_hi = N_PHASES;
    void* kargs[] = {&a};
#if MK_USE_CG
    hipError_t e = hipLaunchCooperativeKernel((const void*)fwd_kernel, dim3(grid), dim3(NTHREADS), kargs, LDS_BYTES, stream);
    if (e != hipSuccess) fprintf(stderr, "kernel_launch: cooperative launch failed: %s\n", hipGetErrorString(e));
#else
    (void)kargs; hipLaunchKernelGGL(fwd_kernel, dim3(grid), dim3(NTHREADS), LDS_BYTES, stream, a);
#endif
#else
    for (int p = 0; p < N_PHASES; ++p) { a.ph_lo = p; a.ph_hi = p + 1; hipLaunchKernelGGL(fwd_kernel, dim3(grid), dim3(NTHREADS), LDS_BYTES, stream, a); }
#endif
}
```

```cpp
#include <hip/hip_runtime.h>
#include <hip/hip_cooperative_groups.h>
#include <cstdio>
#include <cstdint>
namespace cg = cooperative_groups;

#ifndef PROBE_DUP
#define PROBE_DUP -1
#endif
#ifndef PROBE_TS
#define PROBE_TS -1
#endif
#ifndef PROBE_V
#define PROBE_V 1.4f
#endif
#ifndef PROBE_SCALE
#define PROBE_SCALE 1e-3f
#endif
#ifndef MK_N_LAUNCHES
#define MK_N_LAUNCHES 1
#endif

#define LAS __attribute__((address_space(3)))
#define GAS __attribute__((address_space(1)))
typedef unsigned short bf16_t;
typedef short bf16x8 __attribute__((ext_vector_type(8)));
typedef short s16x4 __attribute__((ext_vector_type(4)));
typedef float f32x4 __attribute__((ext_vector_type(4)));
typedef float f32x2 __attribute__((ext_vector_type(2)));
typedef float f32x16 __attribute__((ext_vector_type(16)));
typedef unsigned u32x4 __attribute__((ext_vector_type(4)));
typedef unsigned u32x2 __attribute__((ext_vector_type(2)));
typedef __bf16 bf16x2_t __attribute__((ext_vector_type(2)));

constexpr int NB = 8, SEQ = 4096, M = NB * SEQ, D = 1024, PW = 4352;
constexpr int PWP = 1792;
constexpr int NH = 8, NKV = 2, HD = 64, AD = 512, CD = 512;
constexpr int C_Q = 0, C_K = 512, C_V = 640, C_CB = 768, C_CC = 1280, C_CX = 1792, C_GA = 2304;
constexpr int C_U = 1280;
constexpr int NE = 32, DFF = 256, CAP = 32768;
constexpr float EPS = 1e-6f;
constexpr float QSCALE = 0.125f * 1.4426950408889634f;
constexpr int NWAVES = 8, NTHREADS = 512;

constexpr size_t MiB = 1u << 20;
constexpr size_t WS_CTL = 0, CTL_ZERO_BYTES = 64 * 1024;
constexpr size_t WS_ROPE = 1 * MiB;
constexpr size_t WS_WR = 1 * MiB + 256 * 1024;
constexpr size_t WS_WIN = 2 * MiB;
constexpr size_t WS_WIN8 = 440 * MiB;
constexpr size_t WS_XN8 = 400 * MiB;
constexpr float WIN8_SCALE = 32.0f;
constexpr size_t WS_WA = 11 * MiB, WS_WC = 12 * MiB;
constexpr size_t WS_WOUT = 13 * MiB;
constexpr size_t WS_WGU = 16 * MiB;
constexpr size_t WS_WD = 48 * MiB;
constexpr size_t WS_XN = 64 * MiB;
constexpr size_t WS_AC = 336 * MiB;
constexpr size_t WS_PROJ = 128 * MiB;
constexpr size_t WS_ATT8 = 240 * MiB;
constexpr size_t WS_GATE8 = 272 * MiB;
constexpr size_t WS_H2 = 128 * MiB;
constexpr size_t WS_HID = 192 * MiB;
constexpr size_t WS_Y = 232 * MiB;
constexpr size_t WS_X1B = 64 * MiB;
constexpr size_t WS_RRS = 1 * MiB + 512 * 1024;
constexpr size_t WS_MERGED = 400 * MiB;
constexpr size_t WS_ASG = 464 * MiB;
constexpr size_t WS_RSG = 468 * MiB;
constexpr size_t WS_END = 476 * MiB;
constexpr int CW_CNT = 1024;
constexpr int CW_TS = 2048;
constexpr int CW_BAR = 4096;

constexpr int RING_BYTES = 131072;
constexpr int LDSCTL_OFF = RING_BYTES;
constexpr int LC_MISC = 0;
constexpr int LC_MTPRE = 128;
constexpr int LC_CNT = 128 + 160;
constexpr int LC_HIST = LC_CNT + 128;
constexpr int LC_BASE = LC_HIST + 128;
constexpr int LDS_META_OFF = 136 * 1024;
constexpr int LDS_BYTES = 163840;

__device__ __forceinline__ unsigned cvtpk(float lo, float hi) { f32x2 v = {lo, hi}; bf16x2_t b = __builtin_convertvector(v, bf16x2_t); return __builtin_bit_cast(unsigned, b); }
__device__ __forceinline__ bf16_t f2bf(float f) { return (bf16_t)(cvtpk(f, 0.f) & 0xffffu); }
__device__ __forceinline__ float bf2f(unsigned h) { return __builtin_bit_cast(float, h << 16); }
__device__ __forceinline__ float bflo(unsigned w) { return __builtin_bit_cast(float, w << 16); }
__device__ __forceinline__ float bfhi(unsigned w) { return __builtin_bit_cast(float, w & 0xffff0000u); }
__device__ __forceinline__ float wave_sum(float v) {
#pragma unroll
    for (int o = 1; o < 64; o <<= 1) v += __shfl_xor(v, o);
    return v;
}
__device__ __forceinline__ float wave_max(float v) {
#pragma unroll
    for (int o = 1; o < 64; o <<= 1) v = fmaxf(v, __shfl_xor(v, o));
    return v;
}
__device__ __forceinline__ float sig255(float a, float c1) { return __builtin_amdgcn_rcpf(__builtin_amdgcn_exp2f(__builtin_fmaf(a, c1, -7.994353436858858f)) + (1.0f / 255.0f)); }
__device__ __forceinline__ float sigmoidf_(float v) { return __builtin_amdgcn_rcpf(1.0f + __builtin_amdgcn_exp2f(-1.4426950408889634f * v)); }
__device__ __forceinline__ void unpack8(const u32x4 w, float (&v)[8]) { v[0] = bflo(w.x); v[1] = bfhi(w.x); v[2] = bflo(w.y); v[3] = bfhi(w.y); v[4] = bflo(w.z); v[5] = bfhi(w.z); v[6] = bflo(w.w); v[7] = bfhi(w.w); }
__device__ __forceinline__ u32x4 pack8(const float (&v)[8]) { u32x4 w; w.x = cvtpk(v[0], v[1]); w.y = cvtpk(v[2], v[3]); w.z = cvtpk(v[4], v[5]); w.w = cvtpk(v[6], v[7]); return w; }
__device__ __forceinline__ int lane_id() { unsigned m = ~0u; asm volatile("" : "+s"(m)); return (int)__builtin_amdgcn_mbcnt_hi(m, __builtin_amdgcn_mbcnt_lo(m, 0u)); }
__device__ __forceinline__ unsigned pk4_fp8(float a, float b, float c, float d);
__device__ __forceinline__ unsigned pk4_fp8s(float a, float b, float c, float d) { return pk4_fp8(__builtin_amdgcn_fmed3f(a, -448.f, 448.f), __builtin_amdgcn_fmed3f(b, -448.f, 448.f), __builtin_amdgcn_fmed3f(c, -448.f, 448.f), __builtin_amdgcn_fmed3f(d, -448.f, 448.f)); }
__device__ __forceinline__ unsigned pk4_fp8(float a, float b, float c, float d) { int w = 0; w = __builtin_amdgcn_cvt_pk_fp8_f32(a, b, w, false); w = __builtin_amdgcn_cvt_pk_fp8_f32(c, d, w, true); return (unsigned)w; }
__device__ __forceinline__ void un4_fp8(unsigned w, float& a, float& b, float& c, float& d) { const f32x2 lo = __builtin_amdgcn_cvt_pk_f32_fp8((int)w, false), hi = __builtin_amdgcn_cvt_pk_f32_fp8((int)w, true); a = lo.x; b = lo.y; c = hi.x; d = hi.y; }
#define LDS_WAIT() asm volatile("s_waitcnt lgkmcnt(0)" ::: "memory")
#define VM_WAIT() asm volatile("s_waitcnt vmcnt(0)" ::: "memory")

namespace pg8 {
constexpr int BM = 256, BK = 64, HALF = 128, HTB = HALF * BK * 2, STAGE_BYTES = 8 * HTB, NXCD = 8, WGM = 8;
__host__ __device__ __forceinline__ int lds_byte(int r, int c) { const int st = (r >> 4) * 2 + (c >> 5), rr = r & 15, cc = c & 31, ob = rr * 64 + cc * 2; return st * 1024 + (ob ^ (((ob >> 9) & 1) << 5)); }
__host__ __device__ __forceinline__ void stage_rc(int b, int& R, int& C) { const int st = b / 1024, sb = b % 1024, swz = sb ^ (((sb >> 9) & 1) << 5); R = (st >> 1) * 16 + swz / 64; C = (st & 1) * 32 + (swz % 64) / 2; }
__host__ __device__ __forceinline__ int perm32(int rho) { const int n = rho >> 4, i = rho & 15; return 8 * (i >> 2) + 4 * n + (i & 3); }

struct Unit { int pm, pn, z, valid; };

template <int WG = WGM>
__device__ __forceinline__ void tile_of(int L, int nM, int nN, int& pm, int& pn) {
    const int nwg = nM * nN; int wgid = L;
    { const int q = nwg / NXCD, r = nwg % NXCD, xcd = wgid % NXCD, off = wgid / NXCD; wgid = (xcd < r ? xcd * (q + 1) : r * (q + 1) + (xcd - r) * q) + off; }
    const int nig = WG * nN, gid = wgid / nig, fm = gid * WG, gsz = (nM - fm) < WG ? (nM - fm) : WG;
    pm = fm + ((wgid % nig) % gsz); pn = (wgid % nig) / gsz;
}

struct PlainOrder {
    static constexpr bool GATHER = false;
    const bf16_t* A; const bf16_t* Bt; int lda, ldb, nM, nN, G, c;
    __device__ __forceinline__ bool next(int i, Unit& u) const { const int L = i * G + c; if (L >= nM * nN) return false; tile_of(L, nM, nN, u.pm, u.pn); u.z = 0; u.valid = 256; return true; }
    __device__ __forceinline__ void bases(const void*& a, const void*& b) const { a = A; b = Bt; }
    __device__ __forceinline__ void offs(const Unit& u, unsigned& a, unsigned& b) const { a = (unsigned)u.pm * 256u * (unsigned)lda * 2u; b = (unsigned)u.pn * 256u * (unsigned)ldb * 2u; }
    __device__ __forceinline__ void avoff(const Unit&, const int (&R)[2], const int (&C)[2], unsigned (&v)[2][2]) const {
#pragma unroll
        for (int h = 0; h < 2; ++h)
#pragma unroll
            for (int i = 0; i < 2; ++i) v[h][i] = (unsigned)(R[i] * lda + C[i]) * 2u;
    }
};
struct GateMixOrder {
    static constexpr bool GATHER = false;
    const bf16_t* AC; const bf16_t* WcT; const unsigned char* ATT8; const unsigned char* WA8; int G, c;
    __device__ __forceinline__ bool next(int i, Unit& u) const { const int L = i * G + c; if (L >= 128 * 4) return false; tile_of(L, 128, 4, u.pm, u.pn); u.z = 0; u.valid = 256; return true; }
    __device__ __forceinline__ void bases(const void*& a, const void*& b) const { a = AC; b = WcT; }
    __device__ __forceinline__ void bases8(const void*& a, const void*& b) const { a = ATT8; b = WA8; }
    __device__ __forceinline__ void offs(const Unit& u, unsigned& a, unsigned& b) const { a = (unsigned)u.pm * 256u * 2048u + 1024u; b = (unsigned)u.pn * 256u * 1024u; }
    __device__ __forceinline__ void offs8(const Unit& u, unsigned& a, unsigned& b) const { a = (unsigned)u.pm * 256u * 512u; b = (unsigned)u.pn * 256u * 512u; }
    __device__ __forceinline__ void avoff(const Unit&, const int (&R)[2], const int (&C)[2], unsigned (&v)[2][2]) const {
#pragma unroll
        for (int h = 0; h < 2; ++h)
#pragma unroll
            for (int i = 0; i < 2; ++i) v[h][i] = (unsigned)(R[i] * 1024 + C[i]) * 2u;
    }
};
struct ProjOrder8 {
    static constexpr bool GATHER = false;
    const unsigned char* A; const unsigned char* Bt; int G, c;
    __device__ __forceinline__ bool next(int i, Unit& u) const { const int L = i * G + c; if (L >= 128 * 11) return false; int idx; tile_of<16>(L, 128, 11, u.pm, idx); u.pn = idx < 3 ? idx : idx + 6; u.z = 1; u.valid = 256; return true; }
    __device__ __forceinline__ void bases(const void*& a, const void*& b) const { a = A; b = Bt; }
    __device__ __forceinline__ void offs(const Unit& u, unsigned& a, unsigned& b) const { a = (unsigned)u.pm * 256u * 1024u; b = (unsigned)u.pn * 256u * 1024u; }
    __device__ __forceinline__ void avoff(const Unit&, const int (&R)[2], const int (&C)[2], unsigned (&v)[2][2]) const {
#pragma unroll
        for (int h = 0; h < 2; ++h)
#pragma unroll
            for (int i = 0; i < 2; ++i) v[h][i] = (unsigned)(R[i] * 512 + C[i]) * 2u;
    }
};
struct ProjOrder16 {
    static constexpr bool GATHER = false;
    const bf16_t* A; const bf16_t* Bt; int G, c;
    __device__ __forceinline__ bool next(int i, Unit& u) const { const int L = i * G + c; if (L >= 128 * 6) return false; int idx; tile_of<16>(L, 128, 6, u.pm, idx); u.pn = 3 + idx; u.z = 0; u.valid = 256; return true; }
    __device__ __forceinline__ void bases(const void*& a, const void*& b) const { a = A; b = Bt; }
    __device__ __forceinline__ void offs(const Unit& u, unsigned& a, unsigned& b) const { a = (unsigned)u.pm * 256u * 2048u; b = (unsigned)u.pn * 256u * 2048u; }
    __device__ __forceinline__ void avoff(const Unit&, const int (&R)[2], const int (&C)[2], unsigned (&v)[2][2]) const {
#pragma unroll
        for (int h = 0; h < 2; ++h)
#pragma unroll
            for (int i = 0; i < 2; ++i) v[h][i] = (unsigned)(R[i] * 1024 + C[i]) * 2u;
    }
};
struct MoeOrder {
    const LAS int* mtpre; const LAS int* cnt; int NT, G, c;
    __device__ __forceinline__ bool locate(int i, Unit& u) const {
        const int L = i * G + c; const int U = __builtin_amdgcn_readfirstlane(mtpre[32]) * NT; if (L >= U) return false;
        const int tg = L / NT; u.pn = L - tg * NT;
        const int l = lane_id() & 31; const int e = (int)__popcll(__ballot(l >= 1 && mtpre[l] <= tg)) >> 1;
        u.z = e; u.pm = tg; const int mt = tg - __builtin_amdgcn_readfirstlane(mtpre[e]); const int left = __builtin_amdgcn_readfirstlane(cnt[e]) - mt * 256; u.valid = left < 256 ? left : 256; return true;
    }
};
struct MoeGuOrder : MoeOrder {
    static constexpr bool GATHER = true;
    const unsigned char* H2; const unsigned char* Wgu; const int* asg; LAS int* idl;
    __device__ __forceinline__ bool next(int i, Unit& u) const { return locate(i, u); }
    __device__ __forceinline__ void prefetch_ids(const Unit& u, int wave, int lane) const {
        if (wave < 4) { const int mt = u.pm - mtpre[u.z]; const unsigned pb = (unsigned)__builtin_amdgcn_readfirstlane((int)((unsigned)u.z * CAP + mt * 256));
            const __amdgpu_buffer_rsrc_t rs = __builtin_amdgcn_make_buffer_rsrc(const_cast<int*>(asg), 0, 0xffffffff, 0x00020000);
            __builtin_amdgcn_raw_ptr_buffer_load_lds(rs, (LAS void*)((LAS unsigned char*)idl + wave * 256), 4, (wave * 64 + lane) * 4, (int)(pb * 4u), 0, 0); }
    }
    __device__ __forceinline__ void avoff_lds(const Unit& u, const int (&R)[2], const int (&C)[2], unsigned (&v)[2][2]) const {
#pragma unroll
        for (int h = 0; h < 2; ++h)
#pragma unroll
            for (int i = 0; i < 2; ++i) { const unsigned r = (unsigned)(h * 128 + R[i]); const unsigned rr = ((int)r < u.valid) ? r : 0u; const int tok = idl[rr] >> 1; v[h][i] = (unsigned)(tok * 512 + C[i]) * 2u; }
    }
    __device__ __forceinline__ void bases(const void*& a, const void*& b) const { a = H2; b = Wgu; }
    __device__ __forceinline__ void offs(const Unit& u, unsigned& a, unsigned& b) const { a = 0u; b = ((unsigned)u.z * 512u + (unsigned)u.pn * 256u) * 1024u; }
    __device__ __forceinline__ void avoff(const Unit& u, const int (&R)[2], const int (&C)[2], unsigned (&v)[2][2]) const {
        const int mt = u.pm - mtpre[u.z]; const int* ap = asg + (unsigned)__builtin_amdgcn_readfirstlane((int)((unsigned)u.z * CAP + mt * 256));
        int tk[2][2];
#pragma unroll
        for (int h = 0; h < 2; ++h)
#pragma unroll
            for (int i = 0; i < 2; ++i) { const unsigned r = (unsigned)(h * 128 + R[i]); const unsigned rr = ((int)r < u.valid) ? r : 0u; tk[h][i] = ap[rr]; }
        asm volatile("" : "+v"(tk[0][0]), "+v"(tk[0][1]), "+v"(tk[1][0]), "+v"(tk[1][1]));
#pragma unroll
        for (int h = 0; h < 2; ++h)
#pragma unroll
            for (int i = 0; i < 2; ++i) { const int tok = tk[h][i] >> 1; v[h][i] = (unsigned)(tok * 512 + C[i]) * 2u; }
    }
};
struct MoeDownOrder : MoeOrder {
    static constexpr bool GATHER = false;
    const unsigned char* HID; const unsigned char* Wd;
    __device__ __forceinline__ bool next(int i, Unit& u) const { return locate(i, u); }
    __device__ __forceinline__ void bases(const void*& a, const void*& b) const { a = HID; b = Wd; }
    __device__ __forceinline__ void offs(const Unit& u, unsigned& a, unsigned& b) const { a = (unsigned)u.pm * 256u * 256u; b = ((unsigned)u.z * 1024u + (unsigned)u.pn * 256u) * 256u; }
    __device__ __forceinline__ void avoff(const Unit&, const int (&R)[2], const int (&C)[2], unsigned (&v)[2][2]) const {
#pragma unroll
        for (int h = 0; h < 2; ++h)
#pragma unroll
            for (int i = 0; i < 2; ++i) v[h][i] = (unsigned)(R[i] * 128 + C[i]) * 2u;
    }
};

typedef f32x4 Acc[2][2][4][2];

template <bool WIDE_>
struct EpiProjT {
    static constexpr bool PERM = true, HAS_MID = false, HAS_PRE = true, PRE_LATE = true, WIDE = WIDE_; struct Pre {};
    bf16_t* O; unsigned char* G8; const float* cosT; LAS unsigned char* aux;
    __device__ __forceinline__ void pre(Pre&, const Unit& u, int wave, int lane) const {
        if (u.pn <= 2) { const __amdgpu_buffer_rsrc_t rs = __builtin_amdgcn_make_buffer_rsrc(const_cast<float*>(cosT), 0, 0xffffffff, 0x00020000);
            const int so = ((u.pm & 15) * 256 + wave * 32) * 32;
            __builtin_amdgcn_raw_ptr_buffer_load_lds(rs, (LAS void*)(aux + 4096 + wave * 1024), 16, lane * 16, so, 0, 0);
            __builtin_amdgcn_raw_ptr_buffer_load_lds(rs, (LAS void*)(aux + 4096 + 8192 + wave * 1024), 16, lane * 16, so + SEQ * 32, 0, 0); }
    }
    __device__ __forceinline__ void operator()(const Acc& acc, const Unit& u, int wr, int wc, int fr, int fq, const Pre&) const {
        const bool sg = u.pn >= 9; const float sc = u.z ? (1.0f / WIN8_SCALE) : 1.0f;
        if (u.pn < 2 || (u.pn == 2 && wc < 2)) {
            bf16_t* base = O + (size_t)u.pm * BM * PWP + u.pn * BM;
            unsigned l0 = (unsigned)((wr * 64 + fr) * PWP + wc * 64 + 8 * fq); asm volatile("" : "+v"(l0));
            const LAS float* gl = (const LAS float*)aux + (u.pn == 2 ? 64 : 0) + 8 * fq;
            const f32x4 g0a = *(const LAS f32x4*)gl, g0b = *(const LAS f32x4*)(gl + 4), g1a = *(const LAS f32x4*)(gl + 32), g1b = *(const LAS f32x4*)(gl + 36);
            const float g0[8] = {g0a.x, g0a.y, g0a.z, g0a.w, g0b.x, g0b.y, g0b.z, g0b.w}, g1[8] = {g1a.x, g1a.y, g1a.z, g1a.w, g1b.x, g1b.y, g1b.z, g1b.w};
#pragma unroll
            for (int ai = 0; ai < 2; ++ai)
#pragma unroll
                for (int m = 0; m < 4; ++m) { const int row = ai * HALF + wr * 64 + m * 16 + fr;
                    float x0[8], x1[8]; float ss = 0.f;
#pragma unroll
                    for (int k = 0; k < 8; ++k) { x0[k] = (k < 4 ? acc[ai][0][m][0][k] : acc[ai][0][m][1][k - 4]) * sc; x1[k] = (k < 4 ? acc[ai][1][m][0][k] : acc[ai][1][m][1][k - 4]) * sc; ss += x0[k] * x0[k] + x1[k] * x1[k]; }
                    ss += __shfl_xor(ss, 16); ss += __shfl_xor(ss, 32);
                    const float rstd = rsqrtf(ss * (1.f / 64.f) + EPS);
                    const LAS float* cl = (const LAS float*)(aux + 4096) + row * 8; const f32x4 ca = *(const LAS f32x4*)cl, cb = *(const LAS f32x4*)(cl + 4), sa = *(const LAS f32x4*)(cl + 2048), sb = *(const LAS f32x4*)(cl + 2052);
                    const float cc[8] = {ca.x, ca.y, ca.z, ca.w, cb.x, cb.y, cb.z, cb.w}, sn[8] = {sa.x, sa.y, sa.z, sa.w, sb.x, sb.y, sb.z, sb.w};
#pragma unroll
                    for (int k = 0; k < 8; ++k) { const float y = x0[k] * rstd * g0[k]; const float p = __shfl_xor(y, 16);
                        const float yr = (fq == 0) ? (y * cc[k] - p * sn[k]) : (y * cc[k] + p * sn[k]);
                        x0[k] = (fq < 2) ? yr : y; x1[k] = x1[k] * rstd * g1[k]; }
                    *(u32x4*)(base + (l0 + (unsigned)((ai * HALF + m * 16) * PWP))) = pack8(x0);
                    *(u32x4*)(base + (l0 + (unsigned)((ai * HALF + m * 16) * PWP + 32))) = pack8(x1); }
        } else
        if (u.pn >= 5 && u.pn <= 8) {
            bf16_t* base = O + (size_t)u.pm * BM * PWP + C_U + (u.pn - 5) * 128;
            unsigned l0 = (unsigned)((wr * 64 + fr) * PWP + wc * 32 + 8 * fq); asm volatile("" : "+v"(l0));
#pragma unroll
            for (int ai = 0; ai < 2; ++ai)
#pragma unroll
                for (int m = 0; m < 4; ++m) { const f32x4 v0 = acc[ai][0][m][0] * acc[ai][1][m][0], v1 = acc[ai][0][m][1] * acc[ai][1][m][1];
                    u32x4 w; w.x = cvtpk(v0[0], v0[1]); w.y = cvtpk(v0[2], v0[3]); w.z = cvtpk(v1[0], v1[1]); w.w = cvtpk(v1[2], v1[3]);
                    *(u32x4*)(base + (l0 + (unsigned)((ai * HALF + m * 16) * PWP))) = w; }
        } else if (!sg) {
            bf16_t* base = O + (size_t)u.pm * BM * PWP + u.pn * BM;
            unsigned l0 = (unsigned)((wr * 64 + fr) * PWP + wc * (WIDE ? 64 : 32) + 8 * fq); asm volatile("" : "+v"(l0));
#pragma unroll
            for (int ai = 0; ai < 2; ++ai)
#pragma unroll
                for (int m = 0; m < 4; ++m)
#pragma unroll
                    for (int bj = 0; bj < 2; ++bj) { const f32x4 v0 = acc[ai][bj][m][0] * sc, v1 = acc[ai][bj][m][1] * sc;
                        u32x4 w; w.x = cvtpk(v0[0], v0[1]); w.y = cvtpk(v0[2], v0[3]); w.z = cvtpk(v1[0], v1[1]); w.w = cvtpk(v1[2], v1[3]);
                        *(u32x4*)(base + (l0 + (unsigned)((ai * HALF + m * 16) * PWP + bj * (WIDE ? 32 : HALF)))) = w; }
        } else {
            unsigned char* base = G8 + ((size_t)u.pm * 8 + (u.pn - 9)) * 65536 + (wr * 4 + wc) * 8192;
            const float c1 = -1.4426950408889634f * sc;
            unsigned l0 = (unsigned)((fr + 16 * fq) * 16); asm volatile("" : "+v"(l0));
#pragma unroll
            for (int ai = 0; ai < 2; ++ai)
#pragma unroll
                for (int bj = 0; bj < 2; ++bj)
#pragma unroll
                    for (int m2 = 0; m2 < 2; ++m2) { u32x4 w4;
#pragma unroll
                        for (int mm = 0; mm < 2; ++mm) { const int m = 2 * m2 + mm; u32x2 w; w.x = 0u; w.y = 0u;
                            const f32x4 t0 = acc[ai][bj][m][0] * c1 + (-7.994353436858858f), t1 = acc[ai][bj][m][1] * c1 + (-7.994353436858858f);
                            f32x4 e0, e1;
#pragma unroll
                            for (int k = 0; k < 4; ++k) { e0[k] = __builtin_amdgcn_exp2f(t0[k]); e1[k] = __builtin_amdgcn_exp2f(t1[k]); }
                            const f32x4 d0 = e0 + (1.0f / 255.0f), d1 = e1 + (1.0f / 255.0f);
                            f32x4 y0, y1;
#pragma unroll
                            for (int k = 0; k < 4; ++k) { y0[k] = __builtin_amdgcn_rcpf(d0[k]); y1[k] = __builtin_amdgcn_rcpf(d1[k]); }
#pragma unroll
                            for (int k = 0; k < 4; ++k) { w.x = __builtin_amdgcn_cvt_pk_u8_f32(y0[k], k, w.x); w.y = __builtin_amdgcn_cvt_pk_u8_f32(y1[k], k, w.y); }
                            if (mm == 0) { w4.x = w.x; w4.y = w.y; } else { w4.z = w.x; w4.w = w.y; } }
                        *(u32x4*)(base + (l0 + (unsigned)((((ai * 2 + bj) * 2 + m2)) * 1024))) = w4; }
        }
    }
};
struct EpiGate2 {
    static constexpr bool PERM = true, PRE_LATE = false, HAS_MID = true, HAS_PRE = false, WIDE = true; struct Pre {};
    const unsigned char* G8; unsigned char* MG;
    static __device__ __forceinline__ void un8(const u32x2 w, float (&v)[8]) {
#pragma unroll
        for (int k = 0; k < 4; ++k) { v[k] = (float)((w.x >> (8 * k)) & 0xffu); v[4 + k] = (float)((w.y >> (8 * k)) & 0xffu); } }
    __device__ __forceinline__ void mid(Acc& acc, const Unit& u, int wr, int wc, int fr, int fq) const {
        const unsigned char* ga_b = G8 + ((size_t)u.pm * 8 + u.pn) * 65536 + (wr * 4 + wc) * 8192;
        const unsigned char* gc_b = ga_b + 4 * 65536;
        unsigned lg = (unsigned)((fr + 16 * fq) * 16); asm volatile("" : "+v"(lg));
        u32x4 ga[2][2][2], gc[2][2][2];
#pragma unroll
        for (int ai = 0; ai < 2; ++ai)
#pragma unroll
            for (int bj = 0; bj < 2; ++bj)
#pragma unroll
                for (int m2 = 0; m2 < 2; ++m2) { const unsigned o = lg + (unsigned)(((ai * 2 + bj) * 2 + m2) * 1024); ga[ai][bj][m2] = *(const u32x4*)(ga_b + o); gc[ai][bj][m2] = *(const u32x4*)(gc_b + o); }
        asm volatile("" ::: "memory");
#pragma unroll
        for (int ai = 0; ai < 2; ++ai) {
#pragma unroll
            for (int m = 0; m < 4; ++m)
#pragma unroll
                for (int bj = 0; bj < 2; ++bj) { float a8[8], c8[8]; const u32x4 ga4 = ga[ai][bj][m >> 1], gc4 = gc[ai][bj][m >> 1];
                    un8((m & 1) ? (u32x2){ga4.z, ga4.w} : (u32x2){ga4.x, ga4.y}, a8); un8((m & 1) ? (u32x2){gc4.z, gc4.w} : (u32x2){gc4.x, gc4.y}, c8);
#pragma unroll
                    for (int k = 0; k < 8; ++k) { const float r = a8[k] * (1.0f / 512.0f) * __builtin_amdgcn_rcpf(fmaxf(c8[k], 2.4318695068359375e-04f)); if (k < 4) acc[ai][bj][m][0][k] *= r; else acc[ai][bj][m][1][k - 4] *= r; } }
            asm volatile("" ::: "memory"); }
    }
    __device__ __forceinline__ void operator()(const Acc& acc, const Unit& u, int wr, int wc, int fr, int fq) const {
        const unsigned char* gc_b = G8 + ((size_t)u.pm * 8 + 4 + u.pn) * 65536 + (wr * 4 + wc) * 8192;
        unsigned char* ob = MG + (size_t)u.pm * BM * 1024 + u.pn * BM;
        unsigned lg = (unsigned)((fr + 16 * fq) * 16), lt = (unsigned)((wr * 64 + fr) * 1024 + wc * 64 + 8 * fq); asm volatile("" : "+v"(lg), "+v"(lt));
        u32x4 gc[2][2][2];
#pragma unroll
        for (int ai = 0; ai < 2; ++ai)
#pragma unroll
            for (int bj = 0; bj < 2; ++bj)
#pragma unroll
                for (int m2 = 0; m2 < 2; ++m2) gc[ai][bj][m2] = *(const u32x4*)(gc_b + (lg + (unsigned)(((ai * 2 + bj) * 2 + m2) * 1024)));
#pragma unroll
        for (int ai = 0; ai < 2; ++ai)
#pragma unroll
            for (int m = 0; m < 4; ++m)
#pragma unroll
                for (int bj = 0; bj < 2; ++bj) { float c8[8]; const u32x4 gc4 = gc[ai][bj][m >> 1]; un8((m & 1) ? (u32x2){gc4.z, gc4.w} : (u32x2){gc4.x, gc4.y}, c8); float v[8];
#pragma unroll
                    for (int k = 0; k < 8; ++k) v[k] = (k < 4 ? acc[ai][bj][m][0][k] : acc[ai][bj][m][1][k - 4]) * (fmaxf(c8[k], 2.4318695068359375e-04f) * (16.0f / 255.0f));
                    u32x2 w8; w8.x = pk4_fp8s(v[0], v[1], v[2], v[3]); w8.y = pk4_fp8s(v[4], v[5], v[6], v[7]);
                    *(u32x2*)(ob + (lt + (unsigned)((ai * HALF + m * 16) * 1024 + bj * 32))) = w8; }
    }
};
struct EpiRes {
    static constexpr bool PERM = true, PRE_LATE = false, HAS_MID = false, HAS_PRE = false, WIDE = true; struct Pre {};
    bf16_t* XO; const float* rrs; const LAS float* igl;
    __device__ __forceinline__ void operator()(const Acc& acc, const Unit& u, int wr, int wc, int fr, int fq) const {
        bf16_t* xb = XO + (size_t)u.pm * BM * D + u.pn * BM; const float* rb = rrs + u.pm * BM;
        unsigned l0 = (unsigned)((wr * 64 + fr) * D + wc * 64 + 8 * fq); int r0 = wr * 64 + fr; asm volatile("" : "+v"(l0), "+v"(r0));
        u32x4 xv[2][4][2]; float rr[2][4];
#pragma unroll
        for (int ai = 0; ai < 2; ++ai)
#pragma unroll
            for (int m = 0; m < 4; ++m) { rr[ai][m] = rb[(unsigned)(r0 + ai * HALF + m * 16)];
#pragma unroll
                for (int bj = 0; bj < 2; ++bj) xv[ai][m][bj] = __builtin_nontemporal_load((const u32x4*)(xb + (l0 + (unsigned)((ai * HALF + m * 16) * D + bj * 32)))); }
        asm volatile("" ::: "memory");
#pragma unroll
        for (int bj = 0; bj < 2; ++bj) { const LAS float* ip = igl + u.pn * BM + wc * 64 + 8 * fq + bj * 32; const f32x4 ia = *(const LAS f32x4*)ip, ib = *(const LAS f32x4*)(ip + 4);
            const float ig[8] = {ia.x, ia.y, ia.z, ia.w, ib.x, ib.y, ib.z, ib.w};
#pragma unroll
            for (int ai = 0; ai < 2; ++ai)
#pragma unroll
                for (int m = 0; m < 4; ++m) { float xn[8], v[8]; unpack8(xv[ai][m][bj], xn);
#pragma unroll
                    for (int k = 0; k < 8; ++k) v[k] = xn[k] * rr[ai][m] * ig[k] + (k < 4 ? acc[ai][bj][m][0][k] : acc[ai][bj][m][1][k - 4]) * (1.0f / 512.0f);
                    *(u32x4*)(xb + (l0 + (unsigned)((ai * HALF + m * 16) * D + bj * 32))) = pack8(v); } }
    }
};
struct EpiGU {
    static constexpr bool PERM = true, PRE_LATE = false, HAS_MID = false, HAS_PRE = true, WIDE = false; struct Pre {};
    unsigned char* HID; const f32x2* rsg; const LAS int* mtpre; LAS unsigned char* meta;
    __device__ __forceinline__ void pre(Pre&, const Unit& u, int wave, int lane) const {
        const int mt = u.pm - mtpre[u.z]; const unsigned pb = (unsigned)__builtin_amdgcn_readfirstlane((int)((unsigned)u.z * CAP + mt * 256));
        const __amdgpu_buffer_rsrc_t rs = __builtin_amdgcn_make_buffer_rsrc(const_cast<f32x2*>(rsg), 0, 0xffffffff, 0x00020000);
        const int wr = wave >> 2;
        unsigned vo = (unsigned)(wr * 64 + (lane >> 2) + 16 * (lane & 3)) * 8u + 4u; asm volatile("" : "+v"(vo));
#pragma unroll
        for (int ai = 0; ai < 2; ++ai) __builtin_amdgcn_raw_ptr_buffer_load_lds(rs, (LAS void*)(meta + wave * 512 + ai * 256), 4, (int)(vo + (unsigned)(ai * HALF * 8)), (int)(pb * 8u), 0, 0);
    }
    __device__ __forceinline__ void operator()(const Acc& acc, const Unit& u, int wr, int wc, int fr, int fq, const Pre&) const {
        unsigned char* hb = HID + (size_t)u.pm * 256 * 256 + u.pn * 128;
        int r0 = wr * 64 + fr; asm volatile("" : "+v"(r0)); const unsigned l0 = (unsigned)(r0 * 256 + wc * 32 + 8 * fq);
#pragma unroll
        for (int ai = 0; ai < 2; ++ai) { const f32x4 r4 = *(const LAS f32x4*)(meta + (wr * 4 + wc) * 512 + ai * 256 + fr * 16);
#pragma unroll
            for (int m = 0; m < 4; ++m) { const int r = r0 + ai * HALF + m * 16; const bool ok = r < u.valid;
                const float rs = (ok ? r4[m] : 1.f) * 0.03125f, c1 = -1.4426950408889634f * rs; const float ir = __builtin_amdgcn_rcpf(rs), kinv = 0.0625f * ir * ir;
                const f32x4 ag0 = acc[ai][0][m][0], ag1 = acc[ai][0][m][1], au0 = acc[ai][1][m][0], au1 = acc[ai][1][m][1];
                const f32x4 t0 = ag0 * c1, t1 = ag1 * c1; f32x4 e0, e1, y0, y1;
#pragma unroll
                for (int k = 0; k < 4; ++k) { e0[k] = __builtin_amdgcn_exp2f(t0[k]); e1[k] = __builtin_amdgcn_exp2f(t1[k]); }
                const f32x4 d0 = e0 * kinv + kinv, d1 = e1 * kinv + kinv;
#pragma unroll
                for (int k = 0; k < 4; ++k) { y0[k] = __builtin_amdgcn_rcpf(d0[k]); y1[k] = __builtin_amdgcn_rcpf(d1[k]); }
                const f32x4 h0 = ag0 * au0 * y0, h1 = ag1 * au1 * y1;
                u32x2 w; w.x = pk4_fp8(h0[0], h0[1], h0[2], h0[3]); w.y = pk4_fp8(h1[0], h1[1], h1[2], h1[3]);
                w.x = ok ? w.x : 0u; w.y = ok ? w.y : 0u;
                *(u32x2*)(hb + (l0 + (unsigned)((ai * HALF + m * 16) * 256))) = w; } }
    }
};
struct EpiDown {
    static constexpr bool PERM = true, PRE_LATE = false, HAS_MID = false, HAS_PRE = true, WIDE = true; struct Pre {};
    unsigned char* Y; const int* asg; const f32x2* rsg; const LAS int* mtpre; LAS unsigned char* meta;
    __device__ __forceinline__ void pre(Pre&, const Unit& u, int wave, int lane) const {
        const int mt = u.pm - mtpre[u.z]; const unsigned pb = (unsigned)__builtin_amdgcn_readfirstlane((int)((unsigned)u.z * CAP + mt * 256)); const int wr = wave >> 2;
        const __amdgpu_buffer_rsrc_t rsa = __builtin_amdgcn_make_buffer_rsrc(const_cast<int*>(asg), 0, 0xffffffff, 0x00020000), rsr = __builtin_amdgcn_make_buffer_rsrc(const_cast<f32x2*>(rsg), 0, 0xffffffff, 0x00020000);
        unsigned row = (unsigned)(wr * 64 + (lane >> 2) + 16 * (lane & 3)); asm volatile("" : "+v"(row));
#pragma unroll
        for (int ai = 0; ai < 2; ++ai) {
            __builtin_amdgcn_raw_ptr_buffer_load_lds(rsa, (LAS void*)(meta + wave * 1024 + ai * 256), 4, (int)((row + (unsigned)(ai * HALF)) * 4u), (int)(pb * 4u), 0, 0);
            __builtin_amdgcn_raw_ptr_buffer_load_lds(rsr, (LAS void*)(meta + wave * 1024 + 512 + ai * 256), 4, (int)((row + (unsigned)(ai * HALF)) * 8u), (int)(pb * 8u), 0, 0); }
    }
    __device__ __forceinline__ void operator()(const Acc& acc, const Unit& u, int wr, int wc, int fr, int fq, const Pre&) const {
        unsigned char* yb = Y + u.pn * BM;
        int r0 = wr * 64 + fr; unsigned c0 = (unsigned)(wc * 64 + 8 * fq); asm volatile("" : "+v"(r0), "+v"(c0));
#pragma unroll
        for (int ai = 0; ai < 2; ++ai) { const LAS unsigned char* mb = meta + (wr * 4 + wc) * 1024 + ai * 256 + fr * 16;
            const u32x4 a4 = *(const LAS u32x4*)mb; const f32x4 g4 = *(const LAS f32x4*)(mb + 512);
#pragma unroll
            for (int m = 0; m < 4; ++m) { const int r = r0 + ai * HALF + m * 16;
                if (r < u.valid) { const float gt = g4[m] * (16.0f / (16.0f * 32.0f));
#pragma unroll
                    for (int bj = 0; bj < 2; ++bj) { const f32x4 v0 = acc[ai][bj][m][0] * gt, v1 = acc[ai][bj][m][1] * gt;
                        u32x2 w; w.x = pk4_fp8(v0[0], v0[1], v0[2], v0[3]); w.y = pk4_fp8(v1[0], v1[1], v1[2], v1[3]);
                        *(u32x2*)(yb + (a4[m] * 1024u + c0 + (unsigned)(bj * 32))) = w; } } } }
    }
};

typedef int v8i_t __attribute__((ext_vector_type(8)));
typedef int v4i_t __attribute__((ext_vector_type(4)));
__device__ __forceinline__ v8i_t cat8(bf16x8 a, bf16x8 b) { return __builtin_shufflevector(__builtin_bit_cast(v4i_t, a), __builtin_bit_cast(v4i_t, b), 0, 1, 2, 3, 4, 5, 6, 7); }
template <class Epi, class Sched, bool ALIGN_EPI, bool NOUNROLL = false, bool FP8 = false, int NF8 = 0, int NSR = 0>
__device__ __forceinline__ void gemm_phase(LAS unsigned char* lds, const int wave, const int K, const int lda, const int ldb, const Sched& S, const Epi& E, const int lda8 = 0, const int ldb8 = 0) {
    int lane = lane_id(); asm volatile("" : "+v"(lane));
    const int wid = wave, tid = wave * 64 + lane, wr = wid >> 2, wc = wid & 3, fr = lane & 15, fq = lane >> 4;
    const int nt = K / BK;
    int sR[2], sC[2]; unsigned voffB[2];
#pragma unroll
    for (int i = 0; i < 2; ++i) { int R, C; stage_rc(tid * 16 + i * 8192, R, C); sR[i] = R; sC[i] = C; const int Rb = !Epi::PERM ? R : Epi::WIDE ? ((R >> 5) * 64 + perm32(R & 31)) : ((R & ~31) + perm32(R & 31));
        voffB[i] = (unsigned)(Rb * ldb + C) * 2u; }
    const unsigned kstep = (unsigned)(BK * 2);
    const unsigned hB = (unsigned)(Epi::WIDE ? 32 : HALF) * ldb * 2, hA = Sched::GATHER ? 0u : (unsigned)HALF * lda * 2;
    const void* baseA_; const void* baseB_; S.bases(baseA_, baseB_);
    const __amdgpu_buffer_rsrc_t rsA = __builtin_amdgcn_make_buffer_rsrc(const_cast<void*>(baseA_), 0, 0xffffffff, 0x00020000), rsB = __builtin_amdgcn_make_buffer_rsrc(const_cast<void*>(baseB_), 0, 0xffffffff, 0x00020000);
    unsigned voffB8[2] = {0u, 0u}, cv8[2] = {0u, 0u}; unsigned hA8 = 0u, hB8 = 0u; __amdgpu_buffer_rsrc_t rsA8 = rsA, rsB8 = rsB;
    if constexpr (NF8 > 0) { const void* a8_; const void* b8_; S.bases8(a8_, b8_);
        rsA8 = __builtin_amdgcn_make_buffer_rsrc(const_cast<void*>(a8_), 0, 0xffffffff, 0x00020000); rsB8 = __builtin_amdgcn_make_buffer_rsrc(const_cast<void*>(b8_), 0, 0xffffffff, 0x00020000);
        hA8 = (unsigned)HALF * lda8 * 2; hB8 = (unsigned)(Epi::WIDE ? 32 : HALF) * ldb8 * 2;
#pragma unroll
        for (int i = 0; i < 2; ++i) { const int Rb = !Epi::PERM ? sR[i] : Epi::WIDE ? ((sR[i] >> 5) * 64 + perm32(sR[i] & 31)) : ((sR[i] & ~31) + perm32(sR[i] & 31)); voffB8[i] = (unsigned)(Rb * ldb8 + sC[i]) * 2u; cv8[i] = (unsigned)(sR[i] * lda8 + sC[i]) * 2u; } }
    const unsigned ldsw = (unsigned)wid * 1024u;
    LAS unsigned char* abase = lds + lds_byte(wr * 64 + fr, fq * 8); LAS unsigned char* bbase = lds + 65536 + lds_byte(wc * 32 + fr, fq * 8);
    asm volatile("" : "+v"(abase), "+v"(bbase));
#define PG8_SA(b, h) (((b) * 2 + (h)) * HTB)
#define PG8_SB(b, h) ((4 + (b) * 2 + (h)) * HTB)
#define PG8_STAGE(bufoff, rs, soff, v0, v1) do { \
        __builtin_amdgcn_raw_ptr_buffer_load_lds(rs, (LAS void*)(lds + (bufoff) + ldsw), 16, (int)(v0), (int)(soff), 0, 0); \
        __builtin_amdgcn_raw_ptr_buffer_load_lds(rs, (LAS void*)(lds + (bufoff) + ldsw + 8192), 16, (int)(v1), (int)(soff), 0, 0); } while (0)
#define PG8_STB(bufoff, k, nx, h) do { if (NF8 > 0 && (k) < NF8) PG8_STAGE(bufoff, rsB8, ((nx) ? nB8 : cB8) + (unsigned)(k) * kstep + (h) * hB8, voffB8[0], voffB8[1]); \
        else PG8_STAGE(bufoff, rsB, ((nx) ? nB : cB) + (unsigned)((k) - NF8) * kstep + (h) * hB, voffB[0], voffB[1]); } while (0)
#define PG8_STA(bufoff, k, nx, h) do { if (NF8 > 0 && (k) < NF8) PG8_STAGE(bufoff, rsA8, ((nx) ? nA8 : cA8) + (unsigned)(k) * kstep + (h) * hA8, cv8[0], cv8[1]); \
        else PG8_STAGE(bufoff, rsA, ((nx) ? nA : cA) + (unsigned)((k) - NF8) * kstep + (h) * hA, cv[Sched::GATHER ? (h) : 0][0], cv[Sched::GATHER ? (h) : 0][1]); } while (0)
#define PG8_LD1(base, off) (*(const LAS bf16x8*)((base) + (off)))
#define PG8_LDA(dst, b, h) do { _Pragma("unroll") for (int m = 0; m < 4; ++m) dst[m] = cat8(PG8_LD1(abase, PG8_SA(b, h) + m * 2048), PG8_LD1(abase, PG8_SA(b, h) + m * 2048 + 1024)); } while (0)
#define PG8_LDB(dst, b, h) do { _Pragma("unroll") for (int n = 0; n < 2; ++n) dst[n] = cat8(PG8_LD1(bbase, PG8_SB(b, h) - 65536 + n * 2048), PG8_LD1(bbase, PG8_SB(b, h) - 65536 + n * 2048 + 1024)); } while (0)
#define PG8_HALF(v, k) __builtin_bit_cast(bf16x8, __builtin_shufflevector(v, v, 4 * (k), 4 * (k) + 1, 4 * (k) + 2, 4 * (k) + 3))
#define PG8_MMA(F8, ai, bj, At, Bt) do { __builtin_amdgcn_s_setprio(1); _Pragma("unroll") for (int m = 0; m < 4; ++m) _Pragma("unroll") for (int n = 0; n < 2; ++n) { \
        if constexpr (F8) acc[ai][bj][m][n] = __builtin_amdgcn_mfma_scale_f32_16x16x128_f8f6f4(Bt[n], At[m], acc[ai][bj][m][n], 0, 0, 0, 0, 0, 0); \
        else { acc[ai][bj][m][n] = __builtin_amdgcn_mfma_f32_16x16x32_bf16(PG8_HALF(Bt[n], 0), PG8_HALF(At[m], 0), acc[ai][bj][m][n], 0, 0, 0); \
               acc[ai][bj][m][n] = __builtin_amdgcn_mfma_f32_16x16x32_bf16(PG8_HALF(Bt[n], 1), PG8_HALF(At[m], 1), acc[ai][bj][m][n], 0, 0, 0); } } __builtin_amdgcn_s_setprio(0); } while (0)
#define PG8_WAIT_V(n) asm volatile("s_waitcnt vmcnt(" #n ")" ::: "memory")
#define PG8_WAIT_L(n) asm volatile("s_waitcnt lgkmcnt(" #n ")" ::: "memory")
#define PG8_LATE do { if constexpr (Epi::HAS_PRE && Epi::PRE_LATE) { if (relax) E.pre(pre, cur, wid, lane_id()); } } while (0)
#define PG8_WAIT_VR do { if (NSR > 0 && relax) { if constexpr (NSR >= 16) asm volatile("s_waitcnt vmcnt(24)" ::: "memory"); else asm volatile("s_waitcnt vmcnt(16)" ::: "memory"); } else PG8_WAIT_V(8); } while (0)
#define PG8_BAR __builtin_amdgcn_s_barrier()
#define PG8_SCHED __builtin_amdgcn_sched_barrier(0)
#define PG8_TRIP(F8) do { \
        PG8_LDB(B0, 0, 0); PG8_LDB(B1, 0, 1); PG8_SCHED; PG8_LDA(At, 0, 0); PG8_STA(PG8_SA(1, 1), k1, false, 1); \
        if (Sched::GATHER) { if (last && has_next) { cv[1][0] = nv[1][0]; cv[1][1] = nv[1][1]; } } \
        PG8_WAIT_VR; PG8_WAIT_L(0); PG8_BAR; PG8_LATE; PG8_MMA(F8, 0, 0, At, B0); PG8_MMA(F8, 0, 1, At, B1); PG8_BAR; PG8_SCHED; \
        PG8_LDA(At, 0, 1); PG8_STB(PG8_SB(0, 0), k2, last, 0); PG8_STB(PG8_SB(0, 1), k2, last, 1); PG8_STA(PG8_SA(0, 0), k2, last, 0); \
        PG8_WAIT_VR; PG8_WAIT_L(0); PG8_BAR; PG8_MMA(F8, 1, 0, At, B0); PG8_MMA(F8, 1, 1, At, B1); PG8_BAR; PG8_SCHED; \
        PG8_LDB(B0, 1, 0); PG8_LDB(B1, 1, 1); PG8_SCHED; PG8_LDA(At, 1, 0); PG8_STA(PG8_SA(0, 1), k2, last, 1); \
        PG8_WAIT_V(8); PG8_WAIT_L(0); PG8_BAR; PG8_MMA(F8, 0, 0, At, B0); PG8_MMA(F8, 0, 1, At, B1); PG8_BAR; PG8_SCHED; \
        PG8_LDA(At, 1, 1); PG8_STB(PG8_SB(1, 0), k3, last, 0); PG8_STB(PG8_SB(1, 1), k3, last, 1); PG8_STA(PG8_SA(1, 0), k3, last, 0); \
        PG8_WAIT_V(8); PG8_WAIT_L(0); PG8_BAR; PG8_MMA(F8, 1, 0, At, B0); PG8_MMA(F8, 1, 1, At, B1); PG8_BAR; PG8_SCHED; } while (0)
    Unit cur, nxt; int ui = 0;
    if (!S.next(0, cur)) return;
    Acc acc;
#pragma unroll
    for (int a = 0; a < 2; ++a)
#pragma unroll
        for (int b = 0; b < 2; ++b)
#pragma unroll
            for (int m = 0; m < 4; ++m)
#pragma unroll
                for (int n = 0; n < 2; ++n) acc[a][b][m][n] = (f32x4){0.f, 0.f, 0.f, 0.f};
    v8i_t At[4], B0[2], B1[2];
    unsigned cA, cB; S.offs(cur, cA, cB);
    unsigned cA8 = 0u, cB8 = 0u, nA8 = 0u, nB8 = 0u; if constexpr (NF8 > 0) S.offs8(cur, cA8, cB8);
    unsigned nA = cA, nB = cB; nA8 = cA8; nB8 = cB8;
    typename Epi::Pre pre; if constexpr (Epi::HAS_PRE) E.pre(pre, cur, wid, lane);
    unsigned cv[2][2];
    PG8_STB(PG8_SB(0, 0), 0, false, 0); PG8_STB(PG8_SB(0, 1), 0, false, 1); S.avoff(cur, sR, sC, cv); PG8_STA(PG8_SA(0, 0), 0, false, 0); PG8_STA(PG8_SA(0, 1), 0, false, 1);
    if (wr == 1) PG8_BAR;
    PG8_WAIT_V(2); PG8_BAR;
    PG8_STB(PG8_SB(1, 0), 1, false, 0); PG8_STA(PG8_SA(1, 0), 1, false, 0); PG8_STB(PG8_SB(1, 1), 1, false, 1);
    PG8_WAIT_V(6); PG8_BAR;
    for (;;) {
        const bool has_next = S.next(ui + 1, nxt);
        nA = cA; nB = cB; nA8 = cA8; nB8 = cB8;
        if (has_next) { S.offs(nxt, nA, nB); if constexpr (NF8 > 0) S.offs8(nxt, nA8, nB8); if constexpr (Sched::GATHER) S.prefetch_ids(nxt, wid, lane_id()); }
        if constexpr (NF8 > 0) {
            for (int t = 0; t < NF8; t += 2) { asm volatile("" : "+s"(t)); const bool last = false; const bool relax = (t == 0) && (ui > 0); unsigned nv[2][2]; const int k1 = t + 1, k2 = t + 2, k3 = t + 3; PG8_TRIP(true); }
            if constexpr (Epi::HAS_MID) { const int l2 = lane_id(); E.mid(acc, cur, wr, wc, l2 & 15, l2 >> 4); }
            for (int t = NF8; t < nt; t += 2) { asm volatile("" : "+s"(t)); const bool last = (t == nt - 2); const bool relax = false; unsigned nv[2][2]; const int k1 = t + 1, k2 = last ? 0 : t + 2, k3 = last ? 1 : t + 3; PG8_TRIP(false); }
        } else {
        for (int t = 0; t < nt; t += 2) {
            if constexpr (NOUNROLL) asm volatile("" : "+s"(t));
            const bool last = (t == nt - 2); const bool relax = (t == 0) && (ui > 0);
            if constexpr (Epi::HAS_MID) { if (t == (nt >> 1)) { const int l2 = lane_id(); E.mid(acc, cur, wr, wc, l2 & 15, l2 >> 4); } }
            unsigned nv[2][2];
            if constexpr (Sched::GATHER) { if (last && has_next) { int sR2[2], sC2[2]; int tid2 = wave * 64 + lane_id(); asm volatile("" : "+v"(tid2));
#pragma unroll
                for (int i = 0; i < 2; ++i) stage_rc(tid2 * 16 + i * 8192, sR2[i], sC2[i]);
                S.avoff_lds(nxt, sR2, sC2, nv); cv[0][0] = nv[0][0]; cv[0][1] = nv[0][1]; } }
            const int k1 = t + 1, k2 = last ? 0 : t + 2, k3 = last ? 1 : t + 3;
            PG8_TRIP(FP8);
        } }
        if constexpr (ALIGN_EPI) { if (wr == 0) PG8_BAR; }
        { const int l2 = lane_id(); if constexpr (Epi::HAS_PRE) E(acc, cur, wr, wc, l2 & 15, l2 >> 4, pre); else E(acc, cur, wr, wc, l2 & 15, l2 >> 4); }
        if (!has_next) break;
#pragma unroll
        for (int a = 0; a < 2; ++a)
#pragma unroll
            for (int b = 0; b < 2; ++b)
#pragma unroll
                for (int m = 0; m < 4; ++m)
#pragma unroll
                    for (int n = 0; n < 2; ++n) acc[a][b][m][n] = (f32x4){0.f, 0.f, 0.f, 0.f};
        cur = nxt; cA = nA; cB = nB; cA8 = nA8; cB8 = nB8; ++ui;
        if constexpr (Epi::HAS_PRE && !Epi::PRE_LATE) E.pre(pre, cur, wid, lane_id());
        if constexpr (ALIGN_EPI) { if (wr == 1) PG8_BAR; }
    }
    PG8_WAIT_V(0);
    if constexpr (!ALIGN_EPI) { if (wr == 0) PG8_BAR; }
    PG8_BAR;
#undef PG8_SA
#undef PG8_SB
#undef PG8_STAGE
#undef PG8_STA
#undef PG8_STB
#undef PG8_LD1
#undef PG8_HALF
#undef PG8_LDA
#undef PG8_LDB
#undef PG8_MMA
#undef PG8_TRIP
#undef PG8_WAIT_V
#undef PG8_WAIT_L
#undef PG8_WAIT_VR
#undef PG8_LATE
#undef PG8_BAR
#undef PG8_SCHED
}
}

#ifndef MK_USE_CG
#define MK_USE_CG 0
#endif
#define XB_TMO      128
#define XB_XCNT(j)  (256  + 64 * (j))
#define XB_XSUB(j)  (1280 + 64 * (j))
#define XB_XGEN(j)  (2304 + 64 * (j))
#define XB_TOP      3328
#define XB_TOPGEN   3392
#define XCD_BAR_WORDS 3456
#define XB_SPIN_CAP (1u << 18)
__device__ __forceinline__ unsigned xb_ld(unsigned* p)              { return __hip_atomic_load(p, __ATOMIC_RELAXED, __HIP_MEMORY_SCOPE_AGENT); }
__device__ __forceinline__ unsigned xb_add(unsigned* p, unsigned v) { return __hip_atomic_fetch_add(p, v, __ATOMIC_RELAXED, __HIP_MEMORY_SCOPE_AGENT); }
__device__ __forceinline__ unsigned xb_xcc_id() { return (unsigned)__builtin_amdgcn_s_getreg((3 << 11) | 20) & 0xFu; }
#define XB_SPIN(cond, bar) do { unsigned _sp = 0; while (cond) { __builtin_amdgcn_s_sleep(1); \
    if ((++_sp & 255u) == 0u) { if (xb_ld(&(bar)[XB_TMO])) break; if (_sp > XB_SPIN_CAP) { atomicAdd(&(bar)[XB_TMO], 1u); break; } } } } while (0)
struct XcdBarrier { unsigned* bar; unsigned x; volatile LAS unsigned* st; int wave; };
__device__ __forceinline__ XcdBarrier xcd_barrier_post(unsigned* bar, volatile LAS unsigned* st, int wave) {
    XcdBarrier b; b.bar = bar; b.x = xb_xcc_id(); b.st = st; b.wave = wave;
    if (wave == 0 && lane_id() == 0) (void)xb_add(&bar[XB_XCNT(b.x)], 1u);
    return b;
}
__device__ __forceinline__ void xcd_barrier_complete(unsigned* bar, unsigned x, unsigned& nloc, unsigned& nx) {
    const unsigned G = gridDim.x * gridDim.y * gridDim.z;
    unsigned sum, cnt, mine, sp = 0u;
    for (;;) {
        sum = 0u; cnt = 0u; mine = 0u;
        unsigned c[16];
#pragma unroll
        for (unsigned j = 0; j < 16; ++j) c[j] = xb_ld(&bar[XB_XCNT(j)]);
        asm volatile("" : "+v"(c[0]), "+v"(c[1]), "+v"(c[2]), "+v"(c[3]), "+v"(c[4]), "+v"(c[5]), "+v"(c[6]), "+v"(c[7]), "+v"(c[8]), "+v"(c[9]), "+v"(c[10]), "+v"(c[11]), "+v"(c[12]), "+v"(c[13]), "+v"(c[14]), "+v"(c[15]));
#pragma unroll
        for (unsigned j = 0; j < 16; ++j) { sum += c[j]; cnt += (c[j] > 0u) ? 1u : 0u; mine = (j == x) ? c[j] : mine; }
        if (sum == G) break;
        __builtin_amdgcn_s_sleep(1);
        if ((++sp & 255u) == 0u) { if (xb_ld(&bar[XB_TMO])) break; if (sp > XB_SPIN_CAP) { atomicAdd(&bar[XB_TMO], 1u); break; } }
    }
    nloc = mine > 0u ? mine : 1u; nx = cnt > 0u ? cnt : 1u;
}
__device__ __forceinline__ void xcd_barrier(const XcdBarrier& b) {
    asm volatile("s_waitcnt vmcnt(0)" ::: "memory");
    __syncthreads();
    if (b.wave == 0 && lane_id() == 0) {
        unsigned* bar = b.bar;
        __builtin_amdgcn_s_waitcnt(0);
        unsigned nloc = b.st[0], nx = b.st[1];
        if (nloc == 0u) { xcd_barrier_complete(bar, b.x, nloc, nx); b.st[0] = nloc; b.st[1] = nx; }
        const unsigned old = xb_add(&bar[XB_XSUB(b.x)], 1u);
        const unsigned gen = old / nloc;
        if (old + 1u == (gen + 1u) * nloc) {
            __builtin_amdgcn_fence(__ATOMIC_RELEASE, "agent");
            asm volatile("s_waitcnt vmcnt(0)" ::: "memory");
            const unsigned og = xb_add(&bar[XB_TOP], 1u);
            const unsigned tg = og / nx;
            if (og + 1u != (tg + 1u) * nx) XB_SPIN(xb_ld(&bar[XB_TOP]) / nx == tg, bar);
            __builtin_amdgcn_fence(__ATOMIC_ACQUIRE, "agent");
            xb_add(&bar[XB_XGEN(b.x)], 1u);
            asm volatile("s_waitcnt vmcnt(0)" ::: "memory");
        } else {
            XB_SPIN(xb_ld(&bar[XB_XGEN(b.x)]) == gen, bar);
            __builtin_amdgcn_fence(__ATOMIC_ACQUIRE, "agent");
            asm volatile("s_waitcnt vmcnt(0)" ::: "memory");
        }
    }
    __syncthreads();
}

struct Args {
    const float* in[19]; float* out; unsigned char* ws; int ph_lo, ph_hi; int rep[10];
};
struct Frame {
    LAS unsigned char* lds; int tid, lane, wave, G, vcu;
};

__device__ __forceinline__ void tr_item(const float* W, int ldw, int k0, int n0, bf16_t* WT, int ldt, int drow0, LAS float* scr, int lane) {
    float tv[32];
#pragma unroll
    for (int i = 0; i < 32; ++i) { const int kk = 2 * i + (lane >> 5); tv[i] = __builtin_nontemporal_load(W + (size_t)(k0 + kk) * ldw + n0 + (lane & 31)); }
#pragma unroll
    for (int i = 0; i < 32; ++i) { const int kk = 2 * i + (lane >> 5); scr[kk * 33 + (lane & 31)] = tv[i]; }
    LDS_WAIT(); asm volatile("" ::: "memory");
    const int c = lane & 7;
#pragma unroll
    for (int j = 0; j < 4; ++j) { const int n = (lane >> 3) + 8 * j; const LAS float* s = scr + (8 * c) * 33 + n;
        u32x4 o; o.x = cvtpk(s[0 * 33], s[1 * 33]); o.y = cvtpk(s[2 * 33], s[3 * 33]); o.z = cvtpk(s[4 * 33], s[5 * 33]); o.w = cvtpk(s[6 * 33], s[7 * 33]);
        *(u32x4*)(WT + (size_t)(drow0 + n) * ldt + k0 + 8 * c) = o; }
    LDS_WAIT(); asm volatile("" ::: "memory");
}
__device__ __forceinline__ void tr_item8(const float* W, int ldw, int k0, int n0, unsigned char* WT, int ldt, int drow0, float scale, LAS float* scr, int lane) {
    float tv[32];
#pragma unroll
    for (int i = 0; i < 32; ++i) { const int kk = 2 * i + (lane >> 5); tv[i] = __builtin_nontemporal_load(W + (size_t)(k0 + kk) * ldw + n0 + (lane & 31)); }
#pragma unroll
    for (int i = 0; i < 32; ++i) { const int kk = 2 * i + (lane >> 5); scr[kk * 33 + (lane & 31)] = tv[i] * scale; }
    LDS_WAIT(); asm volatile("" ::: "memory");
    const int c = lane & 7;
#pragma unroll
    for (int j = 0; j < 4; ++j) { const int n = (lane >> 3) + 8 * j; const LAS float* s = scr + (8 * c) * 33 + n;
        u32x2 o; o.x = pk4_fp8(s[0 * 33], s[1 * 33], s[2 * 33], s[3 * 33]); o.y = pk4_fp8(s[4 * 33], s[5 * 33], s[6 * 33], s[7 * 33]);
        *(u32x2*)(WT + (size_t)(drow0 + n) * ldt + k0 + 8 * c) = o; }
    LDS_WAIT(); asm volatile("" ::: "memory");
}
constexpr int I_IN = 16 * 136, I_A = 8 * 32, I_OUT = 16 * 32, I_G = 32 * 128, I_D = 32 * 128;
constexpr int I_SMALL = I_IN + 2 * I_A + I_OUT, NITEMS = I_SMALL + 2 * I_G + I_D;
__device__ __forceinline__ void convert_items(const Frame& F, const Args& a, int first, int last, int worker, int nworkers) {
    unsigned char* ws = a.ws;
    LAS float* scr = (LAS float*)(F.lds + F.wave * 16384);
    const float* w_in = a.in[2]; const float* w_a = a.in[8]; const float* w_c = a.in[9]; const float* w_out = a.in[10];
    const float* w_gate = a.in[16]; const float* w_up = a.in[17]; const float* w_down = a.in[18];
    bf16_t* WinT = (bf16_t*)(ws + WS_WIN); bf16_t* WaT = (bf16_t*)(ws + WS_WA); bf16_t* WoutT = (bf16_t*)(ws + WS_WOUT);
    bf16_t* WguT = (bf16_t*)(ws + WS_WGU); bf16_t* WdT = (bf16_t*)(ws + WS_WD);
    for (int it = first + worker * NWAVES + F.wave; it < last; it += nworkers * NWAVES) {
        int r = it;
        if (r < I_IN) { const int kb = r / 136, nb = r % 136, n0 = 32 * nb;
            if (n0 >= C_CB && n0 < C_GA) { int drow = n0;
                if (n0 >= C_CC) { const int cx = n0 >= C_CX, ch = n0 - (cx ? C_CX : C_CC); drow = C_CC + (ch >> 7) * 256 + ((ch >> 5) & 3) * 64 + cx * 32 + (ch & 31); }
                tr_item(w_in, PW, 64 * kb, n0, WinT, 1024, drow, scr, F.lane); }
            else tr_item8(w_in, PW, 64 * kb, n0, ws + WS_WIN8, 1024, n0, WIN8_SCALE, scr, F.lane);
            continue; } r -= I_IN;
        if (r < I_A) { const int kb = r / 32, nb = r % 32; tr_item8(w_a, 1024, 64 * kb, 32 * nb, ws + WS_WA, 512, 32 * nb, 32.0f, scr, F.lane); continue; } r -= I_A;
        if (r < I_A) { const int kb = r / 32, nb = r % 32; tr_item(w_c, 1024, 64 * kb, 32 * nb, (bf16_t*)(ws + WS_WC), 512, 32 * nb, scr, F.lane); continue; } r -= I_A;
        if (r < I_OUT) { const int kb = r / 32, nb = r % 32; tr_item8(w_out, 1024, 64 * kb, 32 * nb, ws + WS_WOUT, 1024, 32 * nb, 32.0f, scr, F.lane); continue; } r -= I_OUT;
        if (r < 2 * I_G) { const int up = r >= I_G; if (up) r -= I_G; const int e = r / 128, q = r % 128, kb = q / 8, nb = q % 8, n0 = 32 * nb;
            tr_item8((up ? w_up : w_gate) + (size_t)e * 1024 * 256, 256, 64 * kb, n0, (unsigned char*)WguT + (size_t)e * 512 * 1024, 1024, (n0 >> 7) * 256 + up * 128 + (n0 & 127), 32.0f, scr, F.lane); continue; } r -= 2 * I_G;
        { const int e = r / 128, q = r % 128, kb = q / 32, nb = q % 32; tr_item8(w_down + (size_t)e * 256 * 1024, 1024, 64 * kb, 32 * nb, (unsigned char*)WdT + (size_t)e * 1024 * 256, 256, 32 * nb, 32.0f, scr, F.lane); }
    }
}
__device__ __forceinline__ void p0_prologue(const Frame& F, const Args& a) {
    unsigned char* ws = a.ws;
    const int gw = F.vcu * NWAVES + F.wave, NGW = F.G * NWAVES;
    const int gt = F.vcu * NTHREADS + F.tid, NGT = F.G * NTHREADS;
    { const float* w_rg = a.in[12]; const float* w_re = a.in[14]; bf16_t* WrT = (bf16_t*)(ws + WS_WR);
      for (int i = gt; i < 48 * 1024; i += NGT) { const int j = i >> 10, k = i & 1023; float v = 0.f; if (j < 4) v = w_rg[k * 4 + j]; else if (j < 36) v = w_re[k * 32 + (j - 4)]; WrT[i] = f2bf(v); } }
    { float* cosT = (float*)(ws + WS_ROPE); float* sinT = cosT + SEQ * 8;
      for (int i = F.vcu + F.G * F.tid; i < SEQ * 8; i += F.G * NTHREADS) { const int pos = i >> 3, j = i & 7; const float inv = exp2f(-(float)j * (0.125f * 18.931568569324174f));
          const float ang = (float)pos * inv; float sn, cs; sincosf(ang, &sn, &cs); cosT[i] = cs; sinT[i] = sn; } }
    { const float* x = a.in[0]; const float* g1 = a.in[1]; bf16_t* XN = (bf16_t*)(ws + WS_XN);
      f32x4 gv[4];
#pragma unroll
      for (int j = 0; j < 4; ++j) gv[j] = ((const f32x4*)g1)[F.lane + 64 * j];
      int cit = 0;
      for (int m0 = gw; m0 < M; m0 += 8 * NGW) { f32x4 v[8][4];
#pragma unroll
          for (int q = 0; q < 8; ++q) { const int m = m0 + q * NGW; const f32x4* xr = (const f32x4*)(x + (size_t)(m < M ? m : 0) * D) + F.lane;
#pragma unroll
              for (int j = 0; j < 4; ++j) v[q][j] = __builtin_nontemporal_load(xr + 64 * j); }
          { const int first = cit * NGW; if (first < I_SMALL) convert_items(F, a, first, (first + NGW < I_SMALL) ? first + NGW : I_SMALL, F.vcu, F.G); ++cit; }
#pragma unroll
          for (int q = 0; q < 8; ++q) { const int m = m0 + q * NGW; float s = 0.f;
#pragma unroll
              for (int j = 0; j < 4; ++j) s += (v[q][j].x * v[q][j].x + v[q][j].y * v[q][j].y) + (v[q][j].z * v[q][j].z + v[q][j].w * v[q][j].w);
              const float rstd = rsqrtf(wave_sum(s) * (1.f / D) + EPS);
              if (m < M && F.lane == 0) ((float*)(ws + WS_RRS))[m] = 1.0f / rstd;
              if (m < M) { u32x2* o8 = (u32x2*)(XN + (size_t)m * D) + F.lane;
#pragma unroll
                  for (int j = 0; j < 4; ++j) { const float h0 = v[q][j].x * rstd * gv[j].x, h1 = v[q][j].y * rstd * gv[j].y, h2 = v[q][j].z * rstd * gv[j].z, h3 = v[q][j].w * rstd * gv[j].w;
                      u32x2 w; w.x = cvtpk(h0, h1); w.y = cvtpk(h2, h3); o8[64 * j] = w;
                      ((unsigned*)(ws + WS_XN8 + (size_t)m * D))[F.lane + 64 * j] = pk4_fp8(h0, h1, h2, h3); } } } }
      for (int first = cit * NGW; first < I_SMALL; first += NGW) convert_items(F, a, first, (first + NGW < I_SMALL) ? first + NGW : I_SMALL, F.vcu, F.G); }
}

namespace att {
constexpr int NSLOT = 8, WSOFF = RING_BYTES + 1024, OSTOFF = WSOFF + 2048, CWOFF = OSTOFF + 8 * 2048, QGOFF = CWOFF + 8192;
static_assert(QGOFF + 256 <= LDS_BYTES, "attention LDS map");
__device__ __forceinline__ int crow(int r, int hi) { return (r & 3) + 8 * (r >> 2) + 4 * hi; }
__device__ __forceinline__ s16x4 vtr(const LAS char* p) { return __builtin_bit_cast(s16x4, __builtin_amdgcn_ds_read_tr16_b64_v4i16((LAS s16x4*)p)); }
}
template <int CTRL> __device__ __forceinline__ float dpp_f(float x) { return __builtin_bit_cast(float, __builtin_amdgcn_mov_dpp(__builtin_bit_cast(int, x), CTRL, 0xF, 0xF, true)); }
__device__ __forceinline__ u32x4 k_norm_rope(const u32x4 raw, const float (&g)[8], float cl, float sl, int l7, int lane) {
    float v[8]; unpack8(raw, v); float ss = 0.f;
#pragma unroll
    for (int i = 0; i < 8; ++i) ss += v[i] * v[i];
    ss += dpp_f<0xB1>(ss); ss += dpp_f<0x4E>(ss); ss += dpp_f<0x141>(ss);
    const float rstd = rsqrtf(ss * (1.f / 64.f) + EPS);
    const float sgn = (l7 == 0) ? -1.f : 1.f; const bool rot = l7 < 2;
#pragma unroll
    for (int i = 0; i < 8; ++i) { const float y = v[i] * rstd * g[i]; const float p = dpp_f<0xB1>(y); const float c = __shfl(cl, (lane & ~7) + i), sn = __shfl(sl, (lane & ~7) + i);
        const float yr = __builtin_fmaf(sgn * p, sn, y * c);
        v[i] = rot ? yr : y; }
    return pack8(v);
}
template <int M0, int M1>
__device__ __forceinline__ void att_tile(const LAS char* tile, const bf16x8 (&qr)[4], const f32x16& cinit, const int tm, const int lane, const int hi, const int r32, f32x16& o0, f32x16& o1, float& lsum) {
    const LAS char* kb = tile + hi * 1024 + r32 * 16;
    const LAS char* vp = tile + 8192 + ((lane >> 4) & 1) * 32 + (lane & 3) * 8 + (4 * hi + ((lane & 15) >> 2)) * 64;
    f32x16 p0 = cinit, p1 = cinit;
    if (M0) {
#pragma unroll
        for (int d0 = 0; d0 < 4; ++d0) { const bf16x8 b0 = *(const LAS bf16x8*)(kb + d0 * 2048); p0 = __builtin_amdgcn_mfma_f32_32x32x16_bf16(b0, qr[d0], p0, 0, 0, 0); } }
    if (M1) {
#pragma unroll
        for (int d0 = 0; d0 < 4; ++d0) { const bf16x8 b1 = *(const LAS bf16x8*)(kb + d0 * 2048 + 512); p1 = __builtin_amdgcn_mfma_f32_32x32x16_bf16(b1, qr[d0], p1, 0, 0, 0); } }
    bf16x8 vf[2][2];
#define ATT_LDV(ks0) do { _Pragma("unroll") for (int k2 = 0; k2 < 2; ++k2) _Pragma("unroll") for (int dh = 0; dh < 2; ++dh) { \
        const s16x4 lo = att::vtr(vp + dh * 4096 + ((ks0) + k2) * 1024), hh = att::vtr(vp + dh * 4096 + ((ks0) + k2) * 1024 + 512); vf[k2][dh] = (bf16x8){lo[0], lo[1], lo[2], lo[3], hh[0], hh[1], hh[2], hh[3]}; } } while (0)
#define ATT_EXP(pp, MODE) do { _Pragma("unroll") for (int r = 0; r < 16; ++r) { const int cr = (r & 3) + 8 * (r >> 2); float e = __builtin_amdgcn_exp2f(pp[r]); \
        if (MODE == 2) e = (cr >= tm) ? e : 0.f; if (MODE == 3) e = (cr <= tm) ? e : 0.f; pp[r] = e; lsum += e; } } while (0)
#define ATT_PV(pp) do { _Pragma("unroll") for (int k2 = 0; k2 < 2; ++k2) { const int b = k2 * 8; \
        const u32x4 pw = (u32x4){cvtpk(pp[b + 0], pp[b + 1]), cvtpk(pp[b + 2], pp[b + 3]), cvtpk(pp[b + 4], pp[b + 5]), cvtpk(pp[b + 6], pp[b + 7])}; \
        o0 = __builtin_amdgcn_mfma_f32_32x32x16_bf16(vf[k2][0], __builtin_bit_cast(bf16x8, pw), o0, 0, 0, 0); \
        o1 = __builtin_amdgcn_mfma_f32_32x32x16_bf16(vf[k2][1], __builtin_bit_cast(bf16x8, pw), o1, 0, 0, 0); } } while (0)
    if (M0) {
        ATT_LDV(0);
        __builtin_amdgcn_sched_barrier(0);
        ATT_EXP(p0, M0);
        __builtin_amdgcn_sched_barrier(0);
        ATT_PV(p0);
    }
    if (M1) {
        ATT_LDV(2);
        __builtin_amdgcn_sched_barrier(0);
        ATT_EXP(p1, M1);
        __builtin_amdgcn_sched_barrier(0);
        ATT_PV(p1);
    }
#undef ATT_LDV
#undef ATT_EXP
#undef ATT_PV
}
struct QRaw { u32x4 raw[4]; };
__device__ __forceinline__ void q_load(QRaw& q, const bf16_t* qbase  , unsigned loff) {
#pragma unroll
    for (int d0 = 0; d0 < 4; ++d0) q.raw[d0] = *(const u32x4*)(qbase + (loff + (unsigned)(d0 * 16)));
}
__device__ __forceinline__ void p3_attention(const Frame& F, const Args& a) {
    using namespace att;
    unsigned char* ws = a.ws;
    const bf16_t* PROJ = (const bf16_t*)(ws + WS_PROJ); bf16_t* AC = (bf16_t*)(ws + WS_AC);
    const float* cosT = (const float*)(ws + WS_ROPE); const float* sinT = cosT + SEQ * 8;
    const float* qg = a.in[3]; const float* kg = a.in[4]; const float* sink = a.in[5]; const float* conv_w = a.in[6]; const float* conv_b = a.in[7];
    const int lane0 = F.lane, wid = F.wave;
    float qgl = qg[lane0], kgl = kg[lane0]; f32x4 cw4 = (F.tid < 384) ? ((const f32x4*)conv_w)[F.tid] : ((const f32x4*)conv_b)[F.tid - 384]; f32x4 qg4 = ((const f32x4*)qg)[F.tid & 15];
    asm volatile("" : "+v"(qgl), "+v"(kgl), "+v"(cw4), "+v"(qg4));
    const float bound = 8.0f * wave_max(fabsf(qgl)) * wave_max(fabsf(kgl)) * 1.4426950408889634f * 1.0001f;
    LAS char* lds = (LAS char*)F.lds; LAS float* wsf = (LAS float*)(lds + WSOFF) + wid * 64;
    const int g = wid >> 1, qsub = wid & 1;
    { const int t = F.tid; *(LAS f32x4*)(lds + CWOFF + t * 16) = cw4;
      if (t < 16) *(LAS f32x4*)(lds + QGOFF + t * 16) = qg4; }
    for (int su = F.vcu; su < NB * NKV * 16; su += F.G) {
        int lane = lane0; asm volatile("" : "+v"(lane));
        const int l7 = lane & 7;
        float gk8[8];
#pragma unroll
        for (int k = 0; k < 8; ++k) gk8[k] = kg[8 * l7 + k];
        const int n0 = (su & 15) * 4, hk = (su >> 4) & 1, b = su >> 5;
        const int h = hk * 4 + g; const float snk = sink[h] * 1.4426950408889634f; const float mref = fmaxf(bound, snk);
        f32x16 cinit;
#pragma unroll
        for (int r = 0; r < 16; ++r) cinit[r] = -mref;
        const size_t rowbase = (size_t)b * SEQ;
        const int ct0 = (su * NWAVES + wid) * 16;
        __syncthreads();
        const unsigned qloff = (unsigned)((lane & 31) * PWP + (lane >> 5) * 8);
        QRaw qn; q_load(qn, PROJ + (rowbase + n0 * 64 + qsub * 32) * PWP + C_Q + h * 64, qloff);
        float up[8], uc[8];
        constexpr int NS0 = 5;
        { u32x4 kraw[NS0], vraw[NS0];
#pragma unroll
          for (int sl = 0; sl < NS0; ++sl) { const int j = n0 - 2 + sl; const bool ok = (j >= 0 && j < 64); const int jj = ok ? j : n0;
              const bf16_t* kbase = PROJ + (rowbase + 64 * jj + 8 * wid) * PWP + C_K + hk * 64;
              const bf16_t* vbase = PROJ + (rowbase + 64 * jj + 16 * (wid & 3)) * PWP + C_V + hk * 64 + (wid >> 2) * 32;
              kraw[sl] = *(const u32x4*)(kbase + (unsigned)((lane >> 3) * PWP + l7 * 8));
              vraw[sl] = *(const u32x4*)(vbase + (unsigned)((lane >> 2) * PWP + (lane & 3) * 8)); }
          const bool hp = (ct0 & (SEQ - 1)) > 0; const size_t tp = (size_t)(hp ? ct0 - 1 : ct0);
          const unsigned l8 = (unsigned)(8 * lane);
          const u32x4 pu = *(const u32x4*)(PROJ + tp * PWP + C_U + l8), cu = *(const u32x4*)(PROJ + (size_t)ct0 * PWP + C_U + l8);
#pragma unroll
          for (int sl = 0; sl < NS0; ++sl) { const int key = 8 * wid + (lane >> 3);
              const u32x4 kn = kraw[sl];
              *(LAS u32x4*)(lds + sl * 16384 + l7 * 1024 + key * 16) = kn;
              *(LAS u32x4*)(lds + sl * 16384 + 8192 + wid * 1024 + lane * 16) = vraw[sl]; }
          { float a8[8]; unpack8(pu, a8);
#pragma unroll
            for (int k = 0; k < 8; ++k) up[k] = hp ? a8[k] : 0.f;
            unpack8(cu, uc); } }
        __syncthreads();
#pragma unroll 1
        for (int uu = 0; uu < 4; ++uu) {
        int lane = lane0; asm volatile("" : "+v"(lane));
        const int r32 = lane & 31, hi = lane >> 5;
        const int n64 = n0 + uu;
        const int qs = n64 * 64 + qsub * 32;
        const int ctb = ct0 + 4 * uu;
        u32x4 rcu[4], rcb[4];
#pragma unroll
        for (int tk = 0; tk < 4; ++tk) { const int t = ctb + tk; const bool hn = ((t & (SEQ - 1)) < SEQ - 1); const size_t tn = (size_t)(hn ? t + 1 : t);
            const unsigned l8 = (unsigned)(8 * lane); rcu[tk] = *(const u32x4*)(PROJ + tn * PWP + C_U + l8); rcb[tk] = *(const u32x4*)(PROJ + (size_t)t * PWP + C_CB + l8); }
        QRaw qc = qn;
        if (uu < 3) q_load(qn, PROJ + (rowbase + qs + 64) * PWP + C_Q + h * 64, (unsigned)(r32 * PWP + hi * 8));
        u32x4 kraw1 = {0u, 0u, 0u, 0u}, vraw1 = {0u, 0u, 0u, 0u};
        if (uu < 3) { const int sl = 5 + uu; const int j = n0 - 2 + sl; const bool ok = (j >= 0 && j < 64); const int jj = ok ? j : n0;
            const bf16_t* kbase = PROJ + (rowbase + 64 * jj + 8 * wid) * PWP + C_K + hk * 64;
            const bf16_t* vbase = PROJ + (rowbase + 64 * jj + 16 * (wid & 3)) * PWP + C_V + hk * 64 + (wid >> 2) * 32;
            kraw1 = *(const u32x4*)(kbase + (unsigned)((lane >> 3) * PWP + (lane & 7) * 8));
            vraw1 = *(const u32x4*)(vbase + (unsigned)((lane >> 2) * PWP + (lane & 3) * 8)); }
        bf16x8 qr[4];
#pragma unroll
        for (int d0 = 0; d0 < 4; ++d0) qr[d0] = __builtin_bit_cast(bf16x8, qc.raw[d0]);
        asm volatile("" ::: "memory");
        f32x16 o0 = {}, o1 = {}; float lsum = 0.f;
        { const int tm = r32 - 4 * hi; const LAS char* t0 = lds + uu * 16384;
          if (n64 >= 2)  { if (qsub) att_tile<0, 2>(t0, qr, cinit, tm, lane, hi, r32, o0, o1, lsum); else att_tile<2, 1>(t0, qr, cinit, tm, lane, hi, r32, o0, o1, lsum); }
#pragma unroll 1
          for (int sl = 1; sl < 4; ++sl) { const int j = n64 - 2 + sl; if (j < 0 || j >= 64) continue; att_tile<1, 1>(t0 + sl * 16384, qr, cinit, tm, lane, hi, r32, o0, o1, lsum); }
          if (n64 < 62) { if (qsub) att_tile<1, 3>(t0 + 4 * 16384, qr, cinit, tm, lane, hi, r32, o0, o1, lsum); else att_tile<3, 0>(t0 + 4 * 16384, qr, cinit, tm, lane, hi, r32, o0, o1, lsum); } }
        lsum += __shfl_xor(lsum, 32); lsum += __builtin_amdgcn_exp2f(snk - mref);
        { const float rl16 = __builtin_amdgcn_rcpf(lsum) * 16.0f;
          unsigned char* Ow = ws + WS_ATT8 + (rowbase + qs) * 512 + h * 64;
#pragma unroll
          for (int dh = 0; dh < 2; ++dh) { unsigned w[4];
#pragma unroll
              for (int gq = 0; gq < 4; ++gq) { const float a0 = (dh ? o1[4 * gq] : o0[4 * gq]) * rl16, a1 = (dh ? o1[4 * gq + 1] : o0[4 * gq + 1]) * rl16, a2 = (dh ? o1[4 * gq + 2] : o0[4 * gq + 2]) * rl16, a3 = (dh ? o1[4 * gq + 3] : o0[4 * gq + 3]) * rl16;
                  w[gq] = pk4_fp8(a0, a1, a2, a3); }
              { const auto s01 = __builtin_amdgcn_permlane32_swap(w[0], w[1], false, false); w[0] = s01[0]; w[1] = s01[1]; }
              { const auto s23 = __builtin_amdgcn_permlane32_swap(w[2], w[3], false, false); w[2] = s23[0]; w[3] = s23[1]; }
              { const auto s02 = __builtin_amdgcn_permlane32_swap(w[0], w[2], false, false); w[0] = s02[0]; w[2] = s02[1]; }
              { const auto s13 = __builtin_amdgcn_permlane32_swap(w[1], w[3], false, false); w[1] = s13[0]; w[3] = s13[1]; }
              *(u32x4*)(Ow + (size_t)r32 * 512 + dh * 32 + hi * 16) = (u32x4){w[0], w[1], w[2], w[3]}; } }
        asm volatile("" ::: "memory");
        { float w0[8], w1[8], w2[8], bb[8];
#pragma unroll
          for (int k = 0; k < 8; ++k) { const LAS float* cw = (const LAS float*)(lds + CWOFF) + 8 * lane + k; w0[k] = cw[0]; w1[k] = cw[CD]; w2[k] = cw[2 * CD]; bb[k] = cw[3 * CD]; }
#pragma unroll
          for (int tk = 0; tk < 4; ++tk) { const int t = ctb + tk; const bool hn = ((t & (SEQ - 1)) < SEQ - 1);
              float a8[8], cbv[8], un[8], o[8]; unpack8(rcu[tk], a8); unpack8(rcb[tk], cbv);
#pragma unroll
              for (int k = 0; k < 8; ++k) { un[k] = hn ? a8[k] : 0.f; o[k] = cbv[k] * (up[k] * w0[k] + uc[k] * w1[k] + un[k] * w2[k] + bb[k]); up[k] = uc[k]; uc[k] = un[k]; }
              *(u32x4*)(AC + (size_t)t * 1024 + 512 + 8 * lane) = pack8(o); } }
        if (uu < 3) { const int sl = 5 + uu;
            *(LAS u32x4*)(lds + sl * 16384 + (lane & 7) * 1024 + (8 * wid + (lane >> 3)) * 16) = kraw1;
            *(LAS u32x4*)(lds + sl * 16384 + 8192 + wid * 1024 + lane * 16) = vraw1;
            __syncthreads(); }
        }
    }
    __syncthreads();
}

__device__ __forceinline__ void p6_route(const Frame& F, const Args& a) {
    unsigned char* ws = a.ws;
    const bf16_t* X1 = (const bf16_t*)(ws + WS_X1B); const float* g2 = a.in[11]; const float* b_rg = a.in[13]; const float* b_re = a.in[15];
    unsigned char* H2 = ws + WS_H2; const bf16_t* WrT = (const bf16_t*)(ws + WS_WR);
    int* asg = (int*)(ws + WS_ASG); f32x2* rsg = (f32x2*)(ws + WS_RSG); unsigned* gcnt = (unsigned*)(ws + WS_CTL) + CW_CNT;
    const int lane = F.lane, wid = F.wave, r = lane & 15, kg = lane >> 4;
    constexpr int WR_PITCH = 2064, WR_BYTES = 48 * WR_PITCH, G2_OFF = WR_BYTES, LG_OFF = G2_OFF + 4096;
    LAS unsigned char* wrl = F.lds; LAS float* g2l = (LAS float*)(F.lds + G2_OFF); LAS float* lg = (LAS float*)(F.lds + LG_OFF) + wid * (16 * 48);
    LAS int* hist = (LAS int*)(F.lds + LDSCTL_OFF + LC_HIST); LAS int* base = (LAS int*)(F.lds + LDSCTL_OFF + LC_BASE);
    { const __amdgpu_buffer_rsrc_t rsw = __builtin_amdgcn_make_buffer_rsrc(const_cast<bf16_t*>(WrT), 0, 0xffffffff, 0x00020000);
#pragma unroll
      for (int j = 0; j < 12; ++j) { const int idx = wid * 12 + j, row = idx >> 1, half = idx & 1;
          __builtin_amdgcn_raw_ptr_buffer_load_lds(rsw, (LAS void*)(wrl + row * WR_PITCH + half * 1024), 16, lane * 16, row * 2048 + half * 1024, 0, 0); } }
    constexpr int BR_OFF = LG_OFF + NWAVES * 16 * 48 * 4; LAS float* brl = (LAS float*)(F.lds + BR_OFF);
    static_assert(BR_OFF + 144 <= RING_BYTES, "P6 LDS map");
    const float* csrc = (F.tid < 256) ? g2 + 4 * F.tid : (F.tid == 256) ? b_rg : (F.tid < 265) ? b_re + 4 * (F.tid - 257) : g2;
    const f32x4 cst = *(const f32x4*)csrc;
    bool cst_pending = true;
    const int nblk = M / 128;
    for (int blk = F.vcu; blk < nblk; blk += F.G) {
        if (F.tid < 32) hist[F.tid] = 0;
        const int row0 = blk * 128 + wid * 16;
        f32x4 acc[3] = {{0.f, 0.f, 0.f, 0.f}, {0.f, 0.f, 0.f, 0.f}, {0.f, 0.f, 0.f, 0.f}}; float ss = 0.f;
        const bf16_t* xr = X1 + (size_t)(row0 + r) * D + 8 * kg; unsigned char* hr = H2 + (size_t)(row0 + r) * D + 8 * kg;
        const LAS unsigned char* wb = wrl + r * WR_PITCH + 16 * kg; const LAS float* gl = g2l + 8 * kg;
        { u32x4 xv[32];
#pragma unroll
            for (int q = 0; q < 32; ++q) xv[q] = *(const u32x4*)(xr + 32 * q);
            asm volatile("s_waitcnt vmcnt(0)" ::: "memory");
            if (cst_pending) { cst_pending = false; if (F.tid < 256) *(LAS f32x4*)(g2l + 4 * F.tid) = cst; else if (F.tid < 265) *(LAS f32x4*)(brl + 4 * (F.tid - 256)) = cst; }
            __syncthreads();
#pragma unroll
            for (int q = 0; q < 32; ++q) { const int s = q; const f32x4 x0 = {bflo(xv[q].x), bfhi(xv[q].x), bflo(xv[q].y), bfhi(xv[q].y)}, x1 = {bflo(xv[q].z), bfhi(xv[q].z), bflo(xv[q].w), bfhi(xv[q].w)};
                const f32x4 ga = *(const LAS f32x4*)(gl + 32 * s), gb = *(const LAS f32x4*)(gl + 32 * s + 4);
                ss += (x0.x * x0.x + x0.y * x0.y) + (x0.z * x0.z + x0.w * x0.w) + (x1.x * x1.x + x1.y * x1.y) + (x1.z * x1.z + x1.w * x1.w);
                u32x4 w; w.x = cvtpk(x0.x * ga.x, x0.y * ga.y); w.y = cvtpk(x0.z * ga.z, x0.w * ga.w); w.z = cvtpk(x1.x * gb.x, x1.y * gb.y); w.w = cvtpk(x1.z * gb.z, x1.w * gb.w);
                { u32x2 w8; w8.x = pk4_fp8(x0.x * ga.x, x0.y * ga.y, x0.z * ga.z, x0.w * ga.w); w8.y = pk4_fp8(x1.x * gb.x, x1.y * gb.y, x1.z * gb.z, x1.w * gb.w); *(u32x2*)(hr + 32 * s) = w8; }
                const bf16x8 af = __builtin_bit_cast(bf16x8, w);
#pragma unroll
                for (int j = 0; j < 3; ++j) { const bf16x8 bfr = *(const LAS bf16x8*)(wb + 16 * j * WR_PITCH + 64 * s); acc[j] = __builtin_amdgcn_mfma_f32_16x16x32_bf16(af, bfr, acc[j], 0, 0, 0); } } }
        ss += __shfl_xor(ss, 16); ss += __shfl_xor(ss, 32);
        const float rstd = rsqrtf(ss * (1.f / D) + EPS);
#pragma unroll
        for (int j = 0; j < 3; ++j)
#pragma unroll
            for (int i = 0; i < 4; ++i) lg[(4 * kg + i) * 48 + 16 * j + r] = acc[j][i];
        LDS_WAIT(); asm volatile("" ::: "memory");
        int e0 = 0, e1 = 0, rk0 = 0, rk1 = 0; float gt0 = 0.f, gt1 = 0.f;
        if (lane < 16) {
            const LAS float* L = lg + lane * 48;
            float gl4[4]; int grp = 0; float gm;
#pragma unroll
            for (int i = 0; i < 4; ++i) gl4[i] = L[i] * rstd + brl[i];
            gm = gl4[0];
#pragma unroll
            for (int i = 1; i < 4; ++i) if (gl4[i] > gm) { gm = gl4[i]; grp = i; }
            float gs = 0.f;
#pragma unroll
            for (int i = 0; i < 4; ++i) gs += __expf(gl4[i] - gm);
            const float pg = 1.0f / gs;
            float el[8];
#pragma unroll
            for (int i = 0; i < 8; ++i) el[i] = L[4 + grp * 8 + i] * rstd + brl[4 + grp * 8 + i];
            int i0 = 0; float m0 = el[0];
#pragma unroll
            for (int i = 1; i < 8; ++i) if (el[i] > m0) { m0 = el[i]; i0 = i; }
            int i1 = -1; float m1 = -3.0e38f;
#pragma unroll
            for (int i = 0; i < 8; ++i) if (i != i0 && el[i] > m1) { m1 = el[i]; i1 = i; }
            const float ex1 = __expf(m1 - m0); const float den = 1.0f / (1.0f + ex1);
            gt0 = pg * den; gt1 = pg * ex1 * den; e0 = grp * 8 + i0; e1 = grp * 8 + i1;
            rk0 = __hip_atomic_fetch_add(&hist[e0], 1, __ATOMIC_RELAXED, __HIP_MEMORY_SCOPE_WORKGROUP);
            rk1 = __hip_atomic_fetch_add(&hist[e1], 1, __ATOMIC_RELAXED, __HIP_MEMORY_SCOPE_WORKGROUP);
        }
        __syncthreads();
        if (F.tid < 32) { const int n = hist[F.tid]; int bs = 0; if (n > 0) bs = (int)__hip_atomic_fetch_add(gcnt + F.tid, (unsigned)n, __ATOMIC_RELAXED, __HIP_MEMORY_SCOPE_AGENT); base[F.tid] = bs; }
        __syncthreads();
        if (lane < 16) { const int tok = row0 + lane;
            const size_t p0 = (size_t)e0 * CAP + base[e0] + rk0, p1 = (size_t)e1 * CAP + base[e1] + rk1;
            asg[p0] = tok * 2; asg[p1] = tok * 2 + 1; rsg[p0] = (f32x2){gt0, rstd}; rsg[p1] = (f32x2){gt1, rstd}; }
        __syncthreads();
    }
}

__device__ __forceinline__ void moe_tables(const Frame& F, const Args& a) {
    const unsigned* gcnt = (const unsigned*)(a.ws + WS_CTL) + CW_CNT;
    LAS int* mtpre = (LAS int*)(F.lds + LDSCTL_OFF + LC_MTPRE); LAS int* cnt = (LAS int*)(F.lds + LDSCTL_OFF + LC_CNT);
    __syncthreads();
    if (F.wave == 0) {
        int l = lane_id(); asm volatile("" : "+v"(l));
        const int n = (l < 32) ? (int)__hip_atomic_load(gcnt + l, __ATOMIC_RELAXED, __HIP_MEMORY_SCOPE_AGENT) : 0;
        const int t = (n + 255) >> 8; int inc = t;
#pragma unroll
        for (int d = 1; d < 32; d <<= 1) { const int v = __builtin_amdgcn_ds_bpermute(((l - d) & 63) << 2, inc); if (l >= d) inc += v; }
        if (l < 32) { cnt[l] = n; mtpre[l] = inc - t; }
        if (l == 31) mtpre[32] = inc; }
    __syncthreads();
}

__device__ __forceinline__ void p9_combine(const Frame& F, const Args& a, bool dummy = false, float pert = 0.f) {
    const bf16_t* X1 = (const bf16_t*)(a.ws + WS_X1B); float* lo_dst = dummy ? (float*)(a.ws + WS_H2) : a.out; float* hi_dst = dummy ? (float*)(a.ws + WS_MERGED) - (size_t)(M / 2) * D : a.out; const unsigned char* Y = a.ws + WS_Y;
    const unsigned gt = (unsigned)F.vcu * NTHREADS + F.tid, NGT = (unsigned)F.G * NTHREADS, TOT = (unsigned)M * 128u;
    for (unsigned i0 = gt; i0 < TOT; i0 += 4 * NGT) {
        u32x4 xq[4]; u32x2 y0[4], y1[4];
#pragma unroll
        for (int k = 0; k < 4; ++k) { const unsigned i = i0 + k * NGT, ii = i < TOT ? i : gt; const size_t tok = ii >> 7, c8 = (ii & 127) * 8;
            xq[k] = *(const u32x4*)(X1 + tok * D + c8);
            y0[k] = *(const u32x2*)(Y + (tok * 2) * D + c8); y1[k] = *(const u32x2*)(Y + (tok * 2 + 1) * D + c8); }
#pragma unroll
        for (int k = 0; k < 4; ++k) { const unsigned i = i0 + k * NGT; if (i < TOT) { const size_t tok = i >> 7, c8 = (i & 127) * 8; f32x4 x0 = {bflo(xq[k].x), bfhi(xq[k].x), bflo(xq[k].y), bfhi(xq[k].y)}, x1 = {bflo(xq[k].z), bfhi(xq[k].z), bflo(xq[k].w), bfhi(xq[k].w)};
            float p[8], q[8]; un4_fp8(y0[k].x, p[0], p[1], p[2], p[3]); un4_fp8(y0[k].y, p[4], p[5], p[6], p[7]); un4_fp8(y1[k].x, q[0], q[1], q[2], q[3]); un4_fp8(y1[k].y, q[4], q[5], q[6], q[7]);
            x0.x += (p[0] + q[0]) * 0.0625f; x0.y += (p[1] + q[1]) * 0.0625f; x0.z += (p[2] + q[2]) * 0.0625f; x0.w += (p[3] + q[3]) * 0.0625f;
            x1.x += (p[4] + q[4]) * 0.0625f; x1.y += (p[5] + q[5]) * 0.0625f; x1.z += (p[6] + q[6]) * 0.0625f; x1.w += (p[7] + q[7]) * 0.0625f;
            if (PROBE_TS >= 0) { x0.x += pert; x0.y -= pert; x0.z += pert; x0.w -= pert; x1.x += pert; x1.y -= pert; x1.z += pert; x1.w -= pert; }
            float* dst = (tok < (size_t)(M / 2)) ? lo_dst : hi_dst; __builtin_nontemporal_store(x0, (f32x4*)(dst + tok * D + c8)); __builtin_nontemporal_store(x1, (f32x4*)(dst + tok * D + c8 + 4)); } }
    }
}

constexpr int N_PHASES = 10;
__global__ void __launch_bounds__(NTHREADS, 2) fwd_kernel(Args args_) {
    typedef const __attribute__((address_space(4))) Args* KArgP;
#if defined(__HIP_DEVICE_COMPILE__)
#define LOAD_ARGS() KArgP ap_ = (KArgP)__builtin_amdgcn_kernarg_segment_ptr(); asm volatile("" : "+s"(ap_)); const Args args = *ap_;
#else
#define LOAD_ARGS() const Args args = args_;
#endif
#define LOAD_ARGS_NOTE()
    extern __shared__ __attribute__((aligned(16))) unsigned char lds_raw[];
    Frame F; F.lds = (LAS unsigned char*)lds_raw; F.wave = __builtin_amdgcn_readfirstlane((int)threadIdx.x >> 6); F.lane = lane_id(); F.tid = F.wave * 64 + F.lane;
    F.G = gridDim.x; { const int bx = blockIdx.x; F.vcu = (F.G % 8 == 0) ? (bx % 8) * (F.G / 8) + bx / 8 : bx; }
    for (int u = F.tid; u < (LDS_BYTES - LDSCTL_OFF) / 4; u += NTHREADS) ((LAS unsigned*)(F.lds + LDSCTL_OFF))[u] = 0u;
    __syncthreads();
    unsigned char* ws = args_.ws;
    const int lo = args_.ph_lo, hi = args_.ph_hi;
#ifndef PH_MASK
#define PH_MASK 0x3ff
#endif
#define IN(k) (((PH_MASK >> (k)) & 1) && lo <= (k) && (k) < hi)
#if MK_USE_CG
#define GRID_BAR(k) do { if (IN(k) && IN((k) + 1)) { cg::this_grid().sync(); } } while (0)
#else
    XcdBarrier bar; bar.bar = (unsigned*)(ws + WS_CTL) + CW_BAR; bar.x = 0; bar.st = nullptr; bar.wave = F.wave;
    if (hi - lo > 1) bar = xcd_barrier_post((unsigned*)(ws + WS_CTL) + CW_BAR, (volatile LAS unsigned*)(F.lds + LDSCTL_OFF + LC_MISC) + 8, F.wave);
#define GRID_BAR(k) do { if (IN(k) && IN((k) + 1)) { xcd_barrier(bar); if (PROBE_TS >= 0 && blockIdx.x == 0 && F.wave == 0 && lane_id() == 0) ((unsigned long long*)((unsigned*)(ws + WS_CTL) + CW_TS))[(k) + 1] = __builtin_amdgcn_s_memrealtime(); } } while (0)
#endif
    const LAS int* mtpre = (const LAS int*)(F.lds + LDSCTL_OFF + LC_MTPRE); const LAS int* lcnt = (const LAS int*)(F.lds + LDSCTL_OFF + LC_CNT);

#define REP(k) for (int rep_ = 0; rep_ < args_.rep[k]; ++rep_)
#define REFRESH() do { F.lane = lane_id(); asm volatile("" : "+v"(F.lane)); F.tid = F.wave * 64 + F.lane; } while (0)
#define REPBAR() if (rep_) xcd_barrier(bar); REFRESH(); LOAD_ARGS()
    if (PROBE_TS >= 0 && blockIdx.x == 0 && F.wave == 0 && lane_id() == 0) ((unsigned long long*)((unsigned*)(ws + WS_CTL) + CW_TS))[0] = __builtin_amdgcn_s_memrealtime();
    if (IN(0)) REP(0) { REPBAR();
        const int tg_ = F.wave * 64 + lane_id(); const f32x4 hg_ = *(const f32x4*)(((tg_ & 16) ? args.in[4] : args.in[3]) + 4 * (tg_ & 15));
        p0_prologue(F, args);
        if (tg_ < 32) *(LAS f32x4*)(F.lds + LDS_META_OFF + 4096 + tg_ * 16) = (tg_ < 16) ? hg_ * QSCALE : hg_; } GRID_BAR(0);
    if (IN(1)) REP(1) { REPBAR(); pg8::EpiProjT<true> E8{(bf16_t*)(ws + WS_PROJ), ws + WS_GATE8, (const float*)(ws + WS_ROPE), F.lds + LDS_META_OFF + 4096};
        if (rep_ == 0) { const int nwg = 128 * 11, maxc = (nwg + F.G - 1) / F.G, full = nwg - (maxc - 1) * F.G;
            if (full >= F.G) convert_items(F, args, I_SMALL, I_SMALL + 2 * I_G, (int)blockIdx.x, F.G);
            else if ((int)blockIdx.x >= full) convert_items(F, args, I_SMALL, I_SMALL + 2 * I_G, (int)blockIdx.x - full, F.G - full);
            __syncthreads(); }
        { pg8::ProjOrder8 S{ws + WS_XN8, ws + WS_WIN8, F.G, (int)blockIdx.x};
          pg8::gemm_phase<pg8::EpiProjT<true>, pg8::ProjOrder8, true, true, true>(F.lds, F.wave, 512, 512, 512, S, E8); }
        { pg8::ProjOrder16 S{(const bf16_t*)(ws + WS_XN), (const bf16_t*)(ws + WS_WIN), F.G, (int)blockIdx.x};
          pg8::gemm_phase<pg8::EpiProjT<true>, pg8::ProjOrder16, true>(F.lds, F.wave, 1024, 1024, 1024, S, E8); } } GRID_BAR(1);
    if (IN(3)) REP(3) { REPBAR(); p3_attention(F, args); } GRID_BAR(3);
    if (IN(4)) REP(4) { REPBAR(); pg8::GateMixOrder S{(const bf16_t*)(ws + WS_AC), (const bf16_t*)(ws + WS_WC), ws + WS_ATT8, ws + WS_WA, F.G, (int)blockIdx.x};
        pg8::EpiGate2 E{ws + WS_GATE8, ws + WS_MERGED};
        if (F.wave < 4) { const __amdgpu_buffer_rsrc_t rg = __builtin_amdgcn_make_buffer_rsrc(const_cast<float*>(args.in[1]), 0, 0xffffffff, 0x00020000);
            __builtin_amdgcn_raw_ptr_buffer_load_lds(rg, (LAS void*)(F.lds + LDS_META_OFF + F.wave * 1024), 16, lane_id() * 16, F.wave * 1024, 0, 0); }
        pg8::gemm_phase<pg8::EpiGate2, pg8::GateMixOrder, true, true, false, 4>(F.lds, F.wave, 768, 1024, 512, S, E, 256, 256); } GRID_BAR(4);
    if (IN(5)) REP(5) { REPBAR(); pg8::PlainOrder S{(const bf16_t*)(ws + WS_MERGED), (const bf16_t*)(ws + WS_WOUT), 512, 512, M / 256, D / 256, F.G, (int)blockIdx.x};
        { const int t2 = (F.wave * 64 + lane_id()) * 2; LAS float* igw = (LAS float*)(F.lds + LDS_META_OFF);
          f32x2 gv; if (IN(4)) gv = *(const LAS f32x2*)(igw + t2); else gv = *(const f32x2*)(args.in[1] + t2);
          igw[t2] = __builtin_amdgcn_rcpf(gv.x); igw[t2 + 1] = __builtin_amdgcn_rcpf(gv.y); }
        pg8::EpiRes E{(bf16_t*)(ws + WS_X1B), (const float*)(ws + WS_RRS), (const LAS float*)(F.lds + LDS_META_OFF)};
        pg8::gemm_phase<pg8::EpiRes, pg8::PlainOrder, true, true, true>(F.lds, F.wave, 512, 512, 512, S, E); } GRID_BAR(5);
    if (IN(6)) REP(6) { REFRESH(); LOAD_ARGS(); if (rep_) { xcd_barrier(bar); if (blockIdx.x == 0 && F.tid < 32) ((unsigned*)(ws + WS_CTL) + CW_CNT)[F.tid] = 0u; xcd_barrier(bar); } p6_route(F, args); } GRID_BAR(6);
    if (IN(7)) REP(7) { REPBAR(); moe_tables(F, args);
        pg8::MoeGuOrder S; S.mtpre = mtpre; S.cnt = lcnt; S.NT = 2; S.G = F.G; S.c = F.vcu;   S.H2 = ws + WS_H2; S.Wgu = ws + WS_WGU; S.asg = (const int*)(ws + WS_ASG); S.idl = (LAS int*)(F.lds + LDS_META_OFF + 4096);
        pg8::EpiGU E{ws + WS_HID, (const f32x2*)(ws + WS_RSG), mtpre, F.lds + LDS_META_OFF};
        pg8::gemm_phase<pg8::EpiGU, pg8::MoeGuOrder, true, true, true>(F.lds, F.wave, 512, 512, 512, S, E);
        REFRESH();
        if (rep_ == 0) { const int nwg = mtpre[32] * 2, maxc = (nwg + F.G - 1) / F.G, full = nwg - (maxc - 1) * F.G;
            __syncthreads();
            if (full >= F.G || maxc == 0) convert_items(F, args, I_SMALL + 2 * I_G, NITEMS, F.vcu, F.G);
            else if (F.vcu >= full) convert_items(F, args, I_SMALL + 2 * I_G, NITEMS, F.vcu - full, F.G - full); } } GRID_BAR(7);
    if (IN(8)) REP(8) { REPBAR(); if (!(IN(7))) moe_tables(F, args);
        pg8::MoeDownOrder S; S.mtpre = mtpre; S.cnt = lcnt; S.NT = 4; S.G = F.G; S.c = F.vcu; S.HID = ws + WS_HID; S.Wd = ws + WS_WD;
        pg8::EpiDown E{ws + WS_Y, (const int*)(ws + WS_ASG), (const f32x2*)(ws + WS_RSG), mtpre, F.lds + LDS_META_OFF};
        pg8::gemm_phase<pg8::EpiDown, pg8::MoeDownOrder, true, true, true>(F.lds, F.wave, 128, 128, 128, S, E); } GRID_BAR(8);
    if (IN(9)) { REFRESH(); LOAD_ARGS(); if (args.rep[9] > 1) { p9_combine(F, args, true); xcd_barrier(bar); }
        float pert = 0.f;
        if (PROBE_TS >= 0) { xcd_barrier(bar); const unsigned long long* ts = (const unsigned long long*)((unsigned*)(ws + WS_CTL) + CW_TS);
            const float dt_us = (PROBE_TS == 99) ? 100.f : (float)(__hip_atomic_load(ts + PROBE_TS + 1, __ATOMIC_RELAXED, __HIP_MEMORY_SCOPE_AGENT) - __hip_atomic_load(ts + (PROBE_TS == 3 ? 2 : PROBE_TS), __ATOMIC_RELAXED, __HIP_MEMORY_SCOPE_AGENT)) * 0.01f;
            pert = sqrtf(dt_us * PROBE_SCALE * PROBE_V); }
        p9_combine(F, args, false, pert); }
#undef IN
#undef GRID_BAR
}

extern "C" void kernel_launch(void* const* d_in, const int* in_sizes, int n_in, void* d_out, int out_size, void* d_ws, size_t ws_size, hipStream_t stream) {
    static int grid = 0;
    if (grid == 0) {
        if (n_in != 19 || in_sizes[0] != M * D || out_size != M * D || ws_size < WS_END) { fprintf(stderr, "kernel_launch: unexpected shapes (n_in %d, in0 %d, out %d, ws %zu)\n", n_in, n_in > 0 ? in_sizes[0] : -1, out_size, ws_size); grid = -1; return; }
        int dev = 0, cus = 0, per_cu = 0;
        if (hipGetDevice(&dev) != hipSuccess || hipDeviceGetAttribute(&cus, hipDeviceAttributeMultiprocessorCount, dev) != hipSuccess) { grid = -1; return; }
        if (hipFuncSetAttribute((const void*)fwd_kernel, hipFuncAttributeMaxDynamicSharedMemorySize, LDS_BYTES) != hipSuccess) { fprintf(stderr, "kernel_launch: hipFuncSetAttribute failed\n"); grid = -1; return; }
        if (hipOccupancyMaxActiveBlocksPerMultiprocessor(&per_cu, (const void*)fwd_kernel, NTHREADS, LDS_BYTES) != hipSuccess || per_cu < 1) { fprintf(stderr, "kernel_launch: occupancy query says %d\n", per_cu); per_cu = 1; }
        (void)hipGetLastError();
        grid = cus * 1;
        fprintf(stderr, "kernel_launch: cus %d per_cu %d grid %d\n", cus, per_cu, grid);
    }
    if (grid < 0) return;
    (void)hipMemsetAsync((char*)d_ws + WS_CTL, 0, CTL_ZERO_BYTES, stream);
    Args a{};
    for (int i = 0; i < 19; ++i) a.in[i] = (const float*)d_in[i];
    a.out = (float*)d_out; a.ws = (unsigned char*)d_ws;
    for (int i = 0; i < 10; ++i) a.rep[i] = (i == PROBE_DUP) ? 2 : 1;
#if MK_N_LAUNCHES == 1
    a.ph_lo = 0; a.ph_hi = N_PHASES;
    void* kargs[] = {&a};
#if MK_USE_CG
    hipError_t e = hipLaunchCooperativeKernel((const void*)fwd_kernel, dim3(grid), dim3(NTHREADS), kargs, LDS_BYTES, stream);
    if (e != hipSuccess) fprintf(stderr, "kernel_launch: cooperative launch failed: %s\n", hipGetErrorString(e));
#else
    (void)kargs; hipLaunchKernelGGL(fwd_kernel, dim3(grid), dim3(NTHREADS), LDS_BYTES, stream, a);
#endif
#else
    for (int p = 0; p < N_PHASES; ++p) { a.ph_lo = p; a.ph_hi = p + 1; hipLaunchKernelGGL(fwd_kernel, dim3(grid), dim3(NTHREADS), LDS_BYTES, stream, a); }
#endif
}
```
